# Optimizing an MI355X kernel written in HIP

```python
import math
import jax, jax.numpy as jnp
from jax import lax
import numpy as np

D_MODEL = 1024
BATCH = 16
SEQ = 2048
DEPTH = 4

CTX_LEN = 256
GRID_W = 64
N_MOD = 6
EPS = 1e-6
ATTN_HEADS = 4
HEAD_DIM = 64
ATTN_VDIM = 2 * HEAD_DIM
Q_WIDTH = ATTN_HEADS * 2 * HEAD_DIM
ATTN_WIDTH = ATTN_HEADS * ATTN_VDIM
ROPE_BASE = 10000.0
Q_BLOCK = 128
SSD_HEADDIM = 64
SSD_GROUPS = 2
SSD_HPG = 4
SSD_HEADS = SSD_GROUPS * SSD_HPG
SSD_INNER = SSD_HEADS * SSD_HEADDIM
D_STATE = 128
D_CONV = 3
CHUNK = 128
CONV_DIM = SSD_INNER + 2 * SSD_GROUPS * D_STATE
MIX_WIDTH = ATTN_WIDTH + SSD_INNER
P_IN = 2 * Q_WIDTH + ATTN_WIDTH + SSD_INNER + CONV_DIM + 2 * SSD_HEADS
N_EXPERTS = 16
EC_CAPACITY = 2
D_EXPERT = 1408

kernel_name = "hybrid_diffattn_ssd_ecmoe_dit"


def rmsnorm(x, w):
    xf = x.astype(jnp.float32)
    y = xf * lax.rsqrt(jnp.mean(xf * xf, axis=-1, keepdims=True) + EPS)
    return (y * w.astype(jnp.float32)).astype(x.dtype)


def axial_rope_tables(n):
    rows = n // GRID_W
    row = jnp.repeat(jnp.arange(rows), GRID_W)
    col = jnp.tile(jnp.arange(GRID_W), rows)
    n_freq = HEAD_DIM // 4
    inv = ROPE_BASE ** (-jnp.arange(n_freq, dtype=jnp.float32) / n_freq)
    ang = jnp.stack([row, col], axis=-1).astype(jnp.float32)[..., None] * inv
    return jnp.cos(ang), jnp.sin(ang)


def apply_rope(x, cos, sin):
    xr = x.reshape(x.shape[:-1] + (2, 2, HEAD_DIM // 4))
    x1, x2 = xr[..., 0, :], xr[..., 1, :]
    c = cos[:, None, None].astype(x.dtype)
    s = sin[:, None, None].astype(x.dtype)
    out = jnp.stack([x1 * c - x2 * s, x1 * s + x2 * c], axis=-2)
    return out.reshape(x.shape)


def split_proj(p):
    idx = [int(v) for v in np.cumsum([Q_WIDTH, Q_WIDTH, ATTN_WIDTH, SSD_INNER, CONV_DIM, SSD_HEADS])]
    return jnp.split(p, idx, axis=-1)


def diff_attend(q, k_all, v_all, lam):
    s = jnp.einsum("bqhid,bkhid->bhiqk", q, k_all).astype(jnp.float32) * (HEAD_DIM ** -0.5)
    p = jax.nn.softmax(s, axis=-1)
    w = p[:, :, 0] - lam * p[:, :, 1]
    return jnp.einsum("bhqk,bkhe->bqhe", w.astype(v_all.dtype), v_all)


def centred_dwconv(x, w, bias):
    pad = D_CONV // 2
    l = x.shape[1]
    xp = jnp.pad(x, ((0, 0), (pad, pad), (0, 0)))
    out = bias
    for tap in range(D_CONV):
        out = out + xp[:, tap:tap + l] * w[tap]
    return out


def ssd_chunked(xs, dt, a, bm, cm, h0):
    f32 = jnp.float32
    b, l, g, r, p = xs.shape
    nst = bm.shape[-1]
    nc = l // CHUNK
    dtf = dt.astype(f32)
    xdt = (xs.astype(f32) * dtf[..., None]).reshape(b, nc, CHUNK, g, r, p)
    a_cs = jnp.cumsum((dtf * a).reshape(b, nc, CHUNK, g, r), axis=2)
    bc = bm.astype(f32).reshape(b, nc, CHUNK, g, nst)
    cc = cm.astype(f32).reshape(b, nc, CHUNK, g, nst)
    tri = jnp.tril(jnp.ones((CHUNK, CHUNK), bool))[:, :, None, None]
    seg = a_cs[:, :, :, None] - a_cs[:, :, None, :]
    decay = jnp.exp(jnp.where(tri, seg, -jnp.inf))
    cb = jnp.einsum("bclgn,bcsgn->bclsg", cc, bc)
    y_diag = jnp.einsum("bclsgr,bcsgrp->bclgrp", cb[..., None] * decay, xdt)
    to_end = jnp.exp(a_cs[:, :, -1:] - a_cs)
    states = jnp.einsum("bclgn,bclgrp->bcgrpn", bc, xdt * to_end[..., None])
    chunk_decay = jnp.exp(a_cs[:, :, -1])

    def step(h, inp):
        s, d = inp
        return h * d[..., None, None] + s, h

    h_final, h_in = lax.scan(step, h0.astype(f32),
                             (jnp.moveaxis(states, 1, 0), jnp.moveaxis(chunk_decay, 1, 0)))
    h_in = jnp.moveaxis(h_in, 0, 1)
    y_off = jnp.einsum("bclgn,bcgrpn->bclgrp", cc, h_in) * jnp.exp(a_cs)[..., None]
    y = (y_diag + y_off).reshape(b, l, g, r, p)
    return y.astype(xs.dtype), h_final


def ssd_bidirectional(xs, bm, cm, dt_f, dt_b, a_f, a_b, h0_f, h0_b):
    flip = lambda t: jnp.flip(t, axis=1)
    y_f, h_f = ssd_chunked(xs, dt_f, a_f, bm, cm, h0_f)
    y_b, h_b = ssd_chunked(flip(xs), flip(dt_b), a_b, flip(bm), flip(cm), h0_b)
    return y_f + flip(y_b), h_f, h_b


def ssd_inputs(xbc, dtf, dtb, conv_w, conv_b, dt_bias_f, dt_bias_b):
    b, l, _ = xbc.shape
    xbc = jax.nn.silu(centred_dwconv(xbc, conv_w, conv_b))
    xs, bm, cm = jnp.split(xbc, [SSD_INNER, SSD_INNER + SSD_GROUPS * D_STATE], axis=-1)
    xs = xs.reshape(b, l, SSD_GROUPS, SSD_HPG, SSD_HEADDIM)
    bm = bm.reshape(b, l, SSD_GROUPS, D_STATE)
    cm = cm.reshape(b, l, SSD_GROUPS, D_STATE)
    dt_f = jax.nn.softplus(dtf + dt_bias_f).reshape(b, l, SSD_GROUPS, SSD_HPG)
    dt_b = jax.nn.softplus(dtb + dt_bias_b).reshape(b, l, SSD_GROUPS, SSD_HPG)
    return xs, bm, cm, dt_f, dt_b


def gated_group_rmsnorm(y, z, w):
    b, l = z.shape[:2]
    g = (y.reshape(b, l, SSD_INNER) * jax.nn.silu(z)).reshape(b, l, SSD_GROUPS, SSD_INNER // SSD_GROUPS)
    gf = g.astype(jnp.float32)
    gn = gf * lax.rsqrt(jnp.mean(gf * gf, axis=-1, keepdims=True) + EPS)
    return (gn.reshape(b, l, SSD_INNER) * w.astype(jnp.float32)).astype(z.dtype)


def hybrid_mixer(h, hc, cos, sin, lam_init, with_ctx_out, w_in, q_norm_w, k_norm_w,
                 lq1, lk1, lq2, lk2, subln_w, conv_w, conv_b, dt_bias_f, dt_bias_b,
                 a_log_f, a_log_b, d_skip, ssd_norm_w, w_out):
    b, n, _ = h.shape
    m = hc.shape[1]
    q, k, v, z, xbc, dtf, dtb = split_proj(h @ w_in)
    qc, kc, vc, zc, xbcc, dtfc, dtbc = split_proj(hc @ w_in)

    heads = lambda t, w: rmsnorm(t.reshape(t.shape[0], t.shape[1], ATTN_HEADS, 2, HEAD_DIM), w)
    q = apply_rope(heads(q, q_norm_w), cos, sin)
    k = apply_rope(heads(k, k_norm_w), cos, sin)
    qc = heads(qc, q_norm_w)
    kc = heads(kc, k_norm_w)
    v = v.reshape(b, n, ATTN_HEADS, ATTN_VDIM)
    vc = vc.reshape(b, m, ATTN_HEADS, ATTN_VDIM)
    f32 = jnp.float32
    lam = (jnp.exp(jnp.sum(lq1.astype(f32) * lk1.astype(f32)))
           - jnp.exp(jnp.sum(lq2.astype(f32) * lk2.astype(f32))) + lam_init)
    k_all = jnp.concatenate([kc, k], axis=1)
    v_all = jnp.concatenate([vc, v], axis=1)
    nblk = n // Q_BLOCK
    qb = jnp.moveaxis(q.reshape(b, nblk, Q_BLOCK, ATTN_HEADS, 2, HEAD_DIM), 1, 0)
    ob = lax.map(lambda qq: diff_attend(qq, k_all, v_all, lam), qb)
    o = jnp.moveaxis(ob, 0, 1).reshape(b, n, ATTN_HEADS, ATTN_VDIM)
    attn = (rmsnorm(o, subln_w) * (1.0 - lam_init)).reshape(b, n, ATTN_WIDTH)

    a_f = -jnp.exp(a_log_f.astype(f32)).reshape(SSD_GROUPS, SSD_HPG)
    a_b = -jnp.exp(a_log_b.astype(f32)).reshape(SSD_GROUPS, SSD_HPG)
    d_res = d_skip.reshape(SSD_GROUPS, SSD_HPG, 1)
    xs_c, bm_c, cm_c, dtf_c, dtb_c = ssd_inputs(xbcc, dtfc, dtbc, conv_w, conv_b, dt_bias_f, dt_bias_b)
    h0 = jnp.zeros((b, SSD_GROUPS, SSD_HPG, SSD_HEADDIM, D_STATE), f32)
    y_c, hf_c, hb_c = ssd_bidirectional(xs_c, bm_c, cm_c, dtf_c, dtb_c, a_f, a_b, h0, h0)
    xs, bm, cm, dt_f, dt_b = ssd_inputs(xbc, dtf, dtb, conv_w, conv_b, dt_bias_f, dt_bias_b)
    y, _, _ = ssd_bidirectional(xs, bm, cm, dt_f, dt_b, a_f, a_b, hf_c, hb_c)
    ssd = gated_group_rmsnorm(y + d_res * xs, z, ssd_norm_w)

    mix_lat = jnp.concatenate([attn, ssd], axis=-1) @ w_out
    if not with_ctx_out:
        return mix_lat, None
    oc = diff_attend(qc, kc, vc, lam)
    attn_c = (rmsnorm(oc, subln_w) * (1.0 - lam_init)).reshape(b, m, ATTN_WIDTH)
    ssd_c = gated_group_rmsnorm(y_c + d_res * xs_c, zc, ssd_norm_w)
    mix_ctx = jnp.concatenate([attn_c, ssd_c], axis=-1) @ w_out
    return mix_lat, mix_ctx


def expert_choice_ffn(h, w_router, w_gate, w_up, w_down):
    b, n, d = h.shape
    cap = EC_CAPACITY * n // N_EXPERTS
    aff = jax.nn.softmax(jnp.einsum("bnd,de->ben", h, w_router).astype(jnp.float32), axis=1)
    gate, idx = lax.top_k(aff, cap)
    xe = jax.vmap(lambda hb, ib: hb[ib])(h, idx)
    hid = jax.nn.silu(jnp.einsum("becd,edf->becf", xe, w_gate)) * jnp.einsum("becd,edf->becf", xe, w_up)
    ye = jnp.einsum("becf,efd->becd", hid, w_down) * gate[..., None].astype(h.dtype)
    return jax.vmap(lambda ib, yb: jnp.zeros((n, d), yb.dtype).at[ib.reshape(-1)].add(yb.reshape(-1, d)))(idx, ye)


def setup_inputs(seed: int = 0) -> dict:
    key = jax.random.key(seed)
    ks = jax.random.split(key, 32)
    f32 = jnp.float32
    L = DEPTH
    nrm = lambda k, shape, scale: jax.random.normal(k, shape, f32) * scale
    gain = lambda k, shape: 1.0 + 0.02 * jax.random.normal(k, shape, f32)

    def dt_bias(k):
        dt0 = jnp.exp(jax.random.uniform(k, (L, SSD_HEADS), f32, math.log(1e-3), math.log(1e-1)))
        return dt0 + jnp.log(-jnp.expm1(-dt0))

    return {
        "x": nrm(ks[0], (BATCH, SEQ, D_MODEL), 1.0),
        "c": nrm(ks[1], (BATCH, D_MODEL), 1.0),
        "ctx": nrm(ks[2], (BATCH, CTX_LEN, D_MODEL), 1.0),
        "c_ctx": nrm(ks[3], (D_MODEL,), 1.0),
        "w_mod": nrm(ks[4], (L, D_MODEL, N_MOD * D_MODEL), 0.5 * D_MODEL ** -0.5),
        "b_mod": nrm(ks[5], (L, N_MOD * D_MODEL), 0.02),
        "norm1_w": gain(ks[6], (L, D_MODEL)),
        "norm2_w": gain(ks[7], (L, D_MODEL)),
        "w_in": nrm(ks[8], (L, D_MODEL, P_IN), D_MODEL ** -0.5),
        "q_norm_w": gain(ks[9], (L, HEAD_DIM)),
        "k_norm_w": gain(ks[10], (L, HEAD_DIM)),
        "lambda_q1": nrm(ks[11], (L, HEAD_DIM), 0.1),
        "lambda_k1": nrm(ks[12], (L, HEAD_DIM), 0.1),
        "lambda_q2": nrm(ks[13], (L, HEAD_DIM), 0.1),
        "lambda_k2": nrm(ks[14], (L, HEAD_DIM), 0.1),
        "subln_w": gain(ks[15], (L, ATTN_VDIM)),
        "conv_w": nrm(ks[16], (L, D_CONV, CONV_DIM), D_CONV ** -0.5),
        "conv_b": nrm(ks[17], (L, CONV_DIM), 0.02),
        "dt_bias_f": dt_bias(ks[18]),
        "dt_bias_b": dt_bias(ks[19]),
        "a_log_f": jnp.log(jax.random.uniform(ks[20], (L, SSD_HEADS), f32, 1.0, 16.0)),
        "a_log_b": jnp.log(jax.random.uniform(ks[21], (L, SSD_HEADS), f32, 1.0, 16.0)),
        "d_skip": gain(ks[22], (L, SSD_HEADS)),
        "ssd_norm_w": gain(ks[23], (L, SSD_INNER)),
        "w_out": nrm(ks[24], (L, MIX_WIDTH, D_MODEL), MIX_WIDTH ** -0.5),
        "w_router": nrm(ks[25], (L, D_MODEL, N_EXPERTS), D_MODEL ** -0.5),
        "w_gate": nrm(ks[26], (L, N_EXPERTS, D_MODEL, D_EXPERT), D_MODEL ** -0.5),
        "w_up": nrm(ks[27], (L, N_EXPERTS, D_MODEL, D_EXPERT), D_MODEL ** -0.5),
        "w_down": nrm(ks[28], (L, N_EXPERTS, D_EXPERT, D_MODEL), D_EXPERT ** -0.5),
    }


def reference(x, c, ctx, c_ctx, w_mod, b_mod, norm1_w, norm2_w, w_in, q_norm_w, k_norm_w,
              lambda_q1, lambda_k1, lambda_q2, lambda_k2, subln_w, conv_w, conv_b,
              dt_bias_f, dt_bias_b, a_log_f, a_log_b, d_skip, ssd_norm_w, w_out,
              w_router, w_gate, w_up, w_down):
    n = x.shape[1]
    cos, sin = axial_rope_tables(n)
    silu_c = jax.nn.silu(c)
    silu_cc = jax.nn.silu(c_ctx)
    x_lat, x_ctx = x, ctx
    for l in range(DEPTH):
        update_ctx = l < DEPTH - 1
        lam_init = 0.8 - 0.6 * math.exp(-0.3 * l)
        mod = silu_c @ w_mod[l] + b_mod[l]
        sh1, sc1, g1, sh2, sc2, g2 = jnp.split(mod[:, None, :], N_MOD, axis=-1)
        modc = silu_cc @ w_mod[l] + b_mod[l]
        sh1c, sc1c, g1c, sh2c, sc2c, g2c = jnp.split(modc, N_MOD, axis=-1)

        h = rmsnorm(x_lat, norm1_w[l]) * (1.0 + sc1) + sh1
        hc = rmsnorm(x_ctx, norm1_w[l]) * (1.0 + sc1c) + sh1c
        mix_lat, mix_ctx = hybrid_mixer(
            h, hc, cos, sin, lam_init, update_ctx, w_in[l], q_norm_w[l], k_norm_w[l],
            lambda_q1[l], lambda_k1[l], lambda_q2[l], lambda_k2[l], subln_w[l], conv_w[l], conv_b[l],
            dt_bias_f[l], dt_bias_b[l], a_log_f[l], a_log_b[l], d_skip[l], ssd_norm_w[l], w_out[l])
        x_lat = x_lat + g1 * mix_lat

        h2 = rmsnorm(x_lat, norm2_w[l]) * (1.0 + sc2) + sh2
        x_lat = x_lat + g2 * expert_choice_ffn(h2, w_router[l], w_gate[l], w_up[l], w_down[l])
        if update_ctx:
            x_ctx = x_ctx + g1c * mix_ctx
            hc2 = rmsnorm(x_ctx, norm2_w[l]) * (1.0 + sc2c) + sh2c
            x_ctx = x_ctx + g2c * expert_choice_ffn(hc2, w_router[l], w_gate[l], w_up[l], w_down[l])
    return x_lat
```

```cpp
#include <hip/hip_runtime.h>
#include <cstdio>
#include <cstdint>
#include <cmath>

#define LAS __attribute__((address_space(3)))
#define GAS __attribute__((address_space(1)))

namespace pg8 {
#define PG8_LAS __attribute__((address_space(3)))
typedef unsigned short bf16_t;
typedef short bf16x8 __attribute__((ext_vector_type(8)));
typedef float f32x4 __attribute__((ext_vector_type(4)));
typedef unsigned u32x4 __attribute__((ext_vector_type(4)));
typedef int i32x4 __attribute__((ext_vector_type(4)));
constexpr int BM = 256, BK = 64, HALF = 128, HTB = HALF * BK * 2  , STAGE_BYTES = 8 * HTB, NXCD = 8, WGM = 8;

__host__ __device__ __forceinline__ int lds_byte(int r, int c) { const int st = (r >> 4) * 2 + (c >> 5), rr = r & 15, cc = c & 31, ob = rr * 64 + cc * 2; return st * 1024 + (ob ^ (((ob >> 9) & 1) << 5)); }
__host__ __device__ __forceinline__ void stage_rc(int b, int& R, int& C) { const int st = b / 1024, sb = b % 1024, swz = sb ^ (((sb >> 9) & 1) << 5); R = (st >> 1) * 16 + swz / 64; C = (st & 1) * 32 + (swz % 64) / 2; }
__host__ __device__ __forceinline__ int perm32(int rho) { const int n = rho >> 4, i = rho & 15; return 8 * (i >> 2) + 4 * n + (i & 3); }

struct Unit { int pm, pn; };
struct Gemm { const bf16_t* A; const bf16_t* Bt; int M, N, K; };

struct StaticOrder {
    int nM, nN, nwg, G, c;
    __host__ __device__ void init(int M, int N, int G_, int c_) { nM = M / BM; nN = N / BM; nwg = nM * nN; G = G_; c = c_; }
    __host__ __device__ bool next(int i, Unit& u) const {
        const long L = (long)i * G + c; if (L >= nwg) return false;
        int wgid = (int)L; { const int q = nwg / NXCD, r = nwg % NXCD, xcd = wgid % NXCD, off = wgid / NXCD; wgid = (xcd < r ? xcd * (q + 1) : r * (q + 1) + (xcd - r) * q) + off; }
        const int nig = WGM * nN, gid = wgid / nig, fm = gid * WGM, gsz = (nM - fm) < WGM ? (nM - fm) : WGM;
        u.pm = fm + ((wgid % nig) % gsz); u.pn = (wgid % nig) / gsz; return true;
    }
    __device__ __forceinline__ void a_ready(const Unit&) const {}
    __device__ __forceinline__ void done(const Unit&) const {}
};

template <class Epi, class Sched, bool ALIGN_EPI = false, bool SP2 = false>
__device__ __forceinline__ void gemm_phase(PG8_LAS unsigned char* lds, const Gemm g, const Sched& S, const Epi& E, const int tid_arg) {
    int tid_ = tid_arg; asm volatile("" : "+v"(tid_));
    const int tid = tid_, wid = __builtin_amdgcn_readfirstlane(tid >> 6), lane = tid & 63, wr = wid >> 2, wc = wid & 3, fr = lane & 15, fq = lane >> 4;
    const int K = g.K, nt = K / BK;
    unsigned voffA[2], voffB[2];
#pragma unroll
    for (int i = 0; i < 2; ++i) { int R, C; stage_rc(tid * 16 + i * 8192, R, C); const int Rb = Epi::PERM ? ((R & ~31) + perm32(R & 31)) : R;
        voffA[i] = (unsigned)(R * K + C) * 2u; voffB[i] = (unsigned)(Rb * K + C) * 2u; }
    const size_t kstep = (size_t)(BK * 2);
    const size_t hstep = (size_t)HALF * K * 2;
    const size_t tstep = 2 * hstep;
    const unsigned ldsw = (unsigned)wid * 1024u;
    const int aoff = lds_byte(wr * 64 + fr, fq * 8), boff = lds_byte(wc * 32 + fr, fq * 8);
#define PG8_SA(b, h) (((b) * 2 + (h)) * HTB)
#define PG8_SB(b, h) ((4 + (b) * 2 + (h)) * HTB)
#define PG8_STAGE(bufoff, gbase, voff) do { _Pragma("unroll") for (int _i = 0; _i < 2; ++_i) \
        __builtin_amdgcn_global_load_lds((const unsigned*)((const char*)(gbase) + (voff)[_i]), (PG8_LAS unsigned*)(lds + (bufoff) + ldsw + _i * 8192), 16, 0, 0); } while (0)
#define PG8_LDA(dst, b, h) do { _Pragma("unroll") for (int m = 0; m < 4; ++m) _Pragma("unroll") for (int k = 0; k < 2; ++k) dst[m][k] = *(const PG8_LAS bf16x8*)(lds + PG8_SA(b, h) + aoff + m * 2048 + k * 1024); } while (0)
#define PG8_LDB(dst, b, h) do { _Pragma("unroll") for (int n = 0; n < 2; ++n) _Pragma("unroll") for (int k = 0; k < 2; ++k) dst[n][k] = *(const PG8_LAS bf16x8*)(lds + PG8_SB(b, h) + boff + n * 2048 + k * 1024); } while (0)
#define PG8_MMA(ai, bj, At, Bt) do { __builtin_amdgcn_s_setprio(1); _Pragma("unroll") for (int m = 0; m < 4; ++m) _Pragma("unroll") for (int n = 0; n < 2; ++n) _Pragma("unroll") for (int k = 0; k < 2; ++k) \
        acc[ai][bj][m][n] = __builtin_amdgcn_mfma_f32_16x16x32_bf16(Bt[n][k], At[m][k], acc[ai][bj][m][n], 0, 0, 0); __builtin_amdgcn_s_setprio(0); } while (0)
#define PG8_WAIT_V(n) asm volatile("s_waitcnt vmcnt(" #n ")" ::: "memory")
#define PG8_WAIT_L(n) asm volatile("s_waitcnt lgkmcnt(" #n ")" ::: "memory")
#define PG8_BAR __builtin_amdgcn_s_barrier()
#define PG8_SCHED __builtin_amdgcn_sched_barrier(0)
    Unit cur, nxt; int ui = 0;
    if (!S.next(0, cur)) return;
    f32x4 acc[2][2][4][2];
#pragma unroll
    for (int a = 0; a < 2; ++a)
#pragma unroll
        for (int b = 0; b < 2; ++b)
#pragma unroll
            for (int m = 0; m < 4; ++m)
#pragma unroll
                for (int n = 0; n < 2; ++n) acc[a][b][m][n] = (f32x4){0.f, 0.f, 0.f, 0.f};
    bf16x8 At[4][2], B0[2][2], B1[2][2];
    const char* cA = (const char*)g.A + (size_t)cur.pm * tstep; const char* cB = (const char*)g.Bt + (size_t)cur.pn * tstep;
    S.a_ready(cur);
    if constexpr (SP2) {
        PG8_STAGE(PG8_SB(0, 0), cB, voffB); PG8_STAGE(PG8_SB(0, 1), cB + hstep, voffB); PG8_STAGE(PG8_SA(0, 0), cA, voffA); PG8_STAGE(PG8_SA(0, 1), cA + hstep, voffA);
        if (wr == 1) PG8_BAR;
        PG8_WAIT_V(2); PG8_BAR;
        PG8_STAGE(PG8_SB(1, 0), cB + kstep, voffB); PG8_STAGE(PG8_SA(1, 0), cA + kstep, voffA); PG8_STAGE(PG8_SB(1, 1), cB + hstep + kstep, voffB);
        PG8_WAIT_V(6); PG8_BAR;
    } else {
        PG8_STAGE(PG8_SB(0, 0), cB, voffB); PG8_STAGE(PG8_SA(0, 0), cA, voffA); PG8_STAGE(PG8_SB(0, 1), cB + hstep, voffB); PG8_STAGE(PG8_SA(0, 1), cA + hstep, voffA);
        if (wr == 1) PG8_BAR;
        PG8_WAIT_V(4); PG8_BAR;
        PG8_STAGE(PG8_SB(1, 0), cB + kstep, voffB); PG8_STAGE(PG8_SA(1, 0), cA + kstep, voffA); PG8_STAGE(PG8_SB(1, 1), cB + hstep + kstep, voffB);
        PG8_WAIT_V(6); PG8_BAR;
    }
    for (;;) {
        const bool has_next = S.next(ui + 1, nxt);
        const char* nA = has_next ? (const char*)g.A + (size_t)nxt.pm * tstep : cA; const char* nB = has_next ? (const char*)g.Bt + (size_t)nxt.pn * tstep : cB;
        for (int t = 0; t < nt; t += 2) {
            const bool last = (t == nt - 2);
            const char* a1 = cA + (size_t)(t + 1) * kstep;
            const char* a2 = last ? nA : cA + (size_t)(t + 2) * kstep; const char* b2 = last ? nB : cB + (size_t)(t + 2) * kstep;
            const char* a3 = a2 + kstep; const char* b3 = b2 + kstep;
            if (last && has_next) S.a_ready(nxt);
            if constexpr (SP2) {
            PG8_LDB(B0, 0, 0); PG8_LDB(B1, 0, 1); PG8_SCHED; PG8_LDA(At, 0, 0); PG8_STAGE(PG8_SA(1, 1), a1 + hstep, voffA);
            PG8_WAIT_V(8); PG8_WAIT_L(0); PG8_BAR; PG8_MMA(0, 0, At, B0); PG8_MMA(0, 1, At, B1); PG8_BAR; PG8_SCHED;
            PG8_LDA(At, 0, 1); PG8_STAGE(PG8_SB(0, 0), b2, voffB); PG8_STAGE(PG8_SB(0, 1), b2 + hstep, voffB); PG8_STAGE(PG8_SA(0, 0), a2, voffA);
            PG8_WAIT_V(8); PG8_WAIT_L(0); PG8_BAR; PG8_MMA(1, 0, At, B0); PG8_MMA(1, 1, At, B1); PG8_BAR; PG8_SCHED;
            PG8_LDB(B0, 1, 0); PG8_LDB(B1, 1, 1); PG8_SCHED; PG8_LDA(At, 1, 0); PG8_STAGE(PG8_SA(0, 1), a2 + hstep, voffA);
            PG8_WAIT_V(8); PG8_WAIT_L(0); PG8_BAR; PG8_MMA(0, 0, At, B0); PG8_MMA(0, 1, At, B1); PG8_BAR; PG8_SCHED;
            PG8_LDA(At, 1, 1); PG8_STAGE(PG8_SB(1, 0), b3, voffB); PG8_STAGE(PG8_SB(1, 1), b3 + hstep, voffB); PG8_STAGE(PG8_SA(1, 0), a3, voffA);
            PG8_WAIT_V(8); PG8_WAIT_L(0); PG8_BAR; PG8_MMA(1, 0, At, B0); PG8_MMA(1, 1, At, B1); PG8_BAR; PG8_SCHED;
            } else {
            PG8_LDB(B0, 0, 0); PG8_SCHED; PG8_LDA(At, 0, 0); PG8_STAGE(PG8_SA(1, 1), a1 + hstep, voffA);
            PG8_WAIT_L(8); PG8_BAR; PG8_WAIT_L(0); PG8_MMA(0, 0, At, B0); PG8_BAR; PG8_SCHED;
            PG8_LDB(B1, 0, 1); PG8_STAGE(PG8_SB(0, 0), b2, voffB);
            PG8_BAR; PG8_WAIT_L(0); PG8_MMA(0, 1, At, B1); PG8_BAR;
            PG8_LDA(At, 0, 1); PG8_STAGE(PG8_SA(0, 0), a2, voffA);
            PG8_BAR; PG8_WAIT_L(0); PG8_MMA(1, 0, At, B0); PG8_BAR; PG8_SCHED;
            PG8_STAGE(PG8_SB(0, 1), b2 + hstep, voffB);
            PG8_WAIT_V(6); PG8_BAR; PG8_MMA(1, 1, At, B1); PG8_BAR;
            PG8_LDB(B0, 1, 0); PG8_SCHED; PG8_LDA(At, 1, 0); PG8_STAGE(PG8_SA(0, 1), a2 + hstep, voffA);
            PG8_WAIT_L(8); PG8_BAR; PG8_WAIT_L(0); PG8_MMA(0, 0, At, B0); PG8_BAR; PG8_SCHED;
            PG8_LDB(B1, 1, 1); PG8_STAGE(PG8_SB(1, 0), b3, voffB);
            PG8_BAR; PG8_WAIT_L(0); PG8_MMA(0, 1, At, B1); PG8_BAR;
            PG8_LDA(At, 1, 1); PG8_STAGE(PG8_SA(1, 0), a3, voffA);
            PG8_BAR; PG8_WAIT_L(0); PG8_MMA(1, 0, At, B0); PG8_BAR; PG8_SCHED;
            PG8_STAGE(PG8_SB(1, 1), b3 + hstep, voffB);
            PG8_WAIT_V(6); PG8_BAR; PG8_MMA(1, 1, At, B1); PG8_BAR;
            }
        }
        if constexpr (ALIGN_EPI) { if (wr == 0) PG8_BAR; }
        if constexpr (!Epi::AFTER_DRAIN) { E(acc, cur, wr, wc, fr, fq); S.done(cur); }
        if (!has_next) break;
#pragma unroll
        for (int a = 0; a < 2; ++a)
#pragma unroll
            for (int b = 0; b < 2; ++b)
#pragma unroll
                for (int m = 0; m < 4; ++m)
#pragma unroll
                    for (int n = 0; n < 2; ++n) acc[a][b][m][n] = (f32x4){0.f, 0.f, 0.f, 0.f};
        cur = nxt; cA = nA; cB = nB; ++ui;
        if constexpr (ALIGN_EPI) { if (wr == 1) PG8_BAR; }
    }
    PG8_WAIT_V(0);
    if constexpr (!ALIGN_EPI) { if (wr == 0) PG8_BAR; }
    PG8_BAR;
    if constexpr (Epi::AFTER_DRAIN) { E.fused(acc, cur, wr, wc, fr, fq, lds, wid, lane); S.done(cur); }
#undef PG8_SA
#undef PG8_SB
#undef PG8_STAGE
#undef PG8_LDA
#undef PG8_LDB
#undef PG8_MMA
#undef PG8_WAIT_V
#undef PG8_WAIT_L
#undef PG8_BAR
#undef PG8_SCHED
}template <class Epi, class Sched, bool ALIGN_EPI = false, bool SP2 = false>
__device__ __forceinline__ void gemm_phase_gather(PG8_LAS unsigned char* lds, const Gemm g, const Sched& S, const Epi& E, const int tid_arg, const unsigned* __restrict__ rowoff) {
    int tid_ = tid_arg; asm volatile("" : "+v"(tid_));
    const int tid = tid_, wid = __builtin_amdgcn_readfirstlane(tid >> 6), lane = tid & 63, wr = wid >> 2, wc = wid & 3, fr = lane & 15, fq = lane >> 4;
    const int K = g.K, nt = K / BK;
    unsigned voffA[2], voffB[2]; int rA[2]; unsigned cAoff[2];
#pragma unroll
    for (int i = 0; i < 2; ++i) { int R, C; stage_rc(tid * 16 + i * 8192, R, C); const int Rb = Epi::PERM ? ((R & ~31) + perm32(R & 31)) : R;
        voffA[i] = (unsigned)(R * K + C) * 2u; voffB[i] = (unsigned)(Rb * K + C) * 2u; rA[i] = R; cAoff[i] = (unsigned)C * 2u; }
    const size_t kstep = (size_t)(BK * 2);
    const size_t hstep = (size_t)HALF * K * 2;
    const size_t tstep = 2 * hstep;
    const unsigned ldsw = (unsigned)wid * 1024u;
    const int aoff = lds_byte(wr * 64 + fr, fq * 8), boff = lds_byte(wc * 32 + fr, fq * 8);
#define PG8_SA(b, h) (((b) * 2 + (h)) * HTB)
#define PG8_SB(b, h) ((4 + (b) * 2 + (h)) * HTB)
#define PG8_STAGE(bufoff, gbase, voff) do { _Pragma("unroll") for (int _i = 0; _i < 2; ++_i) \
        __builtin_amdgcn_global_load_lds((const unsigned*)((const char*)(gbase) + (voff)[_i]), (PG8_LAS unsigned*)(lds + (bufoff) + ldsw + _i * 8192), 16, 0, 0); } while (0)
#define PG8_LDA(dst, b, h) do { _Pragma("unroll") for (int m = 0; m < 4; ++m) _Pragma("unroll") for (int k = 0; k < 2; ++k) dst[m][k] = *(const PG8_LAS bf16x8*)(lds + PG8_SA(b, h) + aoff + m * 2048 + k * 1024); } while (0)
#define PG8_LDB(dst, b, h) do { _Pragma("unroll") for (int n = 0; n < 2; ++n) _Pragma("unroll") for (int k = 0; k < 2; ++k) dst[n][k] = *(const PG8_LAS bf16x8*)(lds + PG8_SB(b, h) + boff + n * 2048 + k * 1024); } while (0)
#define PG8_MMA(ai, bj, At, Bt) do { __builtin_amdgcn_s_setprio(1); _Pragma("unroll") for (int m = 0; m < 4; ++m) _Pragma("unroll") for (int n = 0; n < 2; ++n) _Pragma("unroll") for (int k = 0; k < 2; ++k) \
        acc[ai][bj][m][n] = __builtin_amdgcn_mfma_f32_16x16x32_bf16(Bt[n][k], At[m][k], acc[ai][bj][m][n], 0, 0, 0); __builtin_amdgcn_s_setprio(0); } while (0)
#define PG8_WAIT_V(n) asm volatile("s_waitcnt vmcnt(" #n ")" ::: "memory")
#define PG8_WAIT_L(n) asm volatile("s_waitcnt lgkmcnt(" #n ")" ::: "memory")
#define PG8_BAR __builtin_amdgcn_s_barrier()
#define PG8_SCHED __builtin_amdgcn_sched_barrier(0)
    Unit cur, nxt; int ui = 0;
    if (!S.next(0, cur)) return;
    f32x4 acc[2][2][4][2];
#pragma unroll
    for (int a = 0; a < 2; ++a)
#pragma unroll
        for (int b = 0; b < 2; ++b)
#pragma unroll
            for (int m = 0; m < 4; ++m)
#pragma unroll
                for (int n = 0; n < 2; ++n) acc[a][b][m][n] = (f32x4){0.f, 0.f, 0.f, 0.f};
    bf16x8 At[4][2], B0[2][2], B1[2][2];
    const char* cA = (const char*)g.A; const char* cB = (const char*)g.Bt + (size_t)cur.pn * tstep;
    unsigned v0[2], v1[2], n0[2], n1[2];
#define PG8_LOADOFF(D0, D1, PM) do { _Pragma("unroll") for (int _i = 0; _i < 2; ++_i) { D0[_i] = rowoff[256 * (PM) + rA[_i]] + cAoff[_i]; D1[_i] = rowoff[256 * (PM) + 128 + rA[_i]] + cAoff[_i]; } } while (0)
    PG8_LOADOFF(v0, v1, cur.pm);
#pragma unroll
    for (int _i = 0; _i < 2; ++_i) { n0[_i] = v0[_i]; n1[_i] = v1[_i]; }
    S.a_ready(cur);
    if constexpr (SP2) {
        PG8_STAGE(PG8_SB(0, 0), cB, voffB); PG8_STAGE(PG8_SB(0, 1), cB + hstep, voffB); PG8_STAGE(PG8_SA(0, 0), cA, v0); PG8_STAGE(PG8_SA(0, 1), cA, v1);
        if (wr == 1) PG8_BAR;
        PG8_WAIT_V(2); PG8_BAR;
        PG8_STAGE(PG8_SB(1, 0), cB + kstep, voffB); PG8_STAGE(PG8_SA(1, 0), cA + kstep, v0); PG8_STAGE(PG8_SB(1, 1), cB + hstep + kstep, voffB);
        PG8_WAIT_V(6); PG8_BAR;
    } else {
        PG8_STAGE(PG8_SB(0, 0), cB, voffB); PG8_STAGE(PG8_SA(0, 0), cA, v0); PG8_STAGE(PG8_SB(0, 1), cB + hstep, voffB); PG8_STAGE(PG8_SA(0, 1), cA, v1);
        if (wr == 1) PG8_BAR;
        PG8_WAIT_V(4); PG8_BAR;
        PG8_STAGE(PG8_SB(1, 0), cB + kstep, voffB); PG8_STAGE(PG8_SA(1, 0), cA + kstep, v0); PG8_STAGE(PG8_SB(1, 1), cB + hstep + kstep, voffB);
        PG8_WAIT_V(6); PG8_BAR;
    }
    for (;;) {
        const bool has_next = S.next(ui + 1, nxt);
        if (has_next) PG8_LOADOFF(n0, n1, nxt.pm);
        const char* nA = cA; const char* nB = has_next ? (const char*)g.Bt + (size_t)nxt.pn * tstep : cB;
        for (int t = 0; t < nt; t += 2) {
            const bool last = (t == nt - 2);
            const char* a1 = cA + (size_t)(t + 1) * kstep;
            const char* a2 = last ? nA : cA + (size_t)(t + 2) * kstep; const char* b2 = last ? nB : cB + (size_t)(t + 2) * kstep;
            const char* a3 = a2 + kstep; const char* b3 = b2 + kstep;
            unsigned o2a[2], o2b[2];
#pragma unroll
            for (int _i = 0; _i < 2; ++_i) { o2a[_i] = last ? n0[_i] : v0[_i]; o2b[_i] = last ? n1[_i] : v1[_i]; }
            if (last && has_next) S.a_ready(nxt);
            if constexpr (SP2) {
            PG8_LDB(B0, 0, 0); PG8_LDB(B1, 0, 1); PG8_SCHED; PG8_LDA(At, 0, 0); PG8_STAGE(PG8_SA(1, 1), a1, v1);
            PG8_WAIT_V(8); PG8_WAIT_L(0); PG8_BAR; PG8_MMA(0, 0, At, B0); PG8_MMA(0, 1, At, B1); PG8_BAR; PG8_SCHED;
            PG8_LDA(At, 0, 1); PG8_STAGE(PG8_SB(0, 0), b2, voffB); PG8_STAGE(PG8_SB(0, 1), b2 + hstep, voffB); PG8_STAGE(PG8_SA(0, 0), a2, o2a);
            PG8_WAIT_V(8); PG8_WAIT_L(0); PG8_BAR; PG8_MMA(1, 0, At, B0); PG8_MMA(1, 1, At, B1); PG8_BAR; PG8_SCHED;
            PG8_LDB(B0, 1, 0); PG8_LDB(B1, 1, 1); PG8_SCHED; PG8_LDA(At, 1, 0); PG8_STAGE(PG8_SA(0, 1), a2, o2b);
            PG8_WAIT_V(8); PG8_WAIT_L(0); PG8_BAR; PG8_MMA(0, 0, At, B0); PG8_MMA(0, 1, At, B1); PG8_BAR; PG8_SCHED;
            PG8_LDA(At, 1, 1); PG8_STAGE(PG8_SB(1, 0), b3, voffB); PG8_STAGE(PG8_SB(1, 1), b3 + hstep, voffB); PG8_STAGE(PG8_SA(1, 0), a3, o2a);
            PG8_WAIT_V(8); PG8_WAIT_L(0); PG8_BAR; PG8_MMA(1, 0, At, B0); PG8_MMA(1, 1, At, B1); PG8_BAR; PG8_SCHED;
            } else {
            PG8_LDB(B0, 0, 0); PG8_SCHED; PG8_LDA(At, 0, 0); PG8_STAGE(PG8_SA(1, 1), a1, v1);
            PG8_WAIT_L(8); PG8_BAR; PG8_WAIT_L(0); PG8_MMA(0, 0, At, B0); PG8_BAR; PG8_SCHED;
            PG8_LDB(B1, 0, 1); PG8_STAGE(PG8_SB(0, 0), b2, voffB);
            PG8_BAR; PG8_WAIT_L(0); PG8_MMA(0, 1, At, B1); PG8_BAR;
            PG8_LDA(At, 0, 1); PG8_STAGE(PG8_SA(0, 0), a2, o2a);
            PG8_BAR; PG8_WAIT_L(0); PG8_MMA(1, 0, At, B0); PG8_BAR; PG8_SCHED;
            PG8_STAGE(PG8_SB(0, 1), b2 + hstep, voffB);
            PG8_WAIT_V(6); PG8_BAR; PG8_MMA(1, 1, At, B1); PG8_BAR;
            PG8_LDB(B0, 1, 0); PG8_SCHED; PG8_LDA(At, 1, 0); PG8_STAGE(PG8_SA(0, 1), a2, o2b);
            PG8_WAIT_L(8); PG8_BAR; PG8_WAIT_L(0); PG8_MMA(0, 0, At, B0); PG8_BAR; PG8_SCHED;
            PG8_LDB(B1, 1, 1); PG8_STAGE(PG8_SB(1, 0), b3, voffB);
            PG8_BAR; PG8_WAIT_L(0); PG8_MMA(0, 1, At, B1); PG8_BAR;
            PG8_LDA(At, 1, 1); PG8_STAGE(PG8_SA(1, 0), a3, o2a);
            PG8_BAR; PG8_WAIT_L(0); PG8_MMA(1, 0, At, B0); PG8_BAR; PG8_SCHED;
            PG8_STAGE(PG8_SB(1, 1), b3 + hstep, voffB);
            PG8_WAIT_V(6); PG8_BAR; PG8_MMA(1, 1, At, B1); PG8_BAR;
            }
        }
        if constexpr (ALIGN_EPI) { if (wr == 0) PG8_BAR; }
        if constexpr (!Epi::AFTER_DRAIN) { E(acc, cur, wr, wc, fr, fq); S.done(cur); }
        if (!has_next) break;
#pragma unroll
        for (int a = 0; a < 2; ++a)
#pragma unroll
            for (int b = 0; b < 2; ++b)
#pragma unroll
                for (int m = 0; m < 4; ++m)
#pragma unroll
                    for (int n = 0; n < 2; ++n) acc[a][b][m][n] = (f32x4){0.f, 0.f, 0.f, 0.f};
        cur = nxt; cA = nA; cB = nB; ++ui;
#pragma unroll
        for (int _i = 0; _i < 2; ++_i) { v0[_i] = n0[_i]; v1[_i] = n1[_i]; }
        if constexpr (ALIGN_EPI) { if (wr == 1) PG8_BAR; }
    }
    PG8_WAIT_V(0);
    if constexpr (!ALIGN_EPI) { if (wr == 0) PG8_BAR; }
    PG8_BAR;
    if constexpr (Epi::AFTER_DRAIN) { E.fused(acc, cur, wr, wc, fr, fq, lds, wid, lane); S.done(cur); }
#undef PG8_LOADOFF
#undef PG8_SA
#undef PG8_SB
#undef PG8_STAGE
#undef PG8_LDA
#undef PG8_LDB
#undef PG8_MMA
#undef PG8_WAIT_V
#undef PG8_WAIT_L
#undef PG8_BAR
#undef PG8_SCHED
}template <class Epi, class Sched, bool ALIGN_EPI = false, bool SP2 = false>
__device__ __forceinline__ void gemm_phase_gather_i8(PG8_LAS unsigned char* lds, const Gemm g, const Sched& S, const Epi& E, const int tid_arg, const unsigned* __restrict__ rowoff) {
    int tid_ = tid_arg; asm volatile("" : "+v"(tid_));
    const int tid = tid_, wid = __builtin_amdgcn_readfirstlane(tid >> 6), lane = tid & 63, wr = wid >> 2, wc = wid & 3, fr = lane & 15, fq = lane >> 4;
    const int K = g.K, nt = K / BK;
    unsigned voffA[2], voffB[2]; int rA[2]; unsigned cAoff[2];
#pragma unroll
    for (int i = 0; i < 2; ++i) { int R, C; stage_rc(tid * 16 + i * 8192, R, C); const int Rb = Epi::PERM ? ((R & ~31) + perm32(R & 31)) : R;
        voffA[i] = (unsigned)(R * K + C) * 2u; voffB[i] = (unsigned)(Rb * K + C) * 2u; rA[i] = R; cAoff[i] = (unsigned)C * 2u; }
    const size_t kstep = (size_t)(BK * 2);
    const size_t hstep = (size_t)HALF * K * 2;
    const size_t tstep = 2 * hstep;
    const unsigned ldsw = (unsigned)wid * 1024u;
    const int aoff = lds_byte(wr * 64 + fr, fq * 8), boff = lds_byte(wc * 32 + fr, fq * 8);
#define PG8_SA(b, h) (((b) * 2 + (h)) * HTB)
#define PG8_SB(b, h) ((4 + (b) * 2 + (h)) * HTB)
#define PG8_STAGE(bufoff, gbase, voff) do { _Pragma("unroll") for (int _i = 0; _i < 2; ++_i) \
        __builtin_amdgcn_global_load_lds((const unsigned*)((const char*)(gbase) + (voff)[_i]), (PG8_LAS unsigned*)(lds + (bufoff) + ldsw + _i * 8192), 16, 0, 0); } while (0)
#define PG8_LDA(dst, b, h) do { _Pragma("unroll") for (int m = 0; m < 4; ++m) _Pragma("unroll") for (int k = 0; k < 2; ++k) dst[m][k] = *(const PG8_LAS bf16x8*)(lds + PG8_SA(b, h) + aoff + m * 2048 + k * 1024); } while (0)
#define PG8_LDB(dst, b, h) do { _Pragma("unroll") for (int n = 0; n < 2; ++n) _Pragma("unroll") for (int k = 0; k < 2; ++k) dst[n][k] = *(const PG8_LAS bf16x8*)(lds + PG8_SB(b, h) + boff + n * 2048 + k * 1024); } while (0)
#define PG8_MMA(ai, bj, At, Bt) do { __builtin_amdgcn_s_setprio(1); _Pragma("unroll") for (int m = 0; m < 4; ++m) _Pragma("unroll") for (int n = 0; n < 2; ++n) _Pragma("unroll") for (int k = 0; k < 2; ++k) \
        acc[ai][bj][m][n] = __builtin_amdgcn_mfma_i32_16x16x64_i8(__builtin_bit_cast(i32x4, Bt[n][k]), __builtin_bit_cast(i32x4, At[m][k]), acc[ai][bj][m][n], 0, 0, 0); __builtin_amdgcn_s_setprio(0); } while (0)
#define PG8_WAIT_V(n) asm volatile("s_waitcnt vmcnt(" #n ")" ::: "memory")
#define PG8_WAIT_L(n) asm volatile("s_waitcnt lgkmcnt(" #n ")" ::: "memory")
#define PG8_BAR __builtin_amdgcn_s_barrier()
#define PG8_SCHED __builtin_amdgcn_sched_barrier(0)
    Unit cur, nxt; int ui = 0;
    if (!S.next(0, cur)) return;
    i32x4 acc[2][2][4][2];
#pragma unroll
    for (int a = 0; a < 2; ++a)
#pragma unroll
        for (int b = 0; b < 2; ++b)
#pragma unroll
            for (int m = 0; m < 4; ++m)
#pragma unroll
                for (int n = 0; n < 2; ++n) acc[a][b][m][n] = (i32x4){0, 0, 0, 0};
    bf16x8 At[4][2], B0[2][2], B1[2][2];
    const char* cA = (const char*)g.A; const char* cB = (const char*)g.Bt + (size_t)cur.pn * tstep;
    unsigned v0[2], v1[2], n0[2], n1[2];
#define PG8_LOADOFF(D0, D1, PM) do { _Pragma("unroll") for (int _i = 0; _i < 2; ++_i) { D0[_i] = rowoff[256 * (PM) + rA[_i]] + cAoff[_i]; D1[_i] = rowoff[256 * (PM) + 128 + rA[_i]] + cAoff[_i]; } } while (0)
    PG8_LOADOFF(v0, v1, cur.pm);
#pragma unroll
    for (int _i = 0; _i < 2; ++_i) { n0[_i] = v0[_i]; n1[_i] = v1[_i]; }
    S.a_ready(cur);
    if constexpr (SP2) {
        PG8_STAGE(PG8_SB(0, 0), cB, voffB); PG8_STAGE(PG8_SB(0, 1), cB + hstep, voffB); PG8_STAGE(PG8_SA(0, 0), cA, v0); PG8_STAGE(PG8_SA(0, 1), cA, v1);
        if (wr == 1) PG8_BAR;
        PG8_WAIT_V(2); PG8_BAR;
        PG8_STAGE(PG8_SB(1, 0), cB + kstep, voffB); PG8_STAGE(PG8_SA(1, 0), cA + kstep, v0); PG8_STAGE(PG8_SB(1, 1), cB + hstep + kstep, voffB);
        PG8_WAIT_V(6); PG8_BAR;
    } else {
        PG8_STAGE(PG8_SB(0, 0), cB, voffB); PG8_STAGE(PG8_SA(0, 0), cA, v0); PG8_STAGE(PG8_SB(0, 1), cB + hstep, voffB); PG8_STAGE(PG8_SA(0, 1), cA, v1);
        if (wr == 1) PG8_BAR;
        PG8_WAIT_V(4); PG8_BAR;
        PG8_STAGE(PG8_SB(1, 0), cB + kstep, voffB); PG8_STAGE(PG8_SA(1, 0), cA + kstep, v0); PG8_STAGE(PG8_SB(1, 1), cB + hstep + kstep, voffB);
        PG8_WAIT_V(6); PG8_BAR;
    }
    for (;;) {
        const bool has_next = S.next(ui + 1, nxt);
        if (has_next) PG8_LOADOFF(n0, n1, nxt.pm);
        const char* nA = cA; const char* nB = has_next ? (const char*)g.Bt + (size_t)nxt.pn * tstep : cB;
        for (int t = 0; t < nt; t += 2) {
            const bool last = (t == nt - 2);
            const char* a1 = cA + (size_t)(t + 1) * kstep;
            const char* a2 = last ? nA : cA + (size_t)(t + 2) * kstep; const char* b2 = last ? nB : cB + (size_t)(t + 2) * kstep;
            const char* a3 = a2 + kstep; const char* b3 = b2 + kstep;
            unsigned o2a[2], o2b[2];
#pragma unroll
            for (int _i = 0; _i < 2; ++_i) { o2a[_i] = last ? n0[_i] : v0[_i]; o2b[_i] = last ? n1[_i] : v1[_i]; }
            if (last && has_next) S.a_ready(nxt);
            if constexpr (SP2) {
            PG8_LDB(B0, 0, 0); PG8_LDB(B1, 0, 1); PG8_SCHED; PG8_LDA(At, 0, 0); PG8_STAGE(PG8_SA(1, 1), a1, v1);
            PG8_WAIT_V(8); PG8_WAIT_L(0); PG8_BAR; PG8_MMA(0, 0, At, B0); PG8_MMA(0, 1, At, B1); PG8_BAR; PG8_SCHED;
            PG8_LDA(At, 0, 1); PG8_STAGE(PG8_SB(0, 0), b2, voffB); PG8_STAGE(PG8_SB(0, 1), b2 + hstep, voffB); PG8_STAGE(PG8_SA(0, 0), a2, o2a);
            PG8_WAIT_V(8); PG8_WAIT_L(0); PG8_BAR; PG8_MMA(1, 0, At, B0); PG8_MMA(1, 1, At, B1); PG8_BAR; PG8_SCHED;
            PG8_LDB(B0, 1, 0); PG8_LDB(B1, 1, 1); PG8_SCHED; PG8_LDA(At, 1, 0); PG8_STAGE(PG8_SA(0, 1), a2, o2b);
            PG8_WAIT_V(8); PG8_WAIT_L(0); PG8_BAR; PG8_MMA(0, 0, At, B0); PG8_MMA(0, 1, At, B1); PG8_BAR; PG8_SCHED;
            PG8_LDA(At, 1, 1); PG8_STAGE(PG8_SB(1, 0), b3, voffB); PG8_STAGE(PG8_SB(1, 1), b3 + hstep, voffB); PG8_STAGE(PG8_SA(1, 0), a3, o2a);
            PG8_WAIT_V(8); PG8_WAIT_L(0); PG8_BAR; PG8_MMA(1, 0, At, B0); PG8_MMA(1, 1, At, B1); PG8_BAR; PG8_SCHED;
            } else {
            PG8_LDB(B0, 0, 0); PG8_SCHED; PG8_LDA(At, 0, 0); PG8_STAGE(PG8_SA(1, 1), a1, v1);
            PG8_WAIT_L(8); PG8_BAR; PG8_WAIT_L(0); PG8_MMA(0, 0, At, B0); PG8_BAR; PG8_SCHED;
            PG8_LDB(B1, 0, 1); PG8_STAGE(PG8_SB(0, 0), b2, voffB);
            PG8_BAR; PG8_WAIT_L(0); PG8_MMA(0, 1, At, B1); PG8_BAR;
            PG8_LDA(At, 0, 1); PG8_STAGE(PG8_SA(0, 0), a2, o2a);
            PG8_BAR; PG8_WAIT_L(0); PG8_MMA(1, 0, At, B0); PG8_BAR; PG8_SCHED;
            PG8_STAGE(PG8_SB(0, 1), b2 + hstep, voffB);
            PG8_WAIT_V(6); PG8_BAR; PG8_MMA(1, 1, At, B1); PG8_BAR;
            PG8_LDB(B0, 1, 0); PG8_SCHED; PG8_LDA(At, 1, 0); PG8_STAGE(PG8_SA(0, 1), a2, o2b);
            PG8_WAIT_L(8); PG8_BAR; PG8_WAIT_L(0); PG8_MMA(0, 0, At, B0); PG8_BAR; PG8_SCHED;
            PG8_LDB(B1, 1, 1); PG8_STAGE(PG8_SB(1, 0), b3, voffB);
            PG8_BAR; PG8_WAIT_L(0); PG8_MMA(0, 1, At, B1); PG8_BAR;
            PG8_LDA(At, 1, 1); PG8_STAGE(PG8_SA(1, 0), a3, o2a);
            PG8_BAR; PG8_WAIT_L(0); PG8_MMA(1, 0, At, B0); PG8_BAR; PG8_SCHED;
            PG8_STAGE(PG8_SB(1, 1), b3 + hstep, voffB);
            PG8_WAIT_V(6); PG8_BAR; PG8_MMA(1, 1, At, B1); PG8_BAR;
            }
        }
        if constexpr (ALIGN_EPI) { if (wr == 0) PG8_BAR; }
        if constexpr (!Epi::AFTER_DRAIN) { E(acc, cur, wr, wc, fr, fq); S.done(cur); }
        if (!has_next) break;
#pragma unroll
        for (int a = 0; a < 2; ++a)
#pragma unroll
            for (int b = 0; b < 2; ++b)
#pragma unroll
                for (int m = 0; m < 4; ++m)
#pragma unroll
                    for (int n = 0; n < 2; ++n) acc[a][b][m][n] = (i32x4){0, 0, 0, 0};
        cur = nxt; cA = nA; cB = nB; ++ui;
#pragma unroll
        for (int _i = 0; _i < 2; ++_i) { v0[_i] = n0[_i]; v1[_i] = n1[_i]; }
        if constexpr (ALIGN_EPI) { if (wr == 1) PG8_BAR; }
    }
    PG8_WAIT_V(0);
    if constexpr (!ALIGN_EPI) { if (wr == 0) PG8_BAR; }
    PG8_BAR;
    if constexpr (Epi::AFTER_DRAIN) { E.fused(acc, cur, wr, wc, fr, fq, lds, wid, lane); S.done(cur); }
#undef PG8_LOADOFF
#undef PG8_SA
#undef PG8_SB
#undef PG8_STAGE
#undef PG8_LDA
#undef PG8_LDB
#undef PG8_MMA
#undef PG8_WAIT_V
#undef PG8_WAIT_L
#undef PG8_BAR
#undef PG8_SCHED
}template <class Epi, class Sched, bool ALIGN_EPI = false, bool SP2 = false>
__device__ __forceinline__ void gemm_phase_i8(PG8_LAS unsigned char* lds, const Gemm g, const Sched& S, const Epi& E, const int tid_arg) {
    int tid_ = tid_arg; asm volatile("" : "+v"(tid_));
    const int tid = tid_, wid = __builtin_amdgcn_readfirstlane(tid >> 6), lane = tid & 63, wr = wid >> 2, wc = wid & 3, fr = lane & 15, fq = lane >> 4;
    const int K = g.K, nt = K / BK;
    unsigned voffA[2], voffB[2];
#pragma unroll
    for (int i = 0; i < 2; ++i) { int R, C; stage_rc(tid * 16 + i * 8192, R, C); const int Rb = Epi::PERM ? ((R & ~31) + perm32(R & 31)) : R;
        voffA[i] = (unsigned)(R * K + C) * 2u; voffB[i] = (unsigned)(Rb * K + C) * 2u; }
    const size_t kstep = (size_t)(BK * 2);
    const size_t hstep = (size_t)HALF * K * 2;
    const size_t tstep = 2 * hstep;
    const unsigned ldsw = (unsigned)wid * 1024u;
    const int aoff = lds_byte(wr * 64 + fr, fq * 8), boff = lds_byte(wc * 32 + fr, fq * 8);
#define PG8_SA(b, h) (((b) * 2 + (h)) * HTB)
#define PG8_SB(b, h) ((4 + (b) * 2 + (h)) * HTB)
#define PG8_STAGE(bufoff, gbase, voff) do { _Pragma("unroll") for (int _i = 0; _i < 2; ++_i) \
        __builtin_amdgcn_global_load_lds((const unsigned*)((const char*)(gbase) + (voff)[_i]), (PG8_LAS unsigned*)(lds + (bufoff) + ldsw + _i * 8192), 16, 0, 0); } while (0)
#define PG8_LDA(dst, b, h) do { _Pragma("unroll") for (int m = 0; m < 4; ++m) _Pragma("unroll") for (int k = 0; k < 2; ++k) dst[m][k] = *(const PG8_LAS bf16x8*)(lds + PG8_SA(b, h) + aoff + m * 2048 + k * 1024); } while (0)
#define PG8_LDB(dst, b, h) do { _Pragma("unroll") for (int n = 0; n < 2; ++n) _Pragma("unroll") for (int k = 0; k < 2; ++k) dst[n][k] = *(const PG8_LAS bf16x8*)(lds + PG8_SB(b, h) + boff + n * 2048 + k * 1024); } while (0)
#define PG8_MMA(ai, bj, At, Bt) do { __builtin_amdgcn_s_setprio(1); _Pragma("unroll") for (int m = 0; m < 4; ++m) _Pragma("unroll") for (int n = 0; n < 2; ++n) _Pragma("unroll") for (int k = 0; k < 2; ++k) \
        acc[ai][bj][m][n] = __builtin_amdgcn_mfma_i32_16x16x64_i8(__builtin_bit_cast(i32x4, Bt[n][k]), __builtin_bit_cast(i32x4, At[m][k]), acc[ai][bj][m][n], 0, 0, 0); __builtin_amdgcn_s_setprio(0); } while (0)
#define PG8_WAIT_V(n) asm volatile("s_waitcnt vmcnt(" #n ")" ::: "memory")
#define PG8_WAIT_L(n) asm volatile("s_waitcnt lgkmcnt(" #n ")" ::: "memory")
#define PG8_BAR __builtin_amdgcn_s_barrier()
#define PG8_SCHED __builtin_amdgcn_sched_barrier(0)
    Unit cur, nxt; int ui = 0;
    if (!S.next(0, cur)) return;
    i32x4 acc[2][2][4][2];
#pragma unroll
    for (int a = 0; a < 2; ++a)
#pragma unroll
        for (int b = 0; b < 2; ++b)
#pragma unroll
            for (int m = 0; m < 4; ++m)
#pragma unroll
                for (int n = 0; n < 2; ++n) acc[a][b][m][n] = (i32x4){0, 0, 0, 0};
    bf16x8 At[4][2], B0[2][2], B1[2][2];
    const char* cA = (const char*)g.A + (size_t)cur.pm * tstep; const char* cB = (const char*)g.Bt + (size_t)cur.pn * tstep;
    S.a_ready(cur);
    if constexpr (SP2) {
        PG8_STAGE(PG8_SB(0, 0), cB, voffB); PG8_STAGE(PG8_SB(0, 1), cB + hstep, voffB); PG8_STAGE(PG8_SA(0, 0), cA, voffA); PG8_STAGE(PG8_SA(0, 1), cA + hstep, voffA);
        if (wr == 1) PG8_BAR;
        PG8_WAIT_V(2); PG8_BAR;
        PG8_STAGE(PG8_SB(1, 0), cB + kstep, voffB); PG8_STAGE(PG8_SA(1, 0), cA + kstep, voffA); PG8_STAGE(PG8_SB(1, 1), cB + hstep + kstep, voffB);
        PG8_WAIT_V(6); PG8_BAR;
    } else {
        PG8_STAGE(PG8_SB(0, 0), cB, voffB); PG8_STAGE(PG8_SA(0, 0), cA, voffA); PG8_STAGE(PG8_SB(0, 1), cB + hstep, voffB); PG8_STAGE(PG8_SA(0, 1), cA + hstep, voffA);
        if (wr == 1) PG8_BAR;
        PG8_WAIT_V(4); PG8_BAR;
        PG8_STAGE(PG8_SB(1, 0), cB + kstep, voffB); PG8_STAGE(PG8_SA(1, 0), cA + kstep, voffA); PG8_STAGE(PG8_SB(1, 1), cB + hstep + kstep, voffB);
        PG8_WAIT_V(6); PG8_BAR;
    }
    for (;;) {
        const bool has_next = S.next(ui + 1, nxt);
        const char* nA = has_next ? (const char*)g.A + (size_t)nxt.pm * tstep : cA; const char* nB = has_next ? (const char*)g.Bt + (size_t)nxt.pn * tstep : cB;
        for (int t = 0; t < nt; t += 2) {
            const bool last = (t == nt - 2);
            const char* a1 = cA + (size_t)(t + 1) * kstep;
            const char* a2 = last ? nA : cA + (size_t)(t + 2) * kstep; const char* b2 = last ? nB : cB + (size_t)(t + 2) * kstep;
            const char* a3 = a2 + kstep; const char* b3 = b2 + kstep;
            if (last && has_next) S.a_ready(nxt);
            if constexpr (SP2) {
            PG8_LDB(B0, 0, 0); PG8_LDB(B1, 0, 1); PG8_SCHED; PG8_LDA(At, 0, 0); PG8_STAGE(PG8_SA(1, 1), a1 + hstep, voffA);
            PG8_WAIT_V(8); PG8_WAIT_L(0); PG8_BAR; PG8_MMA(0, 0, At, B0); PG8_MMA(0, 1, At, B1); PG8_BAR; PG8_SCHED;
            PG8_LDA(At, 0, 1); PG8_STAGE(PG8_SB(0, 0), b2, voffB); PG8_STAGE(PG8_SB(0, 1), b2 + hstep, voffB); PG8_STAGE(PG8_SA(0, 0), a2, voffA);
            PG8_WAIT_V(8); PG8_WAIT_L(0); PG8_BAR; PG8_MMA(1, 0, At, B0); PG8_MMA(1, 1, At, B1); PG8_BAR; PG8_SCHED;
            PG8_LDB(B0, 1, 0); PG8_LDB(B1, 1, 1); PG8_SCHED; PG8_LDA(At, 1, 0); PG8_STAGE(PG8_SA(0, 1), a2 + hstep, voffA);
            PG8_WAIT_V(8); PG8_WAIT_L(0); PG8_BAR; PG8_MMA(0, 0, At, B0); PG8_MMA(0, 1, At, B1); PG8_BAR; PG8_SCHED;
            PG8_LDA(At, 1, 1); PG8_STAGE(PG8_SB(1, 0), b3, voffB); PG8_STAGE(PG8_SB(1, 1), b3 + hstep, voffB); PG8_STAGE(PG8_SA(1, 0), a3, voffA);
            PG8_WAIT_V(8); PG8_WAIT_L(0); PG8_BAR; PG8_MMA(1, 0, At, B0); PG8_MMA(1, 1, At, B1); PG8_BAR; PG8_SCHED;
            } else {
            PG8_LDB(B0, 0, 0); PG8_SCHED; PG8_LDA(At, 0, 0); PG8_STAGE(PG8_SA(1, 1), a1 + hstep, voffA);
            PG8_WAIT_L(8); PG8_BAR; PG8_WAIT_L(0); PG8_MMA(0, 0, At, B0); PG8_BAR; PG8_SCHED;
            PG8_LDB(B1, 0, 1); PG8_STAGE(PG8_SB(0, 0), b2, voffB);
            PG8_BAR; PG8_WAIT_L(0); PG8_MMA(0, 1, At, B1); PG8_BAR;
            PG8_LDA(At, 0, 1); PG8_STAGE(PG8_SA(0, 0), a2, voffA);
            PG8_BAR; PG8_WAIT_L(0); PG8_MMA(1, 0, At, B0); PG8_BAR; PG8_SCHED;
            PG8_STAGE(PG8_SB(0, 1), b2 + hstep, voffB);
            PG8_WAIT_V(6); PG8_BAR; PG8_MMA(1, 1, At, B1); PG8_BAR;
            PG8_LDB(B0, 1, 0); PG8_SCHED; PG8_LDA(At, 1, 0); PG8_STAGE(PG8_SA(0, 1), a2 + hstep, voffA);
            PG8_WAIT_L(8); PG8_BAR; PG8_WAIT_L(0); PG8_MMA(0, 0, At, B0); PG8_BAR; PG8_SCHED;
            PG8_LDB(B1, 1, 1); PG8_STAGE(PG8_SB(1, 0), b3, voffB);
            PG8_BAR; PG8_WAIT_L(0); PG8_MMA(0, 1, At, B1); PG8_BAR;
            PG8_LDA(At, 1, 1); PG8_STAGE(PG8_SA(1, 0), a3, voffA);
            PG8_BAR; PG8_WAIT_L(0); PG8_MMA(1, 0, At, B0); PG8_BAR; PG8_SCHED;
            PG8_STAGE(PG8_SB(1, 1), b3 + hstep, voffB);
            PG8_WAIT_V(6); PG8_BAR; PG8_MMA(1, 1, At, B1); PG8_BAR;
            }
        }
        if constexpr (ALIGN_EPI) { if (wr == 0) PG8_BAR; }
        if constexpr (!Epi::AFTER_DRAIN) { E(acc, cur, wr, wc, fr, fq); S.done(cur); }
        if (!has_next) break;
#pragma unroll
        for (int a = 0; a < 2; ++a)
#pragma unroll
            for (int b = 0; b < 2; ++b)
#pragma unroll
                for (int m = 0; m < 4; ++m)
#pragma unroll
                    for (int n = 0; n < 2; ++n) acc[a][b][m][n] = (i32x4){0, 0, 0, 0};
        cur = nxt; cA = nA; cB = nB; ++ui;
        if constexpr (ALIGN_EPI) { if (wr == 1) PG8_BAR; }
    }
    PG8_WAIT_V(0);
    if constexpr (!ALIGN_EPI) { if (wr == 0) PG8_BAR; }
    PG8_BAR;
    if constexpr (Epi::AFTER_DRAIN) { E.fused(acc, cur, wr, wc, fr, fq, lds, wid, lane); S.done(cur); }
#undef PG8_SA
#undef PG8_SB
#undef PG8_STAGE
#undef PG8_LDA
#undef PG8_LDB
#undef PG8_MMA
#undef PG8_WAIT_V
#undef PG8_WAIT_L
#undef PG8_BAR
#undef PG8_SCHED
}}

#ifndef PROBE_MASK
#define PROBE_MASK 0
#endif
namespace mk {
using pg8::bf16_t; using pg8::bf16x8; using pg8::f32x4; using pg8::u32x4; using pg8::Unit;
typedef float f32x16 __attribute__((ext_vector_type(16)));
typedef short s16x4 __attribute__((ext_vector_type(4)));
typedef unsigned u32x2 __attribute__((ext_vector_type(2)));
typedef float f32x2_t __attribute__((ext_vector_type(2)));
typedef __bf16 bf16x2_t __attribute__((ext_vector_type(2)));

constexpr int D = 1024, NB = 16, SEQ = 2048, CTXL = 256, DEPTH = 4;
constexpr int NL = NB * SEQ, NC = NB * CTXL, NT = NL + NC;
constexpr int PIN = 3088, NPROJ = 3072;
constexpr int NE = 16, DE = 1408;
constexpr int NTILE = 288, YROWS = NTILE * 256;
constexpr float EPS = 1e-6f;
constexpr float LOG2E = 1.4426950408889634f;
constexpr int NWAVES = 8, NTHREADS = 512;

constexpr size_t al256(size_t x) { return (x + 255) & ~(size_t)255; }
constexpr size_t WS_CTL = 0, CTL_BYTES = 2u << 20;
constexpr size_t WS_AMAX = 1u << 20;
constexpr size_t WS_AMAXIN = WS_AMAX + 786432;
constexpr size_t WS_MOD = CTL_BYTES,                      MOD_BYTES = (size_t)DEPTH * 17 * 6144 * 4;
constexpr size_t WS_ROPE = al256(WS_MOD + MOD_BYTES),     ROPE_BYTES = (size_t)2 * 2048 * 32 * 4;
constexpr size_t WS_QKW = al256(WS_ROPE + ROPE_BYTES),    QKW_BYTES = (size_t)DEPTH * 128 * 4;
constexpr size_t WS_WT = al256(WS_QKW + QKW_BYTES),      WT_BYTES = (size_t)DEPTH * 2 * 16 * 1024 * 4;
constexpr size_t WS_WIN = al256(WS_WT + WT_BYTES),     WIN_BYTES = (size_t)DEPTH * NPROJ * D * 2;
constexpr size_t WS_WOUT = al256(WS_WIN + WIN_BYTES),     WOUT_BYTES = (size_t)DEPTH * D * D * 2;
constexpr size_t WS_WGU = al256(WS_WOUT + WOUT_BYTES),    WGU_BYTES = (size_t)DEPTH * NE * 2816 * D * 2;
constexpr size_t WS_WD = al256(WS_WGU + WGU_BYTES),       WD_BYTES = (size_t)DEPTH * NE * D * DE * 2;
constexpr size_t WS_HA = al256(WS_WD + WD_BYTES),         HA_BYTES = (size_t)NT * D * 2;
constexpr size_t WS_XB = al256(WS_HA + HA_BYTES),         XB_BYTES = (size_t)NT * D * 2;
constexpr size_t WS_DT = al256(WS_XB + XB_BYTES),     DT_BYTES = (size_t)NT * 16 * 4;
constexpr size_t WS_AFF = al256(WS_DT + DT_BYTES),        AFF_BYTES = (size_t)NT * 16 * 4;
constexpr size_t WS_GATE = al256(WS_AFF + AFF_BYTES),     GATE_BYTES = (size_t)YROWS * 4;
constexpr size_t WS_INV = al256(WS_GATE + GATE_BYTES),    INV_BYTES = (size_t)NT * 16 * 4;
constexpr size_t WS_ROFF = al256(WS_INV + INV_BYTES),    ROFF_BYTES = (size_t)YROWS * 4;
constexpr size_t WS_SW = al256(WS_ROFF + ROFF_BYTES),     SW_BYTES = (size_t)DEPTH * NE * 2816 * 4;
constexpr size_t WS_HQ = al256(WS_SW + SW_BYTES),         HQ_BYTES = (size_t)NT * D;
constexpr size_t WS_SA = al256(WS_HQ + HQ_BYTES),         SA_BYTES = (size_t)NT * 4;
constexpr size_t WS_SAY = al256(WS_SA + SA_BYTES),        SAY_BYTES = (size_t)YROWS * 4;
constexpr size_t WS_SAH = al256(WS_SAY + SAY_BYTES),      SAH_BYTES = (size_t)NT * 4;
constexpr size_t WS_SWIN = al256(WS_SAH + SAH_BYTES),     SWIN_BYTES = (size_t)DEPTH * NPROJ * 4;
constexpr size_t WS_U = al256(WS_SWIN + SWIN_BYTES);
constexpr size_t U_Q = 0,                                 QKVZ_BYTES = (size_t)NT * 512 * 2;
constexpr size_t U_K = U_Q + QKVZ_BYTES, U_V = U_K + QKVZ_BYTES, U_Z = U_V + QKVZ_BYTES;
constexpr size_t U_XBC = U_Z + QKVZ_BYTES,                XBC_BYTES = (size_t)NT * 1024 * 2;
constexpr size_t U_XBCC = U_XBC + XBC_BYTES;
constexpr size_t U_GM = U_XBCC + XBC_BYTES,               GM_BYTES = (size_t)288 * 2 * 128 * 128 * 2;
constexpr size_t U_YF = U_GM + GM_BYTES, U_YB = U_YF + QKVZ_BYTES;
constexpr size_t U_A2 = U_YB + QKVZ_BYTES;
constexpr size_t U_MIX_END = U_A2 + XBC_BYTES;
constexpr size_t U_XE = 0,                                XE_BYTES = (size_t)YROWS * D * 2;
constexpr size_t U_HID = U_XE + XE_BYTES,                 HID_BYTES = (size_t)YROWS * DE * 2;
constexpr size_t U_Y = U_HID + HID_BYTES;
constexpr size_t U_MOE_END = U_Y + XE_BYTES;
constexpr size_t WS_END = WS_U + (U_MIX_END > U_MOE_END ? U_MIX_END : U_MOE_END);

constexpr int CW_BAR = 0;
constexpr int CW_WQ = 16384;
constexpr int CW_CVQ = 12288;
constexpr int CW_DONE = 14336;
constexpr int CW_ZERO = 8192;

constexpr int LDS_BYTES = 155648;
constexpr int MISC_OFF = 154624;

__device__ __forceinline__ unsigned pk2(float lo, float hi) { f32x2_t v = {lo, hi}; bf16x2_t b = __builtin_convertvector(v, bf16x2_t); return __builtin_bit_cast(unsigned, b); }
__device__ __forceinline__ float bflo(unsigned w) { return __uint_as_float(w << 16); }
__device__ __forceinline__ float bfhi(unsigned w) { return __uint_as_float(w & 0xffff0000u); }
__device__ __forceinline__ float bf1(unsigned short h) { return __uint_as_float((unsigned)h << 16); }
__device__ __forceinline__ unsigned short f2bf(float f) { return (unsigned short)(pk2(f, 0.f) & 0xffffu); }
__device__ __forceinline__ float silu_f(float x) { return x / (1.f + __expf(-x)); }
__device__ __forceinline__ int lane_id_v() { int l; asm volatile("v_mbcnt_lo_u32_b32 %0, -1, 0\n\tv_mbcnt_hi_u32_b32 %0, -1, %0" : "=v"(l)); return l; }
__device__ __forceinline__ float shx(float v, int m, int lane) { return __int_as_float(__builtin_amdgcn_ds_bpermute((lane ^ m) << 2, __float_as_int(v))); }
__device__ __forceinline__ float shl_from(float v, int src_lane) { return __int_as_float(__builtin_amdgcn_ds_bpermute(src_lane << 2, __float_as_int(v))); }
__device__ __forceinline__ int shl_from_i(int v, int src_lane) { return __builtin_amdgcn_ds_bpermute(src_lane << 2, v); }
__device__ __forceinline__ float wave_sum(float v) {
    const int l = lane_id_v();
#pragma unroll
    for (int o = 1; o < 64; o <<= 1) v += shx(v, o, l);
    return v;
}
__device__ __forceinline__ float wave_max(float v) {
    const int l = lane_id_v();
#pragma unroll
    for (int o = 1; o < 64; o <<= 1) v = fmaxf(v, shx(v, o, l));
    return v;
}
#define LDS_WAIT() asm volatile("s_waitcnt lgkmcnt(0)" ::: "memory")
__device__ __forceinline__ void lds_barrier() { asm volatile("s_waitcnt lgkmcnt(0)" ::: "memory"); __builtin_amdgcn_s_barrier(); asm volatile("" ::: "memory"); }
__device__ __forceinline__ u32x4 pack8(f32x4 a, f32x4 b) { u32x4 w; w.x = pk2(a[0], a[1]); w.y = pk2(a[2], a[3]); w.z = pk2(b[0], b[1]); w.w = pk2(b[2], b[3]); return w; }

__device__ __forceinline__ float reduce16(float (&v)[16], int lane) {
    { const bool b = (lane & 32) != 0;
#pragma unroll
      for (int i = 0; i < 8; ++i) { const float send = b ? v[i] : v[i + 8], keep = b ? v[i + 8] : v[i]; v[i] = keep + shx(send, 32, lane); } }
    { const bool b = (lane & 16) != 0;
#pragma unroll
      for (int i = 0; i < 4; ++i) { const float send = b ? v[i] : v[i + 4], keep = b ? v[i + 4] : v[i]; v[i] = keep + shx(send, 16, lane); } }
    { const bool b = (lane & 8) != 0;
#pragma unroll
      for (int i = 0; i < 2; ++i) { const float send = b ? v[i] : v[i + 2], keep = b ? v[i + 2] : v[i]; v[i] = keep + shx(send, 8, lane); } }
    { const bool b = (lane & 4) != 0; const float send = b ? v[0] : v[1], keep = b ? v[1] : v[0]; v[0] = keep + shx(send, 4, lane); }
    float t = v[0]; t += shx(t, 1, lane); t += shx(t, 2, lane); return t;
}
__device__ __forceinline__ int colidx16(int lane) { return ((lane >> 5) & 1) * 8 + ((lane >> 4) & 1) * 4 + ((lane >> 3) & 1) * 2 + ((lane >> 2) & 1); }
__device__ __forceinline__ int laneof16(int c) { return ((c >> 3) & 1) * 32 + ((c >> 2) & 1) * 16 + ((c >> 1) & 1) * 8 + (c & 1) * 4; }

__device__ __forceinline__ bf16x8 frag_rm(LAS const unsigned char* base, int stride, int row0, int k0, int lane) {
    return *(LAS const bf16x8*)(base + (row0 + (lane & 31)) * stride + (k0 + 8 * (lane >> 5)) * 2);
}
__device__ __forceinline__ bf16x8 frag_tr(LAS const unsigned char* base, int stride, int k0, int col0, int lane) {
    const int h = lane >> 5, blk = (lane >> 4) & 1, q = (lane & 15) >> 2, p = lane & 3;
    LAS const unsigned char* a = base + (k0 + 8 * h + q) * stride + (col0 + 16 * blk + 4 * p) * 2;
    const s16x4 lo = __builtin_bit_cast(s16x4, __builtin_amdgcn_ds_read_tr16_b64_v4i16((LAS s16x4*)a));
    const s16x4 hi = __builtin_bit_cast(s16x4, __builtin_amdgcn_ds_read_tr16_b64_v4i16((LAS s16x4*)(a + 4 * stride)));
    return (bf16x8){lo[0], lo[1], lo[2], lo[3], hi[0], hi[1], hi[2], hi[3]};
}
__device__ __forceinline__ bf16x8 frag_tr_acc(LAS const unsigned char* base, int stride, int k0, int col0, int lane) {
    const int h = lane >> 5, blk = (lane >> 4) & 1, q = (lane & 15) >> 2, p = lane & 3;
    LAS const unsigned char* a = base + (k0 + 4 * h + q) * stride + (col0 + 16 * blk + 4 * p) * 2;
    const s16x4 lo = __builtin_bit_cast(s16x4, __builtin_amdgcn_ds_read_tr16_b64_v4i16((LAS s16x4*)a));
    const s16x4 hi = __builtin_bit_cast(s16x4, __builtin_amdgcn_ds_read_tr16_b64_v4i16((LAS s16x4*)(a + 8 * stride)));
    return (bf16x8){lo[0], lo[1], lo[2], lo[3], hi[0], hi[1], hi[2], hi[3]};
}
__device__ __forceinline__ int accrow(int t, int h) { return (t & 3) + 8 * (t >> 2) + 4 * h; }
#define MFMA32(a, b, c) __builtin_amdgcn_mfma_f32_32x32x16_bf16((a), (b), (c), 0, 0, 0)

struct Frame {
    LAS unsigned char* lds;
    int tid, lane, wave, G, blk;
};
__device__ __forceinline__ unsigned long long karg64(int byteoff) {
    unsigned long long p; auto ka = __builtin_amdgcn_kernarg_segment_ptr();
    asm volatile("s_load_dwordx2 %0, %1, %2\n\ts_waitcnt lgkmcnt(0)" : "=s"(p) : "s"(ka), "i"(byteoff) : "memory");
    return p;
}
#define INP(i)  ((const float*)(const GAS float*)karg64(8 * (i)))
#define OUTP()  ((float*)(GAS float*)karg64(232))
#define WSP()   ((unsigned char*)(GAS unsigned char*)karg64(240))
#define F_CTL   ((unsigned*)(WSP() + WS_CTL))
#define F_MOD   ((float*)(WSP() + WS_MOD))
#define F_ROPEC ((float*)(WSP() + WS_ROPE))
#define F_ROPES ((float*)(WSP() + WS_ROPE) + 2048 * 32)
#define F_QKW   ((float*)(WSP() + WS_QKW))
#define F_WT    ((float*)(WSP() + WS_WT))
#define F_WIN   ((bf16_t*)(WSP() + WS_WIN))
#define F_WOUT  ((bf16_t*)(WSP() + WS_WOUT))
#define F_WGU   ((bf16_t*)(WSP() + WS_WGU))
#define F_WGUQ  ((signed char*)(WSP() + WS_WGU))
#define F_WD    ((bf16_t*)(WSP() + WS_WD))
#define F_HA    ((bf16_t*)(WSP() + WS_HA))
#define F_XB    ((bf16_t*)(WSP() + WS_XB))
#define F_DT    ((float*)(WSP() + WS_DT))
#define F_AFF   ((float*)(WSP() + WS_AFF))
#define F_GATE  ((float*)(WSP() + WS_GATE))
#define F_INV   ((int*)(WSP() + WS_INV))
#define F_ROFF  ((unsigned*)(WSP() + WS_ROFF))
#define F_AMAX  ((unsigned*)(WSP() + WS_AMAX))
#define F_AMAXIN ((unsigned*)(WSP() + WS_AMAXIN))
#define F_SAH   ((float*)(WSP() + WS_SAH))
#define F_SWIN  ((float*)(WSP() + WS_SWIN))
#define F_HAQ   ((signed char*)(WSP() + WS_HA))
#define F_WINQ  ((signed char*)(WSP() + WS_WIN))
#define F_SW    ((float*)(WSP() + WS_SW))
#define F_HQ    ((signed char*)(WSP() + WS_HQ))
#define F_SA    ((float*)(WSP() + WS_SA))
#define F_SAY   ((float*)(WSP() + WS_SAY))
#define F_Q     ((bf16_t*)(WSP() + WS_U + U_Q))
#define F_K     ((bf16_t*)(WSP() + WS_U + U_K))
#define F_V     ((bf16_t*)(WSP() + WS_U + U_V))
#define F_Z     ((bf16_t*)(WSP() + WS_U + U_Z))
#define F_XBC   ((bf16_t*)(WSP() + WS_U + U_XBC))
#define F_XBCC  ((bf16_t*)(WSP() + WS_U + U_XBCC))
#define F_GM    ((bf16_t*)(WSP() + WS_U + U_GM))
#define F_YF    ((bf16_t*)(WSP() + WS_U + U_YF))
#define F_YB    ((bf16_t*)(WSP() + WS_U + U_YB))
#define F_A2    ((bf16_t*)(WSP() + WS_U + U_A2))
#define F_XE    ((bf16_t*)(WSP() + WS_U + U_XE))
#define F_HID   ((bf16_t*)(WSP() + WS_U + U_HID))
#define F_Y     ((bf16_t*)(WSP() + WS_U + U_Y))
enum { I_X = 0, I_C, I_CTX, I_CCTX, I_WMOD, I_BMOD, I_N1W, I_N2W, I_WIN, I_QNW, I_KNW, I_LQ1, I_LK1, I_LQ2, I_LK2, I_SUBLN, I_CONVW, I_CONVB,
       I_DTBF, I_DTBB, I_ALOGF, I_ALOGB, I_DSKIP, I_SSDNW, I_WOUT, I_WR, I_WG, I_WU, I_WDN };

__device__ __forceinline__ void cvt_item64(const float* __restrict__ src, int ld, int c0a, int c0b, int kperm, int k0, bf16_t* __restrict__ dst, int K, LAS float* scr, int lane) {
    { const int cq = lane & 15, col = ((cq >> 3) ? c0b : c0a) + 4 * (cq & 7);
      f32x4 v[16];
#pragma unroll
      for (int i = 0; i < 16; ++i) v[i] = __builtin_nontemporal_load((const f32x4*)(src + (size_t)(k0 + 4 * i + (lane >> 4)) * ld + col));
#pragma unroll
      for (int i = 0; i < 16; ++i) *(LAS f32x4*)(scr + (4 * i + (lane >> 4)) * 68 + 4 * cq) = v[i]; }
    LDS_WAIT();
    const int c = lane & 7;
#pragma unroll
    for (int j = 0; j < 8; ++j) { const int n = (lane >> 3) + 8 * j, nn = n & 31; const int sc = (n & 32) + (kperm ? pg8::perm32(nn) : nn); const LAS float* s = scr + (8 * c) * 68 + sc;
        u32x4 o; o.x = pk2(s[0], s[68]); o.y = pk2(s[136], s[204]); o.z = pk2(s[272], s[340]); o.w = pk2(s[408], s[476]);
        __builtin_nontemporal_store(o, (u32x4*)(dst + (size_t)n * K + k0 + 8 * c)); }
    LDS_WAIT();
}
__device__ __forceinline__ void cvt_item64_i8(const float* __restrict__ src, int ld, int c0a, int c0b, int kperm, int k0, signed char* __restrict__ dst, int Kb, const unsigned* __restrict__ amax, float* sw,
                                              LAS float* scr, int lane) {
    { const int cq = lane & 15, col = ((cq >> 3) ? c0b : c0a) + 4 * (cq & 7);
      f32x4 v[16];
#pragma unroll
      for (int i = 0; i < 16; ++i) v[i] = __builtin_nontemporal_load((const f32x4*)(src + (size_t)(k0 + 4 * i + (lane >> 4)) * ld + col));
#pragma unroll
      for (int i = 0; i < 16; ++i) *(LAS f32x4*)(scr + (4 * i + (lane >> 4)) * 68 + 4 * cq) = v[i]; }
    LDS_WAIT();
    const int c = lane & 3;
#pragma unroll
    for (int j = 0; j < 4; ++j) { const int n = (lane >> 2) + 16 * j, nn = n & 31, pc = kperm ? pg8::perm32(nn) : nn; const int col = ((n & 32) ? c0b : c0a) + pc;
        const float am = __uint_as_float(amax[col]); const float inv = am > 0.f ? 127.f / am : 0.f;
        const LAS float* s = scr + (16 * c) * 68 + (n & 32) + pc;
        u32x4 o;
#pragma unroll
        for (int w = 0; w < 4; ++w) { unsigned pk = 0u;
#pragma unroll
            for (int bq = 0; bq < 4; ++bq) { const float qf = fminf(fmaxf(rintf(s[(4 * w + bq) * 68] * inv), -127.f), 127.f); pk |= ((unsigned)(int)qf & 0xffu) << (8 * bq); }
            o[w] = pk; }
        __builtin_nontemporal_store(o, (u32x4*)(dst + (size_t)n * Kb + k0 + 16 * c));
        if (sw && c == 0) sw[n] = am * (1.f / 127.f); }
    LDS_WAIT();
}
constexpr int AM_IN_ITEMS = DEPTH * 48 * 4;
__device__ __forceinline__ void amax_block(const float* src, int ld, unsigned* dst, int lane) {
    const int rq = lane >> 4, cq = lane & 15;
    f32x4 m = {0.f, 0.f, 0.f, 0.f};
    for (int i = 0; i < 64; i += 16) {
        f32x4 v[16];
#pragma unroll
        for (int q = 0; q < 16; ++q) v[q] = *(const f32x4*)(src + (size_t)(4 * (i + q) + rq) * ld + 4 * cq);
#pragma unroll
        for (int q = 0; q < 16; ++q) { m[0] = fmaxf(m[0], fabsf(v[q][0])); m[1] = fmaxf(m[1], fabsf(v[q][1])); m[2] = fmaxf(m[2], fabsf(v[q][2])); m[3] = fmaxf(m[3], fabsf(v[q][3])); }
    }
#pragma unroll
    for (int cidx = 0; cidx < 4; ++cidx) { m[cidx] = fmaxf(m[cidx], shx(m[cidx], 16, lane)); m[cidx] = fmaxf(m[cidx], shx(m[cidx], 32, lane)); }
    if (rq == 0) {
#pragma unroll
        for (int cidx = 0; cidx < 4; ++cidx) (void)__hip_atomic_fetch_max(dst + 4 * cq + cidx, __float_as_uint(m[cidx]), __ATOMIC_RELAXED, __HIP_MEMORY_SCOPE_AGENT); }
}
__device__ __forceinline__ void amax_in_item(const float* win, unsigned* amaxp, int it, int lane) {
    const int kq = it & 3; int r = it >> 2; const int cb = r % 48, l = r / 48;
    amax_block(win + (size_t)l * D * PIN + (size_t)(256 * kq) * PIN + cb * 64, PIN, amaxp + (size_t)l * NPROJ + cb * 64, lane);
}
constexpr int CV_WIN = 48 * 16, CV_WOUT = 16 * 16, CV_WGU = NE * 44 * 16, CV_WD = NE * 16 * 22, CV_LAYER = CV_WIN + CV_WOUT + CV_WGU + CV_WD;

__device__ __forceinline__ void cvt_layer_item(const Frame& F, int l, int r, LAS float* scr) {
    const int lane = F.lane;
    if (r < CV_WIN) { const int GI = r % 48, kb = r / 48, gI = 2 * GI, pn = gI >> 3, gg = gI & 7; int c0a, c0b, kp;
        if (pn < 4) { c0a = 256 * pn + 64 * (gg & 3) + 32 * (gg >> 2); c0b = 256 * pn + 64 * ((gg + 1) & 3) + 32 * ((gg + 1) >> 2); kp = 0; } else { c0a = 32 * gI; c0b = c0a + 32; kp = 1; }
        cvt_item64_i8(INP(I_WIN) + (size_t)l * D * PIN, PIN, c0a, c0b, kp, 64 * kb, F_WINQ + ((size_t)l * NPROJ + 32 * gI) * D, D, F_AMAXIN + (size_t)l * NPROJ,
                      kb == 0 ? F_SWIN + (size_t)l * NPROJ + 32 * gI : (float*)nullptr, scr, lane); return; }
    r -= CV_WIN;
    if (r < CV_WOUT) { const int GI = r % 16, kb = r / 16;
        cvt_item64(INP(I_WOUT) + (size_t)l * D * D, D, 64 * GI, 64 * GI + 32, 1, 64 * kb, F_WOUT + ((size_t)l * D + 64 * GI) * D, D, scr, lane); return; }
    r -= CV_WOUT;
    r -= CV_WGU;
    { const int e = r / 352, r2 = r % 352, GI = r2 % 16, kb = r2 / 16;
        cvt_item64(INP(I_WDN) + (size_t)(l * NE + e) * DE * D, D, 64 * GI, 64 * GI + 32, 1, 64 * kb, F_WD + ((size_t)(l * NE + e) * D + 64 * GI) * DE, DE, scr, lane); }
}
__device__ __forceinline__ void cvt_wgu_block(const Frame& F, int l, int it) {
    const int lane = F.lane, wave = F.wave, cq = lane & 15, rq = lane >> 4;
    const int e = it / 44, GI = it % 44, gI = 2 * GI, j = gI >> 3, gg = gI & 7;
    const float* src = (gg < 4 ? INP(I_WG) : INP(I_WU)) + (size_t)(l * NE + e) * D * DE + 128 * j + 32 * (gg & 3) + (size_t)(128 * wave + rq) * DE + 4 * cq;
    signed char* dst = F_WGUQ + ((size_t)(l * NE + e) * 2816 + 32 * gI) * D + 128 * wave;
    LAS float* scr = (LAS float*)(F.lds + wave * 17408);
    LAS float* am = (LAS float*)(F.lds + 8 * 17408);
    f32x4 v0[16], v1[16];
#pragma unroll
    for (int i = 0; i < 16; ++i) v0[i] = __builtin_nontemporal_load((const f32x4*)(src + (size_t)(4 * i) * DE));
#pragma unroll
    for (int i = 0; i < 16; ++i) v1[i] = __builtin_nontemporal_load((const f32x4*)(src + (size_t)(64 + 4 * i) * DE));
    f32x4 m = {0.f, 0.f, 0.f, 0.f};
#pragma unroll
    for (int i = 0; i < 16; ++i)
#pragma unroll
        for (int c = 0; c < 4; ++c) m[c] = fmaxf(m[c], fmaxf(fabsf(v0[i][c]), fabsf(v1[i][c])));
#pragma unroll
    for (int c = 0; c < 4; ++c) { m[c] = fmaxf(m[c], shx(m[c], 16, lane)); m[c] = fmaxf(m[c], shx(m[c], 32, lane)); }
    if (rq == 0) *(LAS f32x4*)(am + wave * 64 + 4 * cq) = m;
    __syncthreads();
    const int c4 = lane & 3;
    float inv[4];
#pragma unroll
    for (int jj = 0; jj < 4; ++jj) { const int n = (lane >> 2) + 16 * jj, lc = (n & 32) + pg8::perm32(n & 31);
        float a = am[lc];
#pragma unroll
        for (int w = 1; w < 8; ++w) a = fmaxf(a, am[w * 64 + lc]);
        inv[jj] = a > 0.f ? 127.f / a : 0.f;
        if (wave == 0 && c4 == 0) F_SW[(size_t)(l * NE + e) * 2816 + 32 * gI + n] = a * (1.f / 127.f); }
#pragma unroll
    for (int tl = 0; tl < 2; ++tl) {
#pragma unroll
        for (int i = 0; i < 16; ++i) *(LAS f32x4*)(scr + (4 * i + rq) * 68 + 4 * cq) = tl ? v1[i] : v0[i];
        LDS_WAIT();
#pragma unroll
        for (int jj = 0; jj < 4; ++jj) { const int n = (lane >> 2) + 16 * jj, lc = (n & 32) + pg8::perm32(n & 31);
            const LAS float* s = scr + (16 * c4) * 68 + lc;
            u32x4 o;
#pragma unroll
            for (int w = 0; w < 4; ++w) { unsigned pk = 0u;
#pragma unroll
                for (int bq = 0; bq < 4; ++bq) { const float qf = fminf(fmaxf(rintf(s[(4 * w + bq) * 68] * inv[jj]), -127.f), 127.f); pk |= ((unsigned)(int)qf & 0xffu) << (8 * bq); }
                o[w] = pk; }
            __builtin_nontemporal_store(o, (u32x4*)(dst + (size_t)n * D + 64 * tl + 16 * c4)); }
        LDS_WAIT();
    }
}
constexpr int CV_SMALL = CV_WIN + CV_WOUT;
constexpr int CVB_WGU = NE * 44, CVB = CVB_WGU + CV_WD / 8;
__device__ __forceinline__ void cvt_small(const Frame& F, int l) {
    LAS float* scr = (LAS float*)(F.lds + F.wave * 17408);
    for (int it = F.blk * NWAVES + F.wave; it < CV_SMALL; it += F.G * NWAVES) cvt_layer_item(F, l, it, scr);
}
__device__ __forceinline__ bool cvt_pull(const Frame& F, int l, unsigned* done) {
    if (l >= DEPTH) return true;
    LAS float* scr = (LAS float*)(F.lds + F.wave * 17408);
    volatile LAS unsigned* bc = (volatile LAS unsigned*)(F.lds + MISC_OFF) + 20;
    const int x0 = (int)(__builtin_amdgcn_s_getreg((3 << 11) | 20) & 7u);
    for (int qi = 0; qi < 8; ++qi) {
        const int x = (x0 + qi) & 7; unsigned* const q = F_CTL + CW_CVQ + 64 * (8 * l + x); const unsigned nq = (unsigned)(CVB >> 3);
        for (;;) {
            if (F.tid == 0) { const bool stop = done && __hip_atomic_load(done, __ATOMIC_RELAXED, __HIP_MEMORY_SCOPE_AGENT) >= (unsigned)F.G;
                const bool empty = !stop && __hip_atomic_load(q, __ATOMIC_RELAXED, __HIP_MEMORY_SCOPE_AGENT) >= nq;
                bc[0] = stop ? 0xffffffffu : (empty ? nq : __hip_atomic_fetch_add(q, 1u, __ATOMIC_RELAXED, __HIP_MEMORY_SCOPE_AGENT)); }
            __syncthreads();
            const unsigned k0 = bc[0];
            __syncthreads();
            if (k0 == 0xffffffffu) return false;
            if (k0 >= nq) break;
            { const int g = x + 8 * (int)k0;
              if (g < CVB_WGU) cvt_wgu_block(F, l, g); else cvt_layer_item(F, l, CV_SMALL + CV_WGU + 8 * (g - CVB_WGU) + F.wave, scr); }
        }
    }
    return true;
}
#ifndef PROBE_NOTAIL
#define PROBE_NOTAIL 0
#endif
__device__ __forceinline__ void cvt_tail(const Frame& F0, int l, unsigned* done) {
    Frame F = F0; F.lane = lane_id_v(); F.tid = F.wave * 64 + F.lane;
    if (F.tid == 0) (void)__hip_atomic_fetch_add(done, 1u, __ATOMIC_RELAXED, __HIP_MEMORY_SCOPE_AGENT);
    if (PROBE_NOTAIL) return;
    if (cvt_pull(F, l, done)) (void)cvt_pull(F, l + 1, done);
}
__device__ __forceinline__ void p0_prologue(const Frame& F) {
    const int gw = F.blk * NWAVES + F.wave, NGW = F.G * NWAVES, lane = F.lane, wave = F.wave;
    {
        LAS float* S = (LAS float*)F.lds;
        LAS float* red = (LAS float*)(F.lds + 69632);
        { const float* const cp = INP(I_C); const float* const ccp = INP(I_CCTX);
          for (int i = F.tid; i < 17 * 1024; i += NTHREADS) { const int r = i >> 10, k = i & 1023; const float c = (r < 16) ? cp[r * D + k] : ccp[k]; S[i] = silu_f(c); } }
        __syncthreads();
        const float* const wmod = INP(I_WMOD); const float* const bmod = INP(I_BMOD); float* const modp = F_MOD;
        for (int it = F.blk; it < DEPTH * 96; it += F.G) {
            const int l = it / 96, cb = it % 96, col = cb * 64 + lane;
            const float* wm = wmod + (size_t)l * D * 6144 + (size_t)(128 * wave) * 6144 + col;
            float acc[17];
#pragma unroll
            for (int r = 0; r < 17; ++r) acc[r] = 0.f;
            for (int k = 0; k < 128; k += 8) {
                float w[8];
#pragma unroll
                for (int q = 0; q < 8; ++q) w[q] = wm[(size_t)(k + q) * 6144];
#pragma unroll
                for (int r = 0; r < 17; ++r) { const f32x4 s0 = *(LAS const f32x4*)(S + r * 1024 + 128 * wave + k), s1 = *(LAS const f32x4*)(S + r * 1024 + 128 * wave + k + 4);
                    acc[r] += s0[0] * w[0] + s0[1] * w[1] + s0[2] * w[2] + s0[3] * w[3] + s1[0] * w[4] + s1[1] * w[5] + s1[2] * w[6] + s1[3] * w[7]; }
            }
#pragma unroll
            for (int r = 0; r < 17; ++r) red[(wave * 17 + r) * 64 + lane] = acc[r];
            __syncthreads();
            for (int o = F.tid; o < 17 * 64; o += NTHREADS) { const int r = o >> 6, cc = o & 63; float a = 0.f;
#pragma unroll
                for (int w = 0; w < 8; ++w) a += red[(w * 17 + r) * 64 + cc];
                modp[((size_t)l * 17 + r) * 6144 + cb * 64 + cc] = a + bmod[l * 6144 + cb * 64 + cc]; }
            __syncthreads();
        }
    }
    { const float* const win = INP(I_WIN); unsigned* const amaxin = F_AMAXIN;
      for (int it = gw; it < AM_IN_ITEMS; it += NGW) amax_in_item(win, amaxin, it, lane); }
    float* const ropec = F_ROPEC; float* const ropes = F_ROPES;
    for (int gt = F.blk * NTHREADS + F.tid; gt < 2048 * 32; gt += F.G * NTHREADS) {
        const int n = gt >> 5, a = (gt >> 4) & 1, f = gt & 15; const int pos = a == 0 ? (n >> 6) : (n & 63);
        const float inv = powf(10000.0f, -(float)f / 16.0f); const float ang = (float)pos * inv;
        ropec[gt] = cosf(ang); ropes[gt] = sinf(ang);
    }
    if (F.blk == F.G - 1) { float* const qkw = F_QKW; const float* const qn = INP(I_QNW); const float* const kn = INP(I_KNW);
        for (int i = F.tid; i < DEPTH * 128; i += NTHREADS) { const int l = i >> 7, j = i & 127; qkw[i] = (j < 64) ? qn[l * 64 + j] : kn[l * 64 + j - 64]; } }
    { float* const wt = F_WT; const float* const win = INP(I_WIN); const float* const wr = INP(I_WR);
      for (int i = F.blk * NTHREADS + F.tid; i < DEPTH * 2 * 16 * 1024; i += F.G * NTHREADS) { const int l = i >> 15, w = (i >> 14) & 1, c = (i >> 10) & 15, k = i & 1023;
          wt[i] = w ? wr[((size_t)l * D + k) * NE + c] : win[((size_t)l * D + k) * PIN + NPROJ + c]; } }
}

__device__ __forceinline__ void load_thin_T(const Frame& F, const float* src, LAS float* T) {
    f32x4 t[8];
#pragma unroll
    for (int i = 0; i < 8; ++i) t[i] = *(const f32x4*)(src + 4 * (F.tid + 512 * i));
#pragma unroll
    for (int i = 0; i < 8; ++i) *(LAS f32x4*)(T + 4 * (F.tid + 512 * i)) = t[i];
    __syncthreads();
}
__device__ __forceinline__ float softplus_f(float x) { const float e = __expf(-fabsf(x)), u = 1.f + e; const float l = (u == 1.f) ? e : __logf(u) * (e * __builtin_amdgcn_rcpf(u - 1.f)); return fmaxf(x, 0.f) + l; }


__device__ __forceinline__ void p1_combine2(f32x4 (&va)[4], f32x4 (&vb)[4], int inva, int invb, const bf16_t* Yp, const bf16_t* zrow, const float* g2a, const float* g2b, int lane) {
    unsigned maska = (unsigned)__ballot(inva >= 0) & 0xffffu, maskb = (unsigned)__ballot(invb >= 0) & 0xffffu;
    f32x4 aa[4], ab[4];
#pragma unroll
    for (int j = 0; j < 4; ++j) { aa[j] = (f32x4){0.f, 0.f, 0.f, 0.f}; ab[j] = (f32x4){0.f, 0.f, 0.f, 0.f}; }
    while (maska | maskb) {
        const bf16_t* ypa[4]; const bf16_t* ypb[4];
#pragma unroll
        for (int q = 0; q < 4; ++q) {
            if (maska) { const int e = __builtin_ctz(maska); maska &= maska - 1; ypa[q] = Yp + (size_t)shl_from_i(inva, e) * D; } else ypa[q] = zrow;
            if (maskb) { const int e = __builtin_ctz(maskb); maskb &= maskb - 1; ypb[q] = Yp + (size_t)shl_from_i(invb, e) * D; } else ypb[q] = zrow; }
        u32x2 wa[4][4], wb[4][4];
#pragma unroll
        for (int q = 0; q < 4; ++q)
#pragma unroll
            for (int j = 0; j < 4; ++j) { wa[q][j] = *(const u32x2*)(ypa[q] + 4 * (lane + 64 * j)); wb[q][j] = *(const u32x2*)(ypb[q] + 4 * (lane + 64 * j)); }
#pragma unroll
        for (int q = 0; q < 4; ++q)
#pragma unroll
            for (int j = 0; j < 4; ++j) { aa[j] += (f32x4){bflo(wa[q][j].x), bfhi(wa[q][j].x), bflo(wa[q][j].y), bfhi(wa[q][j].y)};
                ab[j] += (f32x4){bflo(wb[q][j].x), bfhi(wb[q][j].x), bflo(wb[q][j].y), bfhi(wb[q][j].y)}; }
    }
#pragma unroll
    for (int j = 0; j < 4; ++j) { va[j] += aa[j] * *(const f32x4*)(g2a + 4 * (lane + 64 * j)); vb[j] += ab[j] * *(const f32x4*)(g2b + 4 * (lane + 64 * j)); }
}
__device__ __forceinline__ void thin16x2(float (&d0)[16], float (&d1)[16], const f32x4 (&h0)[4], const f32x4 (&h1)[4], LAS const float* T, int lane) {
#pragma unroll
    for (int cg = 0; cg < 8; ++cg) {
#pragma unroll
        for (int cc = 0; cc < 2; ++cc) { const int c = 2 * cg + cc; float a0 = 0.f, a1 = 0.f;
#pragma unroll
            for (int j = 0; j < 4; ++j) { const f32x4 t = *(LAS const f32x4*)(T + c * 1024 + 4 * (lane + 64 * j));
                a0 += h0[j][0] * t[0] + h0[j][1] * t[1] + h0[j][2] * t[2] + h0[j][3] * t[3];
                a1 += h1[j][0] * t[0] + h1[j][1] * t[1] + h1[j][2] * t[2] + h1[j][3] * t[3]; }
            d0[c] = a0; d1[c] = a1; }
        asm volatile("" ::: "memory");
    }
}
__device__ __forceinline__ void p1_norm1(const Frame& F, int layer, int probe_rerun) {
    LAS float* T = (LAS float*)F.lds;
    const bool fin = (layer == DEPTH);
    if (!fin && !probe_rerun) { cvt_small(F, layer); __syncthreads(); }
    if (!fin) load_thin_T(F, F_WT + (size_t)(layer * 2 + 0) * 16384, T);
    const int gw = F.blk * NWAVES + F.wave, NGW = F.G * NWAVES, lane = F.lane;
    const int nrows = fin ? NL : NT;
    const float* modl = F_MOD + (size_t)(fin ? 0 : layer) * 17 * 6144;
    const float* modp = F_MOD + (size_t)(layer > 0 ? layer - 1 : 0) * 17 * 6144;
    const float* n1w = INP(I_N1W) + (size_t)(fin ? 0 : layer) * D;
    float* const outp = OUTP(); bf16_t* const xb = F_XB; const bool srcf32 = (layer == 0 && !probe_rerun);
    const float* const srcl = INP(I_X); const float* const srcc = INP(I_CTX);
    const int* const invp = F_INV; const bf16_t* const Yp = F_Y; signed char* const HQp = F_HAQ; float* const SAp = F_SAH; float* const DTp = F_DT;
    const bf16_t* const zrow = (const bf16_t*)(F_CTL + CW_ZERO);
    const float* const dtbf = INP(I_DTBF) + (fin ? 0 : layer) * 8; const float* const dtbb = INP(I_DTBB) + (fin ? 0 : layer) * 8;
    const bool comb = (layer > 0 && !probe_rerun);
    f32x4 nva[4], nvb[4]; int nia = -1, nib = -1;
#define P1_SRC(r) (((r) < NL) ? srcl + (size_t)(r) * D : srcc + (size_t)((r) - NL) * D)
#define P1_PRELOAD(r) do { const int ra_ = (r), rb_ = ((r) + NGW < nrows) ? (r) + NGW : (r); \
        if (srcf32) { const float* sa_ = P1_SRC(ra_); const float* sb_ = P1_SRC(rb_); \
            _Pragma("unroll") for (int j = 0; j < 4; ++j) { nva[j] = *(const f32x4*)(sa_ + 4 * (lane + 64 * j)); nvb[j] = *(const f32x4*)(sb_ + 4 * (lane + 64 * j)); } } \
        else { const bf16_t* sa_ = xb + (size_t)ra_ * D; const bf16_t* sb_ = xb + (size_t)rb_ * D; \
            _Pragma("unroll") for (int j = 0; j < 4; ++j) { const u32x2 ta_ = *(const u32x2*)(sa_ + 4 * (lane + 64 * j)), tb_ = *(const u32x2*)(sb_ + 4 * (lane + 64 * j)); \
                nva[j][0] = __uint_as_float(ta_.x); nva[j][1] = __uint_as_float(ta_.y); nvb[j][0] = __uint_as_float(tb_.x); nvb[j][1] = __uint_as_float(tb_.y); } } \
        nia = (comb && lane < 16) ? invp[(size_t)ra_ * 16 + lane] : -1; nib = (comb && lane < 16) ? invp[(size_t)rb_ * 16 + lane] : -1; } while (0)
    if (gw < nrows) P1_PRELOAD(gw);
    for (int row0 = gw; row0 < nrows; row0 += 2 * NGW) {
        const bool vB = (row0 + NGW) < nrows; const int rowA = row0, rowB = vB ? row0 + NGW : row0;
        const int mA = (rowA < NL) ? (rowA >> 11) : 16, mB = (rowB < NL) ? (rowB >> 11) : 16;
        f32x4 va[4], vb[4]; const int ia = nia, ib = nib;
#pragma unroll
        for (int j = 0; j < 4; ++j) { va[j] = nva[j]; vb[j] = nvb[j]; }
        if (!srcf32) {
#pragma unroll
            for (int j = 0; j < 4; ++j) { const unsigned ax = __float_as_uint(nva[j][0]), ay = __float_as_uint(nva[j][1]), bx = __float_as_uint(nvb[j][0]), by = __float_as_uint(nvb[j][1]);
                va[j] = (f32x4){bflo(ax), bfhi(ax), bflo(ay), bfhi(ay)}; vb[j] = (f32x4){bflo(bx), bfhi(bx), bflo(by), bfhi(by)}; } }
        if (row0 + 2 * NGW < nrows) P1_PRELOAD(row0 + 2 * NGW);
        if (layer > 0) {
            p1_combine2(va, vb, ia, ib, Yp, zrow, modp + mA * 6144 + 5 * 1024, modp + mB * 6144 + 5 * 1024, lane);
            asm volatile("" ::: "memory");
            if (fin) { float* da_ = outp + (size_t)rowA * D; float* db_ = outp + (size_t)rowB * D;
#pragma unroll
                for (int j = 0; j < 4; ++j) { *(f32x4*)(da_ + 4 * (lane + 64 * j)) = va[j]; if (vB) *(f32x4*)(db_ + 4 * (lane + 64 * j)) = vb[j]; } }
            else { bf16_t* da_ = xb + (size_t)rowA * D; bf16_t* db_ = xb + (size_t)rowB * D;
#pragma unroll
                for (int j = 0; j < 4; ++j) { *(u32x2*)(da_ + 4 * (lane + 64 * j)) = (u32x2){pk2(va[j][0], va[j][1]), pk2(va[j][2], va[j][3])};
                    if (vB) *(u32x2*)(db_ + 4 * (lane + 64 * j)) = (u32x2){pk2(vb[j][0], vb[j][1]), pk2(vb[j][2], vb[j][3])}; } }
        }
        if (fin) continue;
        float sa = 0.f, sb = 0.f;
#pragma unroll
        for (int j = 0; j < 4; ++j) { sa += va[j][0] * va[j][0] + va[j][1] * va[j][1] + va[j][2] * va[j][2] + va[j][3] * va[j][3];
            sb += vb[j][0] * vb[j][0] + vb[j][1] * vb[j][1] + vb[j][2] * vb[j][2] + vb[j][3] * vb[j][3]; }
#pragma unroll
        for (int o = 1; o < 64; o <<= 1) { sa += shx(sa, o, lane); sb += shx(sb, o, lane); }
        asm volatile("" ::: "memory");
        float ma = 0.f, mb = 0.f;
        { const float rstd = rsqrtf(sa * (1.f / D) + EPS); const float* sh = modl + mA * 6144; const float* sc = sh + 1024;
#pragma unroll
          for (int j = 0; j < 4; ++j) { const int k = 4 * (lane + 64 * j);
              const f32x4 w = *(const f32x4*)(n1w + k), s1 = *(const f32x4*)(sc + k), s0 = *(const f32x4*)(sh + k);
              const f32x4 h = va[j] * rstd * w * (s1 + 1.f) + s0;
              ma = fmaxf(fmaxf(ma, fmaxf(fabsf(h[0]), fabsf(h[1]))), fmaxf(fabsf(h[2]), fabsf(h[3])));
              va[j] = h; } }
        asm volatile("" ::: "memory");
        { const float rstd = rsqrtf(sb * (1.f / D) + EPS); const float* sh = modl + mB * 6144; const float* sc = sh + 1024;
#pragma unroll
          for (int j = 0; j < 4; ++j) { const int k = 4 * (lane + 64 * j);
              const f32x4 w = *(const f32x4*)(n1w + k), s1 = *(const f32x4*)(sc + k), s0 = *(const f32x4*)(sh + k);
              const f32x4 h = vb[j] * rstd * w * (s1 + 1.f) + s0;
              mb = fmaxf(fmaxf(mb, fmaxf(fabsf(h[0]), fabsf(h[1]))), fmaxf(fabsf(h[2]), fabsf(h[3])));
              vb[j] = h; } }
        asm volatile("" ::: "memory");
#pragma unroll
        for (int o = 1; o < 64; o <<= 1) { ma = fmaxf(ma, shx(ma, o, lane)); mb = fmaxf(mb, shx(mb, o, lane)); }
        { const float ia = ma > 0.f ? 127.f / ma : 0.f, ib = mb > 0.f ? 127.f / mb : 0.f;
#pragma unroll
          for (int j = 0; j < 4; ++j) { const int k = 4 * (lane + 64 * j);
              unsigned qa = 0u, qb = 0u;
#pragma unroll
              for (int i = 0; i < 4; ++i) { qa |= ((unsigned)(int)rintf(va[j][i] * ia) & 0xffu) << (8 * i); qb |= ((unsigned)(int)rintf(vb[j][i] * ib) & 0xffu) << (8 * i); }
              *(unsigned*)(HQp + (size_t)rowA * D + k) = qa; if (vB) *(unsigned*)(HQp + (size_t)rowB * D + k) = qb; }
          if (lane == 0) { SAp[rowA] = ma * (1.f / 127.f); if (vB) SAp[rowB] = mb * (1.f / 127.f); } }
        asm volatile("" ::: "memory");
        float da[16], db[16];
        thin16x2(da, db, va, vb, T, lane);
        const float tota = reduce16(da, lane); const float totb = reduce16(db, lane);
        if ((lane & 3) == 0) { const int c = colidx16(lane); const float bias = (c < 8) ? dtbf[c] : dtbb[c - 8];
            DTp[(size_t)rowA * 16 + c] = softplus_f(tota + bias); if (vB) DTp[(size_t)rowB * 16 + c] = softplus_f(totb + bias); }
    }
#undef P1_PRELOAD
#undef P1_SRC
}

__device__ __forceinline__ void p7_finish_row(float tot, int lane, int row, float* AFFp) {
    float lg[16]; float mx = -INFINITY;
#pragma unroll
    for (int c = 0; c < 16; ++c) { lg[c] = shl_from(tot, laneof16(c)); mx = fmaxf(mx, lg[c]); }
    float se = 0.f;
#pragma unroll
    for (int c = 0; c < 16; ++c) { lg[c] = __expf(lg[c] - mx); se += lg[c]; }
    float mine = 0.f;
#pragma unroll
    for (int c = 0; c < 16; ++c) mine = (lane == c) ? lg[c] : mine;
    if (lane < 16) {
        const float a = mine / se;
        if (row < NL) AFFp[((size_t)((row >> 11) * 16 + lane)) * 2048 + (row & 2047)] = a;
        else { const int r = row - NL; AFFp[(size_t)NL * 16 + ((size_t)((r >> 8) * 16 + lane)) * 256 + (r & 255)] = a; }
    }
}
__device__ __forceinline__ void p7_norm2(const Frame& F, int layer) {
    LAS float* T = (LAS float*)F.lds;
    load_thin_T(F, F_WT + (size_t)(layer * 2 + 1) * 16384, T);
    const int gw = F.blk * NWAVES + F.wave, NGW = F.G * NWAVES, lane = F.lane;
    const int nrows = (layer < DEPTH - 1) ? NT : NL;
    const float* modl = F_MOD + (size_t)layer * 17 * 6144;
    const float* n2w = INP(I_N2W) + (size_t)layer * D;
    const bf16_t* const xb = F_XB; signed char* const HQp = F_HQ; float* const SAp = F_SA; float* const AFFp = F_AFF;
    u32x2 nva[4], nvb[4];
#define P7_SRC(r) (xb + (size_t)(r) * D)
#define P7_PRELOAD(r) do { const int ra_ = (r), rb_ = ((r) + NGW < nrows) ? (r) + NGW : (r); const bf16_t* sa_ = P7_SRC(ra_); const bf16_t* sb_ = P7_SRC(rb_); \
        _Pragma("unroll") for (int j = 0; j < 4; ++j) { nva[j] = *(const u32x2*)(sa_ + 4 * (lane + 64 * j)); nvb[j] = *(const u32x2*)(sb_ + 4 * (lane + 64 * j)); } } while (0)
    if (gw < nrows) P7_PRELOAD(gw);
    for (int row0 = gw; row0 < nrows; row0 += 2 * NGW) {
        const bool vB = (row0 + NGW) < nrows; const int rowA = row0, rowB = vB ? row0 + NGW : row0;
        f32x4 va[4], vb[4]; float sa = 0.f, sb = 0.f;
#pragma unroll
        for (int j = 0; j < 4; ++j) { va[j] = (f32x4){bflo(nva[j].x), bfhi(nva[j].x), bflo(nva[j].y), bfhi(nva[j].y)}; vb[j] = (f32x4){bflo(nvb[j].x), bfhi(nvb[j].x), bflo(nvb[j].y), bfhi(nvb[j].y)};
            sa += va[j][0] * va[j][0] + va[j][1] * va[j][1] + va[j][2] * va[j][2] + va[j][3] * va[j][3];
            sb += vb[j][0] * vb[j][0] + vb[j][1] * vb[j][1] + vb[j][2] * vb[j][2] + vb[j][3] * vb[j][3]; }
        if (row0 + 2 * NGW < nrows) P7_PRELOAD(row0 + 2 * NGW);
#pragma unroll
        for (int o = 1; o < 64; o <<= 1) { sa += shx(sa, o, lane); sb += shx(sb, o, lane); }
        asm volatile("" ::: "memory");
        float ma = 0.f, mb = 0.f;
        { const int mrow = (rowA < NL) ? (rowA >> 11) : 16; const float rstd = rsqrtf(sa * (1.f / D) + EPS);
          const float* sh = modl + mrow * 6144 + 3 * 1024; const float* sc = sh + 1024;
#pragma unroll
          for (int j = 0; j < 4; ++j) { const int k = 4 * (lane + 64 * j);
              const f32x4 w = *(const f32x4*)(n2w + k), s1 = *(const f32x4*)(sc + k), s0 = *(const f32x4*)(sh + k);
              const f32x4 h = va[j] * rstd * w * (s1 + 1.f) + s0;
              ma = fmaxf(fmaxf(ma, fmaxf(fabsf(h[0]), fabsf(h[1]))), fmaxf(fabsf(h[2]), fabsf(h[3])));
              va[j] = h; } }
        asm volatile("" ::: "memory");
        { const int mrow = (rowB < NL) ? (rowB >> 11) : 16; const float rstd = rsqrtf(sb * (1.f / D) + EPS);
          const float* sh = modl + mrow * 6144 + 3 * 1024; const float* sc = sh + 1024;
#pragma unroll
          for (int j = 0; j < 4; ++j) { const int k = 4 * (lane + 64 * j);
              const f32x4 w = *(const f32x4*)(n2w + k), s1 = *(const f32x4*)(sc + k), s0 = *(const f32x4*)(sh + k);
              const f32x4 h = vb[j] * rstd * w * (s1 + 1.f) + s0;
              mb = fmaxf(fmaxf(mb, fmaxf(fabsf(h[0]), fabsf(h[1]))), fmaxf(fabsf(h[2]), fabsf(h[3])));
              vb[j] = h; } }
        asm volatile("" ::: "memory");
#pragma unroll
        for (int o = 1; o < 64; o <<= 1) { ma = fmaxf(ma, shx(ma, o, lane)); mb = fmaxf(mb, shx(mb, o, lane)); }
        { const float ia = ma > 0.f ? 127.f / ma : 0.f, ib = mb > 0.f ? 127.f / mb : 0.f;
#pragma unroll
          for (int j = 0; j < 4; ++j) { const int k = 4 * (lane + 64 * j);
              unsigned qa = 0u, qb = 0u;
#pragma unroll
              for (int i = 0; i < 4; ++i) { qa |= ((unsigned)(int)rintf(va[j][i] * ia) & 0xffu) << (8 * i); qb |= ((unsigned)(int)rintf(vb[j][i] * ib) & 0xffu) << (8 * i); }
              *(unsigned*)(HQp + (size_t)rowA * D + k) = qa; if (vB) *(unsigned*)(HQp + (size_t)rowB * D + k) = qb; }
          if (lane == 0) { SAp[rowA] = ma * (1.f / 127.f); if (vB) SAp[rowB] = mb * (1.f / 127.f); } }
        asm volatile("" ::: "memory");
        float da[16], db[16];
        thin16x2(da, db, va, vb, T, lane);
        const float tota = reduce16(da, lane); const float totb = reduce16(db, lane);
        p7_finish_row(tota, lane, rowA, AFFp);
        if (vB) p7_finish_row(totb, lane, rowB, AFFp);
    }
#undef P7_PRELOAD
#undef P7_SRC
}

__device__ __forceinline__ void p5_ssd_post(const Frame& F, int layer) {
    const int gw = F.blk * NWAVES + F.wave, NGW = F.G * NWAVES, lane = F.lane;
    const int nrows = (layer < DEPTH - 1) ? NT : NL;
    const int c0 = 8 * lane;
    const float dsk = INP(I_DSKIP)[layer * 8 + (c0 >> 6)];
    const f32x4 w0 = *(const f32x4*)(INP(I_SSDNW) + layer * 512 + c0), w1 = *(const f32x4*)(INP(I_SSDNW) + layer * 512 + c0 + 4);
    const bf16_t* const YFp = F_YF; const bf16_t* const YBp = F_YB; const bf16_t* const XSp = F_XBCC; const bf16_t* const Zp = F_Z; bf16_t* const A2p = F_A2;
    u32x4 nyf[2], nyb[2], nxs[2], nz[2];
#define P5_LOAD(rr_) do { _Pragma("unroll") for (int q = 0; q < 2; ++q) { const int row = (rr_) + q; \
            nyf[q] = *(const u32x4*)(YFp + (size_t)row * 512 + c0); nyb[q] = *(const u32x4*)(YBp + (size_t)row * 512 + c0); \
            nxs[q] = *(const u32x4*)(XSp + (size_t)row * 1024 + c0); nz[q] = *(const u32x4*)(Zp + (size_t)row * 512 + c0); } } while (0)
    if (2 * gw < nrows) P5_LOAD(2 * gw);
    for (int r0 = 2 * gw; r0 < nrows; r0 += 2 * NGW) {
        u32x4 yf[2], yb[2], xs[2], z[2];
#pragma unroll
        for (int q = 0; q < 2; ++q) { yf[q] = nyf[q]; yb[q] = nyb[q]; xs[q] = nxs[q]; z[q] = nz[q]; }
        if (r0 + 2 * NGW < nrows) P5_LOAD(r0 + 2 * NGW);
#pragma unroll
        for (int q = 0; q < 2; ++q) { const int row = r0 + q;
            float g[8]; float ss = 0.f;
#pragma unroll
            for (int i = 0; i < 4; ++i) {
                const float y0 = bflo(yf[q][i]) + bflo(yb[q][i]) + dsk * bflo(xs[q][i]), y1 = bfhi(yf[q][i]) + bfhi(yb[q][i]) + dsk * bfhi(xs[q][i]);
                const float z0 = bflo(z[q][i]), z1 = bfhi(z[q][i]);
                g[2 * i] = y0 * z0 * __builtin_amdgcn_rcpf(1.f + __expf(-z0)); g[2 * i + 1] = y1 * z1 * __builtin_amdgcn_rcpf(1.f + __expf(-z1)); ss += g[2 * i] * g[2 * i] + g[2 * i + 1] * g[2 * i + 1]; }
#pragma unroll
            for (int o = 1; o < 32; o <<= 1) ss += shx(ss, o, lane);
            const float rstd = rsqrtf(ss * (1.f / 256.f) + EPS);
            u32x4 o; o.x = pk2(g[0] * rstd * w0[0], g[1] * rstd * w0[1]); o.y = pk2(g[2] * rstd * w0[2], g[3] * rstd * w0[3]);
            o.z = pk2(g[4] * rstd * w1[0], g[5] * rstd * w1[1]); o.w = pk2(g[6] * rstd * w1[2], g[7] * rstd * w1[3]);
            *(u32x4*)(A2p + (size_t)row * 1024 + 512 + c0) = o; }
    }
#undef P5_LOAD
}

struct EpiInProj {
    static constexpr bool PERM = false, AFTER_DRAIN = false;
    unsigned char* U; const float* qkw; const float* ropec; const float* ropes; const float* sah; const float* swin;
    __device__ __forceinline__ void operator()(const pg8::i32x4 (&acc)[2][2][4][2], const Unit& u, int wr, int wc, int fr, int fq) const {
        const int pn = u.pn;
        f32x4 swv[2][2];
#pragma unroll
        for (int bj = 0; bj < 2; ++bj)
#pragma unroll
            for (int n = 0; n < 2; ++n) swv[bj][n] = *(const f32x4*)(swin + pn * 256 + 128 * bj + 32 * wc + 16 * n + 4 * fq);
        if (pn < 4) {
            const bool isq = pn < 2; bf16_t* base = (bf16_t*)(U + (isq ? U_Q : U_K)); const float* nw = qkw + (isq ? 0 : 64); const float osc = isq ? 0.125f * LOG2E : 1.f;
            const int hg = 4 * (pn & 1) + wc;
            f32x4 w[2][2];
#pragma unroll
            for (int bj = 0; bj < 2; ++bj)
#pragma unroll
                for (int n = 0; n < 2; ++n) w[bj][n] = *(const f32x4*)(nw + 32 * bj + 16 * n + 4 * fq);
#pragma unroll
            for (int ai = 0; ai < 2; ++ai)
#pragma unroll
                for (int m = 0; m < 4; ++m) {
                    const int row = u.pm * 256 + ai * 128 + wr * 64 + m * 16 + fr;
                    float ss = 0.f; const float sa = sah[row]; f32x4 xf[2][2];
#pragma unroll
                    for (int bj = 0; bj < 2; ++bj)
#pragma unroll
                        for (int n = 0; n < 2; ++n) { f32x4 x;
#pragma unroll
                            for (int i = 0; i < 4; ++i) x[i] = (float)acc[ai][bj][m][n][i] * (sa * swv[bj][n][i]);
                            xf[bj][n] = x; ss += x[0] * x[0] + x[1] * x[1] + x[2] * x[2] + x[3] * x[3]; }
                    { const int ln = fq * 16 + fr; ss += shx(ss, 16, ln); ss += shx(ss, 32, ln); }
                    const float rstd = rsqrtf(ss * (1.f / 64.f) + EPS);
                    const bool lat = row < NL; const int tok = row & 2047;
#pragma unroll
                    for (int bj = 0; bj < 2; ++bj) {
                        f32x4 x1 = xf[bj][0] * rstd * w[bj][0], x2 = xf[bj][1] * rstd * w[bj][1];
                        if (lat) { const f32x4 c = *(const f32x4*)(ropec + tok * 32 + bj * 16 + 4 * fq), s = *(const f32x4*)(ropes + tok * 32 + bj * 16 + 4 * fq);
                            const f32x4 o1 = x1 * c - x2 * s, o2 = x1 * s + x2 * c; x1 = o1; x2 = o2; }
                        x1 = x1 * osc; x2 = x2 * osc;
                        bf16_t* p = base + (size_t)row * 512 + 64 * hg + 32 * bj + 4 * fq;
                        *(u32x2*)p = (u32x2){pk2(x1[0], x1[1]), pk2(x1[2], x1[3])};
                        *(u32x2*)(p + 16) = (u32x2){pk2(x2[0], x2[1]), pk2(x2[2], x2[3])};
                    }
                }
        } else {
            size_t boff; int cb, ldc;
            if (pn < 6) { boff = U_V; cb = 256 * (pn - 4); ldc = 512; } else if (pn < 8) { boff = U_Z; cb = 256 * (pn - 6); ldc = 512; } else { boff = U_XBC; cb = 256 * (pn - 8); ldc = 1024; }
            bf16_t* base = (bf16_t*)(U + boff);
#pragma unroll
            for (int ai = 0; ai < 2; ++ai)
#pragma unroll
                for (int m = 0; m < 4; ++m) {
                    const int row = u.pm * 256 + ai * 128 + wr * 64 + m * 16 + fr; const float sa = sah[row];
#pragma unroll
                    for (int bj = 0; bj < 2; ++bj) { f32x4 x0, x1;
#pragma unroll
                        for (int i = 0; i < 4; ++i) { x0[i] = (float)acc[ai][bj][m][0][i] * (sa * swv[bj][0][i]); x1[i] = (float)acc[ai][bj][m][1][i] * (sa * swv[bj][1][i]); }
                        *(u32x4*)(base + (size_t)row * ldc + cb + 128 * bj + 32 * wc + 8 * fq) = pack8(x0, x1); }
                }
        }
    }
};
struct EpiOutProj {
    static constexpr bool PERM = false, AFTER_DRAIN = false;
    const float* sl; const float* sc; bf16_t* xb; const float* modl; float gscale; bool first;
    __device__ __forceinline__ void operator()(const f32x4 (&acc)[2][2][4][2], const Unit& u, int wr, int wc, int fr, int fq) const {
        const int row_t = u.pm * 256; const bool lat = row_t < NL; const int mrow = lat ? (row_t >> 11) : 16;
        const float* g = modl + mrow * 6144 + 2048;
        f32x4 gv[2][2];
#pragma unroll
        for (int bj = 0; bj < 2; ++bj)
#pragma unroll
            for (int n = 0; n < 2; ++n) gv[bj][n] = *(const f32x4*)(g + u.pn * 256 + 128 * bj + 32 * wc + 8 * fq + 4 * n) * gscale;
        if (first) {
            const float* xs = lat ? sl : sc - (size_t)NL * D;
#pragma unroll
            for (int ai = 0; ai < 2; ++ai) {
                f32x4 xv[4][2][2];
#pragma unroll
                for (int m = 0; m < 4; ++m) { const size_t ro = (size_t)(row_t + ai * 128 + wr * 64 + m * 16 + fr) * D + u.pn * 256 + 32 * wc + 8 * fq;
#pragma unroll
                    for (int bj = 0; bj < 2; ++bj)
#pragma unroll
                        for (int n = 0; n < 2; ++n) xv[m][bj][n] = *(const f32x4*)(xs + ro + 128 * bj + 4 * n); }
#pragma unroll
                for (int m = 0; m < 4; ++m) { const size_t ro = (size_t)(row_t + ai * 128 + wr * 64 + m * 16 + fr) * D + u.pn * 256 + 32 * wc + 8 * fq;
#pragma unroll
                    for (int bj = 0; bj < 2; ++bj) *(u32x4*)(xb + ro + 128 * bj) = pack8(xv[m][bj][0] + gv[bj][0] * acc[ai][bj][m][0], xv[m][bj][1] + gv[bj][1] * acc[ai][bj][m][1]); }
            }
        } else {
#pragma unroll
            for (int ai = 0; ai < 2; ++ai) {
                u32x4 xr[4][2];
#pragma unroll
                for (int m = 0; m < 4; ++m) { const size_t ro = (size_t)(row_t + ai * 128 + wr * 64 + m * 16 + fr) * D + u.pn * 256 + 32 * wc + 8 * fq;
#pragma unroll
                    for (int bj = 0; bj < 2; ++bj) xr[m][bj] = *(const u32x4*)(xb + ro + 128 * bj); }
#pragma unroll
                for (int m = 0; m < 4; ++m) { const size_t ro = (size_t)(row_t + ai * 128 + wr * 64 + m * 16 + fr) * D + u.pn * 256 + 32 * wc + 8 * fq;
#pragma unroll
                    for (int bj = 0; bj < 2; ++bj) { const u32x4 r = xr[m][bj];
                        const f32x4 x0 = {bflo(r.x), bfhi(r.x), bflo(r.y), bfhi(r.y)}, x1 = {bflo(r.z), bfhi(r.z), bflo(r.w), bfhi(r.w)};
                        *(u32x4*)(xb + ro + 128 * bj) = pack8(x0 + gv[bj][0] * acc[ai][bj][m][0], x1 + gv[bj][1] * acc[ai][bj][m][1]); } }
            }
        }
    }
};
struct EpiMoe1 {
    static constexpr bool PERM = false, AFTER_DRAIN = false;
    bf16_t* HID; const float* sw; const float* say;
    __device__ __forceinline__ void operator()(const pg8::i32x4 (&acc)[2][2][4][2], const Unit& u, int wr, int wc, int fr, int fq) const {
        const int j = u.pn % 11;
        f32x4 sg[2], su[2];
#pragma unroll
        for (int n = 0; n < 2; ++n) { sg[n] = *(const f32x4*)(sw + (size_t)u.pn * 256 + 32 * wc + 16 * n + 4 * fq); su[n] = *(const f32x4*)(sw + (size_t)u.pn * 256 + 128 + 32 * wc + 16 * n + 4 * fq); }
#pragma unroll
        for (int ai = 0; ai < 2; ++ai)
#pragma unroll
            for (int m = 0; m < 4; ++m) {
                const int row = u.pm * 256 + ai * 128 + wr * 64 + m * 16 + fr; const float sa = say[row];
                f32x4 h0, h1;
#pragma unroll
                for (int i = 0; i < 4; ++i) { const float g0 = (float)acc[ai][0][m][0][i] * (sa * sg[0][i]), g1 = (float)acc[ai][0][m][1][i] * (sa * sg[1][i]);
                    const float u0 = (float)acc[ai][1][m][0][i] * (sa * su[0][i]), u1 = (float)acc[ai][1][m][1][i] * (sa * su[1][i]);
                    h0[i] = g0 * __builtin_amdgcn_rcpf(1.f + __expf(-g0)) * u0; h1[i] = g1 * __builtin_amdgcn_rcpf(1.f + __expf(-g1)) * u1; }
                *(u32x4*)(HID + (size_t)row * DE + 128 * j + 32 * wc + 8 * fq) = pack8(h0, h1);
            }
    }
};
struct EpiMoe2 {
    static constexpr bool PERM = false, AFTER_DRAIN = false;
    bf16_t* Y; const float* gate;
    __device__ __forceinline__ void operator()(const f32x4 (&acc)[2][2][4][2], const Unit& u, int wr, int wc, int fr, int fq) const {
        const int jn = u.pn & 3;
#pragma unroll
        for (int ai = 0; ai < 2; ++ai)
#pragma unroll
            for (int m = 0; m < 4; ++m) {
                const int row = u.pm * 256 + ai * 128 + wr * 64 + m * 16 + fr; const float gt = gate[row];
#pragma unroll
                for (int bj = 0; bj < 2; ++bj) *(u32x4*)(Y + (size_t)row * D + 256 * jn + 128 * bj + 32 * wc + 8 * fq) = pack8(acc[ai][bj][m][0] * gt, acc[ai][bj][m][1] * gt);
            }
    }
};
struct SchedMoe1 {
    int G, c, ctx;
    __device__ __forceinline__ bool next(int i, Unit& u) const {
        if (G & 7) { const int L = i * G + c, nt = ctx ? 3168 : 2816; if (L >= nt) return false;
            if (L < 2816) { const int e = L / 176, rem = L % 176, j = rem >> 4, b = rem & 15; u.pm = b * 16 + e; u.pn = e * 11 + j; }
            else { const int LL = L - 2816, e = LL / 22, rem = LL % 22, j = rem >> 1, hf = rem & 1; u.pm = 256 + 2 * e + hf; u.pn = e * 11 + j; }
            return true; }
        const int W = G >> 3, x = c & 7, q = i * W + (c >> 3), nq = ctx ? 396 : 352;
        if (q >= nq) return false;
        if (q < 352) { const int el = q / 176, rem = q % 176, bg = rem / 44, rem2 = rem % 44, j = rem2 >> 2, bb = rem2 & 3, e = 2 * x + el, b = 4 * bg + bb; u.pm = b * 16 + e; u.pn = e * 11 + j; }
        else { const int qq = q - 352, el = qq / 22, rem = qq % 22, j = rem >> 1, hf = rem & 1, e = 2 * x + el; u.pm = 256 + 2 * e + hf; u.pn = e * 11 + j; }
        return true;
    }
    __device__ __forceinline__ void a_ready(const Unit&) const {}
    __device__ __forceinline__ void done(const Unit&) const {}
};
struct SchedMoe2 {
    int G, c, ctx;
    __device__ __forceinline__ bool next(int i, Unit& u) const {
        if (G & 7) { const int L = i * G + c, nt = ctx ? 1152 : 1024; if (L >= nt) return false;
            if (L < 1024) { const int e = L >> 6, rem = L & 63, j = rem >> 4, b = rem & 15; u.pm = b * 16 + e; u.pn = e * 4 + j; }
            else { const int LL = L - 1024, e = LL >> 3, rem = LL & 7, j = rem >> 1, hf = rem & 1; u.pm = 256 + 2 * e + hf; u.pn = e * 4 + j; }
            return true; }
        const int W = G >> 3, x = c & 7, q = i * W + (c >> 3), nq = ctx ? 144 : 128;
        if (q >= nq) return false;
        if (q < 128) { const int el = q >> 6, rem = q & 63, bg = rem >> 5, j = (rem & 31) >> 3, bb = rem & 7, e = 2 * x + el, b = 8 * bg + bb; u.pm = b * 16 + e; u.pn = e * 4 + j; }
        else { const int qq = q - 128, el = qq >> 3, rem = qq & 7, j = rem >> 1, hf = rem & 1, e = 2 * x + el; u.pm = 256 + 2 * e + hf; u.pn = e * 4 + j; }
        return true;
    }
    __device__ __forceinline__ void a_ready(const Unit&) const {}
    __device__ __forceinline__ void done(const Unit&) const {}
};

__device__ __forceinline__ void chunk_rows(int chunk, int& row0, int& slo, int& shi) {
    if (chunk < 256) { const int b = chunk >> 4, c = chunk & 15; slo = b * SEQ; shi = slo + SEQ; row0 = slo + 128 * c; }
    else { const int cc = chunk - 256, b = cc >> 1, c = cc & 1; slo = NL + b * CTXL; shi = slo + CTXL; row0 = slo + 128 * c; }
}
struct ConvW { f32x4 w[3][2]; f32x4 b[2]; };
__device__ __forceinline__ void conv_load_w(ConvW& cw, const float* convw, const float* convb, int ch0) {
#pragma unroll
    for (int t = 0; t < 3; ++t) { cw.w[t][0] = *(const f32x4*)(convw + t * 1024 + ch0); cw.w[t][1] = *(const f32x4*)(convw + t * 1024 + ch0 + 4); }
    cw.b[0] = *(const f32x4*)(convb + ch0); cw.b[1] = *(const f32x4*)(convb + ch0 + 4);
}
__device__ __forceinline__ float silu_fast(float x) { return x * __builtin_amdgcn_rcpf(1.f + __expf(-x)); }
__device__ __forceinline__ u32x4 conv8v(const ConvW& cw, const u32x4 xp, const u32x4 xc, const u32x4 xn) {
    float o[8];
#pragma unroll
    for (int i = 0; i < 4; ++i) {
        const int h = i >> 1, k = 2 * (i & 1);
        const float a0 = cw.b[h][k] + cw.w[0][h][k] * bflo(xp[i]) + cw.w[1][h][k] * bflo(xc[i]) + cw.w[2][h][k] * bflo(xn[i]);
        const float a1 = cw.b[h][k + 1] + cw.w[0][h][k + 1] * bfhi(xp[i]) + cw.w[1][h][k + 1] * bfhi(xc[i]) + cw.w[2][h][k + 1] * bfhi(xn[i]);
        o[2 * i] = silu_fast(a0); o[2 * i + 1] = silu_fast(a1);
    }
    u32x4 r; r.x = pk2(o[0], o[1]); r.y = pk2(o[2], o[3]); r.z = pk2(o[4], o[5]); r.w = pk2(o[6], o[7]); return r;
}
constexpr int CV_STRIDE = 272;
template <int R, bool TO_LDS>
__device__ __forceinline__ void conv_rows(const ConvW& cw, const bf16_t* __restrict__ XBCp, bf16_t* __restrict__ XBCCp, int rfirst, int row0, int slo, int shi, int ch0, LAS unsigned char* T, int tcol) {
    u32x4 x[R + 2];
#pragma unroll
    for (int i = 0; i < R + 2; ++i) { const int row = row0 + rfirst + i - 1; x[i] = (row >= slo && row < shi) ? *(const u32x4*)(XBCp + (size_t)row * 1024 + ch0) : (u32x4){0u, 0u, 0u, 0u}; }
#pragma unroll
    for (int i = 0; i < R; ++i) { const u32x4 v = conv8v(cw, x[i], x[i + 1], x[i + 2]); *(u32x4*)(XBCCp + (size_t)(row0 + rfirst + i) * 1024 + ch0) = v;
        if (TO_LDS) *(LAS u32x4*)(T + (rfirst + i) * CV_STRIDE + tcol * 16) = v; }
}
__device__ __forceinline__ void p3_conv(const Frame& F, int layer) {
    const float* convw = INP(I_CONVW) + (size_t)layer * 3 * 1024; const float* convb = INP(I_CONVB) + (size_t)layer * 1024;
    LAS unsigned char* Bt = F.lds; LAS unsigned char* Ct = F.lds + 128 * CV_STRIDE;
    const int tid = F.tid, lane = F.lane, wave = F.wave;
    const bf16_t* const XBCp = F_XBC; bf16_t* const XBCCp = F_XBCC; bf16_t* const GMp = F_GM;
    for (int u = F.blk; u < 288 * 3; u += F.G) {
        const int chunk = u / 3, part = u % 3; int row0, slo, shi; chunk_rows(chunk, row0, slo, shi);
        if (part == 0) {
            const int ch0 = 8 * (tid & 63), rg = tid >> 6; ConvW cw; conv_load_w(cw, convw, convb, ch0);
            conv_rows<16, false>(cw, XBCp, XBCCp, 16 * rg, row0, slo, shi, ch0, Bt, 0);
        } else {
            const int g = part - 1, cg = tid & 31, rg = tid >> 5;
            const int ch0 = (cg < 16) ? (512 + 128 * g + 8 * cg) : (768 + 128 * g + 8 * (cg - 16));
            ConvW cw; conv_load_w(cw, convw, convb, ch0);
            conv_rows<8, true>(cw, XBCp, XBCCp, 8 * rg, row0, slo, shi, ch0, (cg < 16) ? Bt : Ct, cg & 15);
            __syncthreads();
            bf16_t* gm = GMp + (size_t)(chunk * 2 + g) * 128 * 128;
#pragma unroll
            for (int i = 0; i < 2; ++i) { const int blk = 2 * wave + i, lb = blk >> 2, sb = blk & 3;
                f32x16 acc = {};
#pragma unroll
                for (int ks = 0; ks < 8; ++ks) acc = MFMA32(frag_rm(Ct, CV_STRIDE, 32 * lb, 16 * ks, lane), frag_rm(Bt, CV_STRIDE, 32 * sb, 16 * ks, lane), acc);
#pragma unroll
                for (int t = 0; t < 16; ++t) gm[(32 * lb + accrow(t, lane >> 5)) * 128 + 32 * sb + (lane & 31)] = f2bf(acc[t]);
            }
            __syncthreads();
        }
    }
}

constexpr int SS_XS = 0, SS_XS_STRIDE = 144;
constexpr int SS_BM = 18432;
constexpr int SS_CM = SS_BM + 34816;
constexpr int SS_GM = SS_CM + 34816;
constexpr int SS_H = SS_GM + 34816, SS_H_BYTES = 64 * 272;
constexpr int SS_SC = SS_H + SS_H_BYTES;
static_assert(SS_SC + 4 * 512 + 16 <= MISC_OFF, "ssd lds");
__device__ __forceinline__ int ssd_chunk_of(int dir, int b, int step) {
    if (dir == 0) return (step < 2) ? (256 + 2 * b + step) : (16 * b + (step - 2));
    return (step < 2) ? (256 + 2 * b + (1 - step)) : (16 * b + (17 - step));
}
__device__ __forceinline__ void ssd_unit(const Frame& F, int layer, int unit) {
    int tid_ = F.tid; asm volatile("" : "+v"(tid_));
    const int tid = tid_, lane = tid & 63, wave = __builtin_amdgcn_readfirstlane(tid >> 6);
    const int dir = unit & 1, hd = (unit >> 1) & 7, b = unit >> 4, g = hd >> 2;
    LAS unsigned char* L = F.lds;
    LAS float* acs = (LAS float*)(L + SS_SC); LAS float* dtv = acs + 128; LAS float* wrow = acs + 256; LAS float* erow = acs + 384; LAS float* aendp = acs + 512;
    const float a_coef = -__expf((dir ? INP(I_ALOGB) : INP(I_ALOGF))[layer * 8 + hd]);
    unsigned vz; asm volatile("v_mov_b32 %0, 0" : "=v"(vz));
    bf16_t* Yout = (dir ? F_YB : F_YF) + vz; const bf16_t* const XBCCp = F_XBCC + vz; const bf16_t* const GMp = F_GM + vz; const float* const DTp = F_DT + vz;
    f32x16 hacc = {};
    for (int prb = 0; prb < ((PROBE_MASK & 256) ? 2 : 1); ++prb) {
    for (int i = tid; i < SS_H_BYTES / 4; i += NTHREADS) ((LAS unsigned*)(L + SS_H))[i] = 0u;
    hacc = (f32x16){};
    u32x4 rx[2], rb[4], rc[4], rg[4]; float rd0 = 0.f, rd1 = 0.f;
#define SS_LOAD(step_) do { const int ck_ = ssd_chunk_of(dir, b, (step_)); int r0_, lo_, hi_; chunk_rows(ck_, r0_, lo_, hi_); \
        _Pragma("unroll") for (int i = 0; i < 2; ++i) { const int idx = tid + 512 * i, r = idx >> 3, ch = idx & 7; rx[i] = *(const u32x4*)(XBCCp + (size_t)(r0_ + r) * 1024 + hd * 64 + ch * 8); } \
        const bf16_t* gmp_ = GMp + (size_t)(ck_ * 2 + g) * 128 * 128; \
        _Pragma("unroll") for (int i = 0; i < 4; ++i) { const int idx = tid + 512 * i, r = idx >> 4, ch = idx & 15; \
            rb[i] = *(const u32x4*)(XBCCp + (size_t)(r0_ + r) * 1024 + 512 + 128 * g + ch * 8); rc[i] = *(const u32x4*)(XBCCp + (size_t)(r0_ + r) * 1024 + 768 + 128 * g + ch * 8); \
            rg[i] = *(const u32x4*)(gmp_ + r * 128 + ch * 8); } \
        if (wave == 7) { rd0 = DTp[(size_t)(r0_ + 2 * lane) * 16 + dir * 8 + hd]; rd1 = DTp[(size_t)(r0_ + 2 * lane + 1) * 16 + dir * 8 + hd]; } } while (0)
#define SS_STORE() do { \
        _Pragma("unroll") for (int i = 0; i < 2; ++i) { const int idx = tid + 512 * i, r = idx >> 3, ch = idx & 7; *(LAS u32x4*)(L + SS_XS + r * SS_XS_STRIDE + ch * 16) = rx[i]; } \
        _Pragma("unroll") for (int i = 0; i < 4; ++i) { const int idx = tid + 512 * i, r = idx >> 4, ch = idx & 15; \
            *(LAS u32x4*)(L + SS_BM + r * 272 + ch * 16) = rb[i]; *(LAS u32x4*)(L + SS_CM + r * 272 + ch * 16) = rc[i]; *(LAS u32x4*)(L + SS_GM + r * 272 + ch * 16) = rg[i]; } } while (0)
    SS_LOAD(0);
    SS_STORE();
    for (int step = 0; step < 18; ++step) {
        const int chunk = ssd_chunk_of(dir, b, step);
        int row0, slo, shi; chunk_rows(chunk, row0, slo, shi);
        int tid2 = tid, lane2 = lane; asm volatile("" : "+v"(tid2), "+v"(lane2));
        if (wave == 7) {
            const float d0 = rd0, d1 = rd1;
            const float da0 = d0 * a_coef, da1 = d1 * a_coef; const float ps = da0 + da1;
            float inc = ps; float c0v, c1v;
            if (dir == 0) {
#pragma unroll
                for (int o = 1; o < 64; o <<= 1) { const float t = shl_from(inc, lane2 - o); if (lane2 >= o) inc += t; }
                c0v = inc - da1; c1v = inc;
            } else {
#pragma unroll
                for (int o = 1; o < 64; o <<= 1) { const float t = shl_from(inc, lane2 + o); if (lane2 + o < 64) inc += t; }
                c0v = inc; c1v = inc - da0;
            }
            const float tot = shl_from(inc, dir ? 0 : 63);
            acs[2 * lane2] = c0v; acs[2 * lane2 + 1] = c1v; dtv[2 * lane2] = d0; dtv[2 * lane2 + 1] = d1;
            wrow[2 * lane2] = __expf(tot - c0v) * d0; wrow[2 * lane2 + 1] = __expf(tot - c1v) * d1;
            erow[2 * lane2] = __expf(c0v); erow[2 * lane2 + 1] = __expf(c1v);
            if (lane2 == 0) aendp[0] = __expf(tot);
        }
        if (step + 1 < 18) SS_LOAD(step + 1);
        lds_barrier();
        {
            u32x4 vg[4], vb[4]; float alr[4], wr_[4]; f32x4 ac0[4], ac1[4], dq0[4], dq1[4];
#pragma unroll
            for (int i = 0; i < 4; ++i) { const int idx = tid2 + 512 * i, r = idx >> 4, ch = idx & 15, s0 = ch * 8;
                vg[i] = *(LAS const u32x4*)(L + SS_GM + r * 272 + ch * 16); vb[i] = *(LAS const u32x4*)(L + SS_BM + r * 272 + ch * 16);
                alr[i] = acs[r]; wr_[i] = wrow[r];
                ac0[i] = *(LAS const f32x4*)(acs + s0); ac1[i] = *(LAS const f32x4*)(acs + s0 + 4); dq0[i] = *(LAS const f32x4*)(dtv + s0); dq1[i] = *(LAS const f32x4*)(dtv + s0 + 4); }
#pragma unroll
            for (int i = 0; i < 4; ++i) { const int idx = tid2 + 512 * i, r = idx >> 4, ch = idx & 15, s0 = ch * 8; float o[8];
#pragma unroll
                for (int e = 0; e < 8; ++e) { const int s = s0 + e; const bool ok = dir ? (s >= r) : (s <= r);
                    const float acv = (e < 4) ? ac0[i][e & 3] : ac1[i][e & 3], dtq = (e < 4) ? dq0[i][e & 3] : dq1[i][e & 3];
                    const float gv = (e & 1) ? bfhi(vg[i][e >> 1]) : bflo(vg[i][e >> 1]); o[e] = ok ? gv * __expf(alr[i] - acv) * dtq : 0.f; }
                u32x4 w; w.x = pk2(o[0], o[1]); w.y = pk2(o[2], o[3]); w.z = pk2(o[4], o[5]); w.w = pk2(o[6], o[7]); *(LAS u32x4*)(L + SS_GM + r * 272 + ch * 16) = w;
                u32x4 wb;
#pragma unroll
                for (int e = 0; e < 4; ++e) wb[e] = pk2(bflo(vb[i][e]) * wr_[i], bfhi(vb[i][e]) * wr_[i]);
                *(LAS u32x4*)(L + SS_BM + r * 272 + ch * 16) = wb; }
        }
        lds_barrier();
        {
            const int lb = wave >> 1, pb = wave & 1; f32x16 y = {}, yo = {};
            bf16x8 fa[8], fb[8];
#pragma unroll
            for (int ks = 0; ks < 8; ++ks) { fa[ks] = frag_rm(L + SS_GM, 272, 32 * lb, 16 * ks, lane); fb[ks] = frag_tr(L + SS_XS, SS_XS_STRIDE, 16 * ks, 32 * pb, lane); }
            __builtin_amdgcn_sched_barrier(0);
#pragma unroll
            for (int ks = 0; ks < 8; ++ks) y = MFMA32(fa[ks], fb[ks], y);
#pragma unroll
            for (int ks = 0; ks < 8; ++ks) { fa[ks] = frag_rm(L + SS_CM, 272, 32 * lb, 16 * ks, lane); fb[ks] = frag_rm(L + SS_H, 272, 32 * pb, 16 * ks, lane); }
            __builtin_amdgcn_sched_barrier(0);
#pragma unroll
            for (int ks = 0; ks < 8; ++ks) yo = MFMA32(fa[ks], fb[ks], yo);
            __builtin_amdgcn_sched_barrier(0);
#pragma unroll
            for (int t = 0; t < 16; ++t) { const int l = 32 * lb + accrow(t, lane >> 5); Yout[(size_t)(row0 + l) * 512 + hd * 64 + 32 * pb + (lane & 31)] = f2bf(y[t] + erow[l] * yo[t]); }
        }
        lds_barrier();
        {
            const int pb = wave & 1, nb = wave >> 1; const float dec = aendp[0];
            bf16x8 fa[8], fb[8];
#pragma unroll
            for (int ks = 0; ks < 8; ++ks) { fa[ks] = frag_tr(L + SS_XS, SS_XS_STRIDE, 16 * ks, 32 * pb, lane); fb[ks] = frag_tr(L + SS_BM, 272, 16 * ks, 32 * nb, lane); }
#pragma unroll
            for (int t = 0; t < 16; ++t) hacc[t] *= dec;
            __builtin_amdgcn_sched_barrier(0);
#pragma unroll
            for (int ks = 0; ks < 8; ++ks) hacc = MFMA32(fa[ks], fb[ks], hacc);
#pragma unroll
            for (int t = 0; t < 16; ++t) *(LAS bf16_t*)(L + SS_H + (32 * pb + accrow(t, lane >> 5)) * 272 + (32 * nb + (lane & 31)) * 2) = f2bf(hacc[t]);
        }
        lds_barrier();
        if (step + 1 < 18) SS_STORE();
    }
    __syncthreads();
    }
#undef SS_LOAD
#undef SS_STORE
    __syncthreads();
}

constexpr int AT_KSTR = 272, AT_VSTR = 320, AT_KBYTES = 64 * AT_KSTR, AT_VBYTES = 64 * AT_VSTR;
constexpr int AT_K = 0, AT_V = 2 * AT_KBYTES, AT_LX = AT_V + 2 * AT_VBYTES;
__device__ __forceinline__ void attn_unit(const Frame& F, int layer, int qrow0, int ntiles, int b, int head, float lam, float m2, float lam_init) {
    int tid_ = F.tid; asm volatile("" : "+v"(tid_));
    const int tid = tid_, lane = tid & 63, wave = __builtin_amdgcn_readfirstlane(tid >> 6), r32 = lane & 31, hh = lane >> 5;
    const int mp = wave & 1, qg = wave >> 1;
    LAS unsigned char* L = F.lds;
    const bf16_t* const Kp = F_K + head * 128; const bf16_t* const Vp = F_V + head * 128; bf16_t* const A2p = F_A2;
    bf16x8 qf[4];
    { const bf16_t* qp = F_Q + (size_t)(qrow0 + 32 * qg + r32) * 512 + head * 128 + mp * 64 + 8 * hh;
#pragma unroll
      for (int d0 = 0; d0 < 4; ++d0) qf[d0] = *(const bf16x8*)(qp + d0 * 16); }
    f32x16 o[4];
#pragma unroll
    for (int j = 0; j < 4; ++j) o[j] = (f32x16){};
    float lsum = 0.f;
    f32x16 negm;
    { float m2l = m2; asm volatile("" : "+v"(m2l));
#pragma unroll
      for (int t = 0; t < 16; ++t) negm[t] = -m2l; }
    u32x4 kreg[2], vreg[2];
    const int prow0 = tid >> 4, pch = tid & 15;
#define AT_KROW(t) (((t) < 4) ? (NL + b * CTXL + 64 * (t)) : (b * SEQ + 64 * ((t) - 4)))
#define AT_LOADK(t) do { const int kr_ = AT_KROW(t); _Pragma("unroll") for (int i_ = 0; i_ < 2; ++i_) kreg[i_] = *(const u32x4*)(Kp + (size_t)(kr_ + prow0 + 32 * i_) * 512 + pch * 8); } while (0)
#define AT_LOADV(t) do { const int kr_ = AT_KROW(t); _Pragma("unroll") for (int i_ = 0; i_ < 2; ++i_) vreg[i_] = *(const u32x4*)(Vp + (size_t)(kr_ + prow0 + 32 * i_) * 512 + pch * 8); } while (0)
#define AT_STOREK(st) do { _Pragma("unroll") for (int i_ = 0; i_ < 2; ++i_) *(LAS u32x4*)(L + AT_K + (st) * AT_KBYTES + (prow0 + 32 * i_) * AT_KSTR + pch * 16) = kreg[i_]; } while (0)
#define AT_STOREV(st) do { _Pragma("unroll") for (int i_ = 0; i_ < 2; ++i_) *(LAS u32x4*)(L + AT_V + (st) * AT_VBYTES + (prow0 + 32 * i_) * AT_VSTR + pch * 16) = vreg[i_]; } while (0)
#define AT_QK(SA, SB, st) do { LAS const unsigned char* Kt_ = L + AT_K + (st) * AT_KBYTES + r32 * AT_KSTR + (mp * 64 + 8 * hh) * 2; SA = negm; SB = negm; \
        _Pragma("unroll") for (int d0 = 0; d0 < 4; ++d0) { const bf16x8 ka = *(LAS const bf16x8*)(Kt_ + d0 * 32); const bf16x8 kb = *(LAS const bf16x8*)(Kt_ + 32 * AT_KSTR + d0 * 32); \
            __builtin_amdgcn_s_setprio(1); SA = MFMA32(ka, qf[d0], SA); SB = MFMA32(kb, qf[d0], SB); __builtin_amdgcn_s_setprio(0); } } while (0)
    AT_LOADK(0); AT_LOADV(0); AT_STOREK(0); AT_STOREV(0);
    if (ntiles > 1) { AT_LOADK(1); AT_STOREK(1); }
    __syncthreads();
    f32x16 sa, sb, na, nb;
    AT_QK(sa, sb, 0);
    lds_barrier();
    for (int t = 0; t < ntiles; ++t) {
        if (t + 2 < ntiles) AT_LOADK(t + 2);
        if (t + 1 < ntiles) AT_LOADV(t + 1);
        if (t + 1 < ntiles) AT_QK(na, nb, (t + 1) & 1);
        float ls = 0.f;
#pragma unroll
        for (int i = 0; i < 16; ++i) { sa[i] = __builtin_amdgcn_exp2f(sa[i]); sb[i] = __builtin_amdgcn_exp2f(sb[i]); ls += sa[i] + sb[i]; }
        lsum += ls;
        bf16x8 pk[4];
        { u32x4 w0, w1, w2, w3;
#pragma unroll
          for (int i = 0; i < 4; ++i) { w0[i] = pk2(sa[2 * i], sa[2 * i + 1]); w1[i] = pk2(sa[8 + 2 * i], sa[9 + 2 * i]); w2[i] = pk2(sb[2 * i], sb[2 * i + 1]); w3[i] = pk2(sb[8 + 2 * i], sb[9 + 2 * i]); }
          pk[0] = __builtin_bit_cast(bf16x8, w0); pk[1] = __builtin_bit_cast(bf16x8, w1); pk[2] = __builtin_bit_cast(bf16x8, w2); pk[3] = __builtin_bit_cast(bf16x8, w3); }
        LAS const unsigned char* Vt = L + AT_V + (t & 1) * AT_VBYTES;
        __builtin_amdgcn_sched_barrier(0);
        bf16x8 vfa[4], vfb[4];
#pragma unroll
        for (int j = 0; j < 4; ++j) vfa[j] = frag_tr_acc(Vt, AT_VSTR, 0, 32 * j, lane);
#pragma unroll
        for (int ks = 0; ks < 4; ks += 2) {
#pragma unroll
            for (int j = 0; j < 4; ++j) vfb[j] = frag_tr_acc(Vt, AT_VSTR, 16 * (ks + 1), 32 * j, lane);
            __builtin_amdgcn_s_setprio(1);
#pragma unroll
            for (int j = 0; j < 4; ++j) o[j] = MFMA32(pk[ks], vfa[j], o[j]);
            __builtin_amdgcn_s_setprio(0);
            __builtin_amdgcn_sched_barrier(0);
            if (ks + 2 < 4) {
#pragma unroll
                for (int j = 0; j < 4; ++j) vfa[j] = frag_tr_acc(Vt, AT_VSTR, 16 * (ks + 2), 32 * j, lane);
            }
            __builtin_amdgcn_s_setprio(1);
#pragma unroll
            for (int j = 0; j < 4; ++j) o[j] = MFMA32(pk[ks + 1], vfb[j], o[j]);
            __builtin_amdgcn_s_setprio(0);
            __builtin_amdgcn_sched_barrier(0);
        }
        if (t + 2 < ntiles) AT_STOREK(t & 1);
        if (t + 1 < ntiles) AT_STOREV((t + 1) & 1);
        __syncthreads();
        sa = na; sb = nb;
    }
#undef AT_LOADK
#undef AT_LOADV
#undef AT_STOREK
#undef AT_STOREV
#undef AT_QK
#undef AT_KROW
    int lane_e = lane; asm volatile("" : "+v"(lane_e));
#define r32 r32e
#define hh hhe
    const int r32e = lane_e & 31, hhe = lane_e >> 5;
    LAS float* lx = (LAS float*)(L + AT_LX + wave * 256);
    { const float l0 = lsum + shx(lsum, 32, lane_e); if (hh == 0) lx[r32] = (mp ? lam : 1.f) / l0; }
    LDS_WAIT();
    LAS float* X = (LAS float*)(L + qg * 16384);
    float isc[16];
#pragma unroll
    for (int t = 0; t < 16; ++t) isc[t] = lx[accrow(t, hh)];
    if (mp == 1) {
#pragma unroll
        for (int t = 0; t < 16; ++t)
#pragma unroll
            for (int j = 0; j < 4; ++j) X[accrow(t, hh) * 128 + 32 * j + r32] = o[j][t] * isc[t];
    }
    __syncthreads();
    if (mp == 0) {
        const float* sw = INP(I_SUBLN) + layer * 128;
        float swv[4];
#pragma unroll
        for (int j = 0; j < 4; ++j) swv[j] = sw[32 * j + r32] * (1.f - lam_init);
#pragma unroll
        for (int t = 0; t < 16; ++t) {
            const int q = accrow(t, hh);
            float v[4]; float ss = 0.f;
#pragma unroll
            for (int j = 0; j < 4; ++j) { v[j] = o[j][t] * isc[t] - X[q * 128 + 32 * j + r32]; ss += v[j] * v[j]; }
#pragma unroll
            for (int of = 1; of < 32; of <<= 1) ss += shx(ss, of, lane_e);
            const float rstd = rsqrtf(ss * (1.f / 128.f) + EPS);
            bf16_t* op = A2p + (size_t)(qrow0 + 32 * qg + q) * 1024 + head * 128 + r32;
#pragma unroll
            for (int j = 0; j < 4; ++j) op[32 * j] = f2bf(v[j] * rstd * swv[j]);
        }
    }
#undef r32
#undef hh
    __syncthreads();
}

__device__ __forceinline__ void p4_mixer(const Frame& F, int layer, int rep) {
    const int lane = F.lane;
    const float lam_init = 0.8f - 0.6f * __expf(-0.3f * (float)layer);
    const float p1 = wave_sum(INP(I_LQ1)[layer * 64 + lane] * INP(I_LK1)[layer * 64 + lane]);
    const float p2 = wave_sum(INP(I_LQ2)[layer * 64 + lane] * INP(I_LK2)[layer * 64 + lane]);
    const float lam = __expf(p1) - __expf(p2) + lam_init;
    const float qmx = wave_max(fabsf(INP(I_QNW)[layer * 64 + lane])), kmx = wave_max(fabsf(INP(I_KNW)[layer * 64 + lane]));
    const float m2 = 8.f * qmx * kmx * LOG2E * 1.01f;
    const int na = (layer < DEPTH - 1) ? 128 + 16 : 128;
    const int nq = 32 + na + CVB / 8;
    volatile LAS unsigned* bc = (volatile LAS unsigned*)(F.lds + MISC_OFF) + 16;
    const int myx = (int)(__builtin_amdgcn_s_getreg((3 << 11) | 20) & 7u);
    unsigned* const wq = F_CTL + CW_WQ + 1024 * (layer + 4 * rep);
    for (int qi = 0; qi < 8; ++qi) {
        const int x = (myx + qi) & 7;
        for (;;) {
            if (F.tid == 0) bc[0] = __hip_atomic_fetch_add(wq + 64 * x, 1u, __ATOMIC_RELAXED, __HIP_MEMORY_SCOPE_AGENT);
            __syncthreads();
            const int it = (int)bc[0];
            __syncthreads();
            if (it >= nq) break;
            if (it < 32) {
#ifndef SKIP_SSD
                const int grp = 4 * x + (it >> 3), m = it & 7, b = grp >> 1, g = grp & 1, hd = 4 * g + (m >> 1), dir = m & 1;
                ssd_unit(F, layer, (b << 4) | (hd << 1) | dir);
#endif
            } else {
                const int p = it - 32; int a = -1, cv = -1;
                if (p < 2 * na) { if (p & 1) cv = p >> 1; else a = p >> 1; } else cv = p - na;
                if (cv >= 0) { const int g = x + 8 * cv; Frame Fc = F; Fc.lane = lane_id_v(); Fc.tid = Fc.wave * 64 + Fc.lane;
                    if (g < CVB_WGU) cvt_wgu_block(Fc, layer, g); else cvt_layer_item(Fc, layer, CV_SMALL + CV_WGU + 8 * (g - CVB_WGU) + Fc.wave, (LAS float*)(Fc.lds + Fc.wave * 17408)); }
#ifndef SKIP_ATT
                else
                for (int pr = 0; pr < ((PROBE_MASK & 512) ? 2 : 1); ++pr)
                if (a < 128) { const int c = 8 * (a >> 4) + x, qb = a & 15, b = c >> 2, head = c & 3; attn_unit(F, layer, b * SEQ + 128 * qb, 36, b, head, lam, m2, lam_init); }
                else { const int a2 = a - 128, c = 8 * (a2 >> 1) + x, qb = a2 & 1, b = c >> 2, head = c & 3; attn_unit(F, layer, NL + b * CTXL + 128 * qb, 4, b, head, lam, m2, lam_init); }
#endif
            }
        }
    }
}

__device__ __forceinline__ void p8_topk(const Frame& F, int layer) {
    const int tid = F.tid, lane = F.lane, wave = F.wave;
    LAS unsigned* cnt = (LAS unsigned*)F.lds;
    LAS unsigned* cg = cnt + 16;
    LAS unsigned* ce = cnt + 48;
    LAS int* sidx = (LAS int*)(F.lds + 1024);
    const int nunits = (layer < DEPTH - 1) ? 512 : 256;
    const float* const AFFp = F_AFF; float* const GATEp = F_GATE; int* const INVp = F_INV; unsigned* const ROFFp = F_ROFF; const float* const SAp = F_SA; float* const SAYp = F_SAY;
    const unsigned long long lt_mask = (lane == 0) ? 0ull : (~0ull >> (64 - lane));
    for (int u = F.blk; u < nunits; u += F.G) {
        const bool lat = u < 256; const int uu = lat ? u : u - 256, b = uu >> 4, e = uu & 15;
        const int n = lat ? SEQ : CTXL, cap = lat ? 256 : 32;
        const float* av = lat ? AFFp + (size_t)uu * 2048 : AFFp + (size_t)NL * 16 + (size_t)uu * 256;
        const int rowb = lat ? b * SEQ : NL + b * CTXL;
        const int yb = lat ? (b * 16 + e) * 256 : (256 + 2 * e + (b >> 3)) * 256 + (b & 7) * 32;
        unsigned v[4];
#pragma unroll
        for (int k = 0; k < 4; ++k) { const int i = tid + 512 * k; v[k] = (i < n) ? __float_as_uint(av[i]) : 0u; }
        unsigned T = 0u;
        for (int bit = 30; bit >= 0; --bit) {
            const unsigned cand = T | (1u << bit); const int par = bit & 1;
            unsigned c = 0;
#pragma unroll
            for (int k = 0; k < 4; ++k) c += (unsigned)__popcll(__ballot(v[k] >= cand));
            if (lane == 0) cnt[par * 8 + wave] = c;
            __syncthreads();
            unsigned tot = 0;
#pragma unroll
            for (int w = 0; w < 8; ++w) tot += cnt[par * 8 + w];
            if (tot >= (unsigned)cap) T = cand;
        }
        unsigned pg[4], pe[4]; bool isg[4], ise[4];
#pragma unroll
        for (int k = 0; k < 4; ++k) { isg[k] = v[k] > T; ise[k] = v[k] == T;
            const unsigned long long mg = __ballot(isg[k]), me = __ballot(ise[k]);
            pg[k] = (unsigned)__popcll(mg & lt_mask); pe[k] = (unsigned)__popcll(me & lt_mask);
            if (lane == 0) { cg[k * 8 + wave] = (unsigned)__popcll(mg); ce[k * 8 + wave] = (unsigned)__popcll(me); } }
        __syncthreads();
        unsigned totg = 0;
#pragma unroll
        for (int j = 0; j < 32; ++j) totg += cg[j];
        unsigned bg = 0, be = 0;
#pragma unroll
        for (int k = 0; k < 4; ++k) {
#pragma unroll
            for (int w = 0; w < 8; ++w) { const bool before = w < wave; if (before) { bg += cg[k * 8 + w]; be += ce[k * 8 + w]; } }
            const int i = tid + 512 * k;
            if (i < n) {
                int slot = -1;
                if (isg[k]) slot = (int)(bg + pg[k]);
                else if (ise[k]) { const unsigned r = be + pe[k]; if (totg + r < (unsigned)cap) slot = (int)(totg + r); }
                const int row = rowb + i;
                if (slot >= 0) { ROFFp[yb + slot] = (unsigned)row * (unsigned)D; SAYp[yb + slot] = SAp[row]; GATEp[yb + slot] = __uint_as_float(v[k]); INVp[(size_t)row * 16 + e] = yb + slot; } else INVp[(size_t)row * 16 + e] = -1;
            }
#pragma unroll
            for (int w = 0; w < 8; ++w) { const bool rest = w >= wave; if (rest) { bg += cg[k * 8 + w]; be += ce[k * 8 + w]; } }
        }
        __syncthreads();
    }
}
}

#define XB_TMO      128
#define XB_XCNT(j)  (256  + 64 * (j))
#define XB_XSUB(j)  (1280 + 64 * (j))
#define XB_XGEN(j)  (2304 + 64 * (j))
#define XB_TOP      3328
#define XB_TOPGEN   3392
#define XCD_BAR_WORDS 3456
#define XB_SPIN_CAP (1u << 22)

__device__ __forceinline__ unsigned xb_ld(unsigned* p)              { return __hip_atomic_load(p, __ATOMIC_RELAXED, __HIP_MEMORY_SCOPE_AGENT); }
__device__ __forceinline__ unsigned xb_add(unsigned* p, unsigned v) { return __hip_atomic_fetch_add(p, v, __ATOMIC_RELAXED, __HIP_MEMORY_SCOPE_AGENT); }
__device__ __forceinline__ unsigned xb_xcc_id() { return (unsigned)__builtin_amdgcn_s_getreg((3 << 11) | 20) & 0xFu; }
#define XB_SPIN(cond, bar) do { unsigned _sp = 0; while (cond) { __builtin_amdgcn_s_sleep(1); \
    if ((++_sp & 255u) == 0u) { if (xb_ld(&(bar)[XB_TMO])) break; if (_sp > XB_SPIN_CAP) { atomicAdd(&(bar)[XB_TMO], 1u); break; } } } } while (0)

struct XcdBarrier { unsigned* bar; unsigned x; volatile LAS unsigned* st; };

__device__ __forceinline__ XcdBarrier xcd_barrier_post(unsigned* bar, volatile LAS unsigned* st) {
    XcdBarrier b; b.bar = bar; b.x = xb_xcc_id(); b.st = st;
    if (threadIdx.x == 0) (void)xb_add(&bar[XB_XCNT(b.x)], 1u);
    return b;
}
__device__ __forceinline__ void xcd_barrier_complete(unsigned* bar, unsigned x, unsigned& nloc, unsigned& nx) {
    const unsigned G = gridDim.x * gridDim.y * gridDim.z;
    unsigned sum, cnt, mine, sp = 0u;
    for (;;) {
        sum = 0u; cnt = 0u; mine = 0u;
#pragma unroll
        for (unsigned j = 0; j < 16; ++j) { const unsigned c = xb_ld(&bar[XB_XCNT(j)]); sum += c; cnt += (c > 0u) ? 1u : 0u; mine = (j == x) ? c : mine; }
        if (sum == G) break;
        __builtin_amdgcn_s_sleep(1);
        if ((++sp & 255u) == 0u) { if (xb_ld(&bar[XB_TMO])) break; if (sp > XB_SPIN_CAP) { atomicAdd(&bar[XB_TMO], 1u); break; } }
    }
    nloc = mine > 0u ? mine : 1u; nx = cnt > 0u ? cnt : 1u;
}
__device__ __forceinline__ void xcd_barrier(const XcdBarrier& b) {
    asm volatile("s_waitcnt vmcnt(0)" ::: "memory");
    __syncthreads();
    if (threadIdx.x == 0) {
        unsigned* bar = b.bar;
        __builtin_amdgcn_s_waitcnt(0);
        unsigned nloc = b.st[0], nx = b.st[1];
        if (nloc == 0u) { xcd_barrier_complete(bar, b.x, nloc, nx); b.st[0] = nloc; b.st[1] = nx; }
        const unsigned old = xb_add(&bar[XB_XSUB(b.x)], 1u);
        const unsigned gen = old / nloc;
        if (old + 1u == (gen + 1u) * nloc) {
            __builtin_amdgcn_fence(__ATOMIC_RELEASE, "agent");
            asm volatile("s_waitcnt vmcnt(0)" ::: "memory");
            const unsigned og = xb_add(&bar[XB_TOP], 1u);
            const unsigned tg = og / nx;
            if (og + 1u == (tg + 1u) * nx) xb_add(&bar[XB_TOPGEN], 1u);
            else XB_SPIN(xb_ld(&bar[XB_TOPGEN]) == tg, bar);
            __builtin_amdgcn_fence(__ATOMIC_ACQUIRE, "agent");
            xb_add(&bar[XB_XGEN(b.x)], 1u);
            asm volatile("s_waitcnt vmcnt(0)" ::: "memory");
        } else {
            XB_SPIN(xb_ld(&bar[XB_XGEN(b.x)]) == gen, bar);
            __builtin_amdgcn_fence(__ATOMIC_ACQUIRE, "agent");
            asm volatile("s_waitcnt vmcnt(0)" ::: "memory");
        }
    }
    __syncthreads();
}


namespace mk {
__device__ __forceinline__ void g_inproj(const Frame& F, int layer) {
    pg8::Gemm g{(const bf16_t*)F_HAQ, (const bf16_t*)(F_WINQ + (size_t)layer * NPROJ * D), NT, NPROJ, D / 2}; pg8::StaticOrder S; S.init(NT, NPROJ, F.G, F.blk);
    EpiInProj E{WSP() + WS_U, F_QKW + layer * 128, F_ROPEC, F_ROPES, F_SAH, F_SWIN + (size_t)layer * NPROJ};
    pg8::gemm_phase_i8<EpiInProj, pg8::StaticOrder, true, true>(F.lds, g, S, E, F.tid);
}
__device__ __forceinline__ void g_outproj(const Frame& F, int layer, float gscale) {
    const int M = (layer < DEPTH - 1) ? NT : NL;
    pg8::Gemm g{F_A2, F_WOUT + (size_t)layer * D * D, M, D, D}; pg8::StaticOrder S; S.init(M, D, F.G, F.blk);
    const bool first = (layer == 0 && gscale != 0.f);
    EpiOutProj E{INP(I_X), INP(I_CTX), F_XB, F_MOD + (size_t)layer * 17 * 6144, gscale, first};
    pg8::gemm_phase<EpiOutProj, pg8::StaticOrder, true, true>(F.lds, g, S, E, F.tid);
}
__device__ __forceinline__ void g_moe1(const Frame& F, int layer) {
    pg8::Gemm g{(const bf16_t*)F_HQ, (const bf16_t*)(F_WGUQ + (size_t)layer * NE * 2816 * D), YROWS, NE * 2816, D / 2}; SchedMoe1 S{F.G, F.blk, (layer < DEPTH - 1) ? 1 : 0};
    EpiMoe1 E{F_HID, F_SW + (size_t)layer * NE * 2816, F_SAY};
    pg8::gemm_phase_gather_i8<EpiMoe1, SchedMoe1, true, true>(F.lds, g, S, E, F.tid, F_ROFF);
}
__device__ __forceinline__ void g_moe2(const Frame& F, int layer) {
    pg8::Gemm g{F_HID, F_WD + (size_t)layer * NE * D * DE, YROWS, NE * D, DE}; SchedMoe2 S{F.G, F.blk, (layer < DEPTH - 1) ? 1 : 0};
    EpiMoe2 E{F_Y, F_GATE};
    pg8::gemm_phase<EpiMoe2, SchedMoe2, true, true>(F.lds, g, S, E, F.tid);
}
}

#ifndef PROBE_MASK
#define PROBE_MASK 0
#endif
#ifndef PROBE_GEMM
#define PROBE_GEMM 0
#endif
#ifndef PROBE_P4
#define PROBE_P4 0
#endif
#ifndef PROBE_ROW
#define PROBE_ROW 0
#endif
#ifndef MK_PER_PHASE
#define MK_PER_PHASE 0
#endif
constexpr int N_PHASES = 1 + 10 * mk::DEPTH + 1;
struct Args { const float* in[29]; float* out; unsigned char* ws; int ph_lo, ph_hi; };

__global__ void __launch_bounds__(512, 2) mk_fwd(Args args) {
    using namespace mk;
    extern __shared__ __attribute__((aligned(16))) unsigned char lds_raw[];
    Frame F0;
    F0.lds = (LAS unsigned char*)lds_raw;
    F0.tid = threadIdx.x; F0.lane = F0.tid & 63; F0.wave = __builtin_amdgcn_readfirstlane(F0.tid >> 6); F0.G = gridDim.x; F0.blk = blockIdx.x;
    const int wave0 = F0.wave;
    volatile LAS unsigned* MISC = (volatile LAS unsigned*)(F0.lds + MISC_OFF);
    for (int u = F0.tid; u < (LDS_BYTES - MISC_OFF) / 4; u += NTHREADS) MISC[u] = 0u;
    __syncthreads();
    XcdBarrier bar; bar.bar = F_CTL + CW_BAR; bar.x = 0; bar.st = nullptr;
    if (!MK_PER_PHASE) bar = xcd_barrier_post(F_CTL + CW_BAR, MISC + 8);

    const int lo = args.ph_lo, hi = args.ph_hi;
    int ph = 0;
#define PH_BEGIN if (ph >= lo && ph < hi) { Frame F; F.lds = (LAS unsigned char*)lds_raw; F.G = gridDim.x; F.blk = blockIdx.x; F.wave = wave0; \
        F.lane = mk::lane_id_v(); asm volatile("" : "+s"(F.G), "+s"(F.blk), "+s"(F.wave)); F.tid = F.wave * 64 + F.lane;
#define PH_END   if (!MK_PER_PHASE && ph + 1 < hi) xcd_barrier(bar); else __syncthreads(); } ++ph;

    PH_BEGIN p0_prologue(F); PH_END
    if (PROBE_MASK & 128) { --ph; PH_BEGIN p0_prologue(F); PH_END }
    for (int layer = 0; layer < DEPTH; ++layer) {
        if (PROBE_MASK & 4096) { for (int e_ = 0; e_ < 8; ++e_) { --ph; PH_BEGIN PH_END } ++ph; --ph; }
        PH_BEGIN p1_norm1(F, layer, 0); PH_END
        if (PROBE_MASK & 2048) { --ph; PH_BEGIN p1_norm1(F, layer, 1); PH_END }
        PH_BEGIN g_inproj(F, layer); PH_END
        if (PROBE_GEMM || (PROBE_MASK & 16)) { --ph; PH_BEGIN g_inproj(F, layer); PH_END }
        PH_BEGIN p3_conv(F, layer); PH_END
        if (PROBE_ROW || (PROBE_MASK & 1)) { --ph; PH_BEGIN p3_conv(F, layer); PH_END }
        PH_BEGIN p4_mixer(F, layer, 0); PH_END
        if (PROBE_P4) { --ph; PH_BEGIN p4_mixer(F, layer, 1); PH_END }
        PH_BEGIN p5_ssd_post(F, layer); PH_END
        if (PROBE_ROW || (PROBE_MASK & 2)) { --ph; PH_BEGIN p5_ssd_post(F, layer); PH_END }
        PH_BEGIN g_outproj(F, layer, 1.f); PH_END
        if (PROBE_MASK & 1024) { --ph; PH_BEGIN g_outproj(F, layer, 0.f); PH_END }
        PH_BEGIN p7_norm2(F, layer); PH_END
        if (PROBE_ROW || (PROBE_MASK & 4)) { --ph; PH_BEGIN p7_norm2(F, layer); PH_END }
        PH_BEGIN p8_topk(F, layer); PH_END
        if (PROBE_ROW || (PROBE_MASK & 8)) { --ph; PH_BEGIN p8_topk(F, layer); PH_END }
        PH_BEGIN g_moe1(F, layer); PH_END
        if (PROBE_GEMM || (PROBE_MASK & 32)) { --ph; PH_BEGIN g_moe1(F, layer); PH_END }
        PH_BEGIN g_moe2(F, layer); PH_END
        if (PROBE_GEMM || (PROBE_MASK & 64)) { --ph; PH_BEGIN g_moe2(F, layer); PH_END }
    }
    PH_BEGIN p1_norm1(F, DEPTH, 0); PH_END
#undef PH_BEGIN
#undef PH_END
}

extern "C" void kernel_launch(void* const* d_in, const int* in_sizes, int n_in, void* d_out, int out_size, void* d_ws, size_t ws_size, hipStream_t stream) {
    static int grid = 0;
    if (grid == 0) {
        if (n_in != 29 || out_size != mk::NL * mk::D || ws_size < mk::WS_END) { fprintf(stderr, "kernel_launch: unexpected shapes: n_in %d out %d ws %zu (need %zu)\n", n_in, out_size, ws_size, (size_t)mk::WS_END); grid = -1; return; }
        int dev = 0, cus = 0, per_cu = 0;
        if (hipGetDevice(&dev) != hipSuccess || hipDeviceGetAttribute(&cus, hipDeviceAttributeMultiprocessorCount, dev) != hipSuccess) { grid = -1; return; }
        if (hipFuncSetAttribute((const void*)mk_fwd, hipFuncAttributeMaxDynamicSharedMemorySize, mk::LDS_BYTES) != hipSuccess) { fprintf(stderr, "kernel_launch: hipFuncSetAttribute failed\n"); grid = -1; return; }
        if (hipOccupancyMaxActiveBlocksPerMultiprocessor(&per_cu, (const void*)mk_fwd, mk::NTHREADS, mk::LDS_BYTES) != hipSuccess || per_cu < 1) { fprintf(stderr, "kernel_launch: occupancy query says %d\n", per_cu); }
        (void)hipGetLastError();
        grid = cus;
    }
    if (grid < 0) return;
    (void)hipMemsetAsync((char*)d_ws + mk::WS_CTL, 0, mk::CTL_BYTES, stream);
    Args a{};
    for (int i = 0; i < 29; ++i) a.in[i] = (const float*)d_in[i];
    a.out = (float*)d_out; a.ws = (unsigned char*)d_ws;
#if MK_PER_PHASE
    for (int p = 0; p < N_PHASES; ++p) { a.ph_lo = p; a.ph_hi = p + 1; hipLaunchKernelGGL(mk_fwd, dim3(grid), dim3(mk::NTHREADS), mk::LDS_BYTES, stream, a); }
#else
    a.ph_lo = 0; a.ph_hi = N_PHASES;
    hipLaunchKernelGGL(mk_fwd, dim3(grid), dim3(mk::NTHREADS), mk::LDS_BYTES, stream, a);
#endif
}
```

```cpp
#include <hip/hip_runtime.h>
#include <cstdio>
#include <cstdint>
#include <cmath>

#define LAS __attribute__((address_space(3)))
#define GAS __attribute__((address_space(1)))

namespace pg8 {
#define PG8_LAS __attribute__((address_space(3)))
typedef unsigned short bf16_t;
typedef short bf16x8 __attribute__((ext_vector_type(8)));
typedef float f32x4 __attribute__((ext_vector_type(4)));
typedef unsigned u32x4 __attribute__((ext_vector_type(4)));
typedef int i32x4 __attribute__((ext_vector_type(4)));
constexpr int BM = 256, BK = 64, HALF = 128, HTB = HALF * BK * 2  , STAGE_BYTES = 8 * HTB, NXCD = 8, WGM = 8;

__host__ __device__ __forceinline__ int lds_byte(int r, int c) { const int st = (r >> 4) * 2 + (c >> 5), rr = r & 15, cc = c & 31, ob = rr * 64 + cc * 2; return st * 1024 + (ob ^ (((ob >> 9) & 1) << 5)); }
__host__ __device__ __forceinline__ void stage_rc(int b, int& R, int& C) { const int st = b / 1024, sb = b % 1024, swz = sb ^ (((sb >> 9) & 1) << 5); R = (st >> 1) * 16 + swz / 64; C = (st & 1) * 32 + (swz % 64) / 2; }
__host__ __device__ __forceinline__ int perm32(int rho) { const int n = rho >> 4, i = rho & 15; return 8 * (i >> 2) + 4 * n + (i & 3); }

struct Unit { int pm, pn; };
struct Gemm { const bf16_t* A; const bf16_t* Bt; int M, N, K; };

struct StaticOrder {
    int nM, nN, nwg, G, c;
    __host__ __device__ void init(int M, int N, int G_, int c_) { nM = M / BM; nN = N / BM; nwg = nM * nN; G = G_; c = c_; }
    __host__ __device__ bool next(int i, Unit& u) const {
        const long L = (long)i * G + c; if (L >= nwg) return false;
        int wgid = (int)L; { const int q = nwg / NXCD, r = nwg % NXCD, xcd = wgid % NXCD, off = wgid / NXCD; wgid = (xcd < r ? xcd * (q + 1) : r * (q + 1) + (xcd - r) * q) + off; }
        const int nig = WGM * nN, gid = wgid / nig, fm = gid * WGM, gsz = (nM - fm) < WGM ? (nM - fm) : WGM;
        u.pm = fm + ((wgid % nig) % gsz); u.pn = (wgid % nig) / gsz; return true;
    }
    __device__ __forceinline__ void a_ready(const Unit&) const {}
    __device__ __forceinline__ void done(const Unit&) const {}
};

template <class Epi, class Sched, bool ALIGN_EPI = false, bool SP2 = false>
__device__ __forceinline__ void gemm_phase(PG8_LAS unsigned char* lds, const Gemm g, const Sched& S, const Epi& E, const int tid_arg) {
    int tid_ = tid_arg; asm volatile("" : "+v"(tid_));
    const int tid = tid_, wid = __builtin_amdgcn_readfirstlane(tid >> 6), lane = tid & 63, wr = wid >> 2, wc = wid & 3, fr = lane & 15, fq = lane >> 4;
    const int K = g.K, nt = K / BK;
    unsigned voffA[2], voffB[2];
#pragma unroll
    for (int i = 0; i < 2; ++i) { int R, C; stage_rc(tid * 16 + i * 8192, R, C); const int Rb = Epi::PERM ? ((R & ~31) + perm32(R & 31)) : R;
        voffA[i] = (unsigned)(R * K + C) * 2u; voffB[i] = (unsigned)(Rb * K + C) * 2u; }
    const size_t kstep = (size_t)(BK * 2);
    const size_t hstep = (size_t)HALF * K * 2;
    const size_t tstep = 2 * hstep;
    const unsigned ldsw = (unsigned)wid * 1024u;
    const int aoff = lds_byte(wr * 64 + fr, fq * 8), boff = lds_byte(wc * 32 + fr, fq * 8);
#define PG8_SA(b, h) (((b) * 2 + (h)) * HTB)
#define PG8_SB(b, h) ((4 + (b) * 2 + (h)) * HTB)
#define PG8_STAGE(bufoff, gbase, voff) do { _Pragma("unroll") for (int _i = 0; _i < 2; ++_i) \
        __builtin_amdgcn_global_load_lds((const unsigned*)((const char*)(gbase) + (voff)[_i]), (PG8_LAS unsigned*)(lds + (bufoff) + ldsw + _i * 8192), 16, 0, 0); } while (0)
#define PG8_LDA(dst, b, h) do { _Pragma("unroll") for (int m = 0; m < 4; ++m) _Pragma("unroll") for (int k = 0; k < 2; ++k) dst[m][k] = *(const PG8_LAS bf16x8*)(lds + PG8_SA(b, h) + aoff + m * 2048 + k * 1024); } while (0)
#define PG8_LDB(dst, b, h) do { _Pragma("unroll") for (int n = 0; n < 2; ++n) _Pragma("unroll") for (int k = 0; k < 2; ++k) dst[n][k] = *(const PG8_LAS bf16x8*)(lds + PG8_SB(b, h) + boff + n * 2048 + k * 1024); } while (0)
#define PG8_MMA(ai, bj, At, Bt) do { __builtin_amdgcn_s_setprio(1); _Pragma("unroll") for (int m = 0; m < 4; ++m) _Pragma("unroll") for (int n = 0; n < 2; ++n) _Pragma("unroll") for (int k = 0; k < 2; ++k) \
        acc[ai][bj][m][n] = __builtin_amdgcn_mfma_f32_16x16x32_bf16(Bt[n][k], At[m][k], acc[ai][bj][m][n], 0, 0, 0); __builtin_amdgcn_s_setprio(0); } while (0)
#define PG8_WAIT_V(n) asm volatile("s_waitcnt vmcnt(" #n ")" ::: "memory")
#define PG8_WAIT_L(n) asm volatile("s_waitcnt lgkmcnt(" #n ")" ::: "memory")
#define PG8_BAR __builtin_amdgcn_s_barrier()
#define PG8_SCHED __builtin_amdgcn_sched_barrier(0)
    Unit cur, nxt; int ui = 0;
    if (!S.next(0, cur)) return;
    f32x4 acc[2][2][4][2];
#pragma unroll
    for (int a = 0; a < 2; ++a)
#pragma unroll
        for (int b = 0; b < 2; ++b)
#pragma unroll
            for (int m = 0; m < 4; ++m)
#pragma unroll
                for (int n = 0; n < 2; ++n) acc[a][b][m][n] = (f32x4){0.f, 0.f, 0.f, 0.f};
    bf16x8 At[4][2], B0[2][2], B1[2][2];
    const char* cA = (const char*)g.A + (size_t)cur.pm * tstep; const char* cB = (const char*)g.Bt + (size_t)cur.pn * tstep;
    S.a_ready(cur);
    if constexpr (SP2) {
        PG8_STAGE(PG8_SB(0, 0), cB, voffB); PG8_STAGE(PG8_SB(0, 1), cB + hstep, voffB); PG8_STAGE(PG8_SA(0, 0), cA, voffA); PG8_STAGE(PG8_SA(0, 1), cA + hstep, voffA);
        if (wr == 1) PG8_BAR;
        PG8_WAIT_V(2); PG8_BAR;
        PG8_STAGE(PG8_SB(1, 0), cB + kstep, voffB); PG8_STAGE(PG8_SA(1, 0), cA + kstep, voffA); PG8_STAGE(PG8_SB(1, 1), cB + hstep + kstep, voffB);
        PG8_WAIT_V(6); PG8_BAR;
    } else {
        PG8_STAGE(PG8_SB(0, 0), cB, voffB); PG8_STAGE(PG8_SA(0, 0), cA, voffA); PG8_STAGE(PG8_SB(0, 1), cB + hstep, voffB); PG8_STAGE(PG8_SA(0, 1), cA + hstep, voffA);
        if (wr == 1) PG8_BAR;
        PG8_WAIT_V(4); PG8_BAR;
        PG8_STAGE(PG8_SB(1, 0), cB + kstep, voffB); PG8_STAGE(PG8_SA(1, 0), cA + kstep, voffA); PG8_STAGE(PG8_SB(1, 1), cB + hstep + kstep, voffB);
        PG8_WAIT_V(6); PG8_BAR;
    }
    for (;;) {
        const bool has_next = S.next(ui + 1, nxt);
        const char* nA = has_next ? (const char*)g.A + (size_t)nxt.pm * tstep : cA; const char* nB = has_next ? (const char*)g.Bt + (size_t)nxt.pn * tstep : cB;
        for (int t = 0; t < nt; t += 2) {
            const bool last = (t == nt - 2);
            const char* a1 = cA + (size_t)(t + 1) * kstep;
            const char* a2 = last ? nA : cA + (size_t)(t + 2) * kstep; const char* b2 = last ? nB : cB + (size_t)(t + 2) * kstep;
            const char* a3 = a2 + kstep; const char* b3 = b2 + kstep;
            if (last && has_next) S.a_ready(nxt);
            if constexpr (SP2) {
            PG8_LDB(B0, 0, 0); PG8_LDB(B1, 0, 1); PG8_SCHED; PG8_LDA(At, 0, 0); PG8_STAGE(PG8_SA(1, 1), a1 + hstep, voffA);
            PG8_WAIT_V(8); PG8_WAIT_L(0); PG8_BAR; PG8_MMA(0, 0, At, B0); PG8_MMA(0, 1, At, B1); PG8_BAR; PG8_SCHED;
            PG8_LDA(At, 0, 1); PG8_STAGE(PG8_SB(0, 0), b2, voffB); PG8_STAGE(PG8_SB(0, 1), b2 + hstep, voffB); PG8_STAGE(PG8_SA(0, 0), a2, voffA);
            PG8_WAIT_V(8); PG8_WAIT_L(0); PG8_BAR; PG8_MMA(1, 0, At, B0); PG8_MMA(1, 1, At, B1); PG8_BAR; PG8_SCHED;
            PG8_LDB(B0, 1, 0); PG8_LDB(B1, 1, 1); PG8_SCHED; PG8_LDA(At, 1, 0); PG8_STAGE(PG8_SA(0, 1), a2 + hstep, voffA);
            PG8_WAIT_V(8); PG8_WAIT_L(0); PG8_BAR; PG8_MMA(0, 0, At, B0); PG8_MMA(0, 1, At, B1); PG8_BAR; PG8_SCHED;
            PG8_LDA(At, 1, 1); PG8_STAGE(PG8_SB(1, 0), b3, voffB); PG8_STAGE(PG8_SB(1, 1), b3 + hstep, voffB); PG8_STAGE(PG8_SA(1, 0), a3, voffA);
            PG8_WAIT_V(8); PG8_WAIT_L(0); PG8_BAR; PG8_MMA(1, 0, At, B0); PG8_MMA(1, 1, At, B1); PG8_BAR; PG8_SCHED;
            } else {
            PG8_LDB(B0, 0, 0); PG8_SCHED; PG8_LDA(At, 0, 0); PG8_STAGE(PG8_SA(1, 1), a1 + hstep, voffA);
            PG8_WAIT_L(8); PG8_BAR; PG8_WAIT_L(0); PG8_MMA(0, 0, At, B0); PG8_BAR; PG8_SCHED;
            PG8_LDB(B1, 0, 1); PG8_STAGE(PG8_SB(0, 0), b2, voffB);
            PG8_BAR; PG8_WAIT_L(0); PG8_MMA(0, 1, At, B1); PG8_BAR;
            PG8_LDA(At, 0, 1); PG8_STAGE(PG8_SA(0, 0), a2, voffA);
            PG8_BAR; PG8_WAIT_L(0); PG8_MMA(1, 0, At, B0); PG8_BAR; PG8_SCHED;
            PG8_STAGE(PG8_SB(0, 1), b2 + hstep, voffB);
            PG8_WAIT_V(6); PG8_BAR; PG8_MMA(1, 1, At, B1); PG8_BAR;
            PG8_LDB(B0, 1, 0); PG8_SCHED; PG8_LDA(At, 1, 0); PG8_STAGE(PG8_SA(0, 1), a2 + hstep, voffA);
            PG8_WAIT_L(8); PG8_BAR; PG8_WAIT_L(0); PG8_MMA(0, 0, At, B0); PG8_BAR; PG8_SCHED;
            PG8_LDB(B1, 1, 1); PG8_STAGE(PG8_SB(1, 0), b3, voffB);
            PG8_BAR; PG8_WAIT_L(0); PG8_MMA(0, 1, At, B1); PG8_BAR;
            PG8_LDA(At, 1, 1); PG8_STAGE(PG8_SA(1, 0), a3, voffA);
            PG8_BAR; PG8_WAIT_L(0); PG8_MMA(1, 0, At, B0); PG8_BAR; PG8_SCHED;
            PG8_STAGE(PG8_SB(1, 1), b3 + hstep, voffB);
            PG8_WAIT_V(6); PG8_BAR; PG8_MMA(1, 1, At, B1); PG8_BAR;
            }
        }
        if constexpr (ALIGN_EPI) { if (wr == 0) PG8_BAR; }
        if constexpr (!Epi::AFTER_DRAIN) { E(acc, cur, wr, wc, fr, fq); S.done(cur); }
        if (!has_next) break;
#pragma unroll
        for (int a = 0; a < 2; ++a)
#pragma unroll
            for (int b = 0; b < 2; ++b)
#pragma unroll
                for (int m = 0; m < 4; ++m)
#pragma unroll
                    for (int n = 0; n < 2; ++n) acc[a][b][m][n] = (f32x4){0.f, 0.f, 0.f, 0.f};
        cur = nxt; cA = nA; cB = nB; ++ui;
        if constexpr (ALIGN_EPI) { if (wr == 1) PG8_BAR; }
    }
    PG8_WAIT_V(0);
    if constexpr (!ALIGN_EPI) { if (wr == 0) PG8_BAR; }
    PG8_BAR;
    if constexpr (Epi::AFTER_DRAIN) { E.fused(acc, cur, wr, wc, fr, fq, lds, wid, lane); S.done(cur); }
#undef PG8_SA
#undef PG8_SB
#undef PG8_STAGE
#undef PG8_LDA
#undef PG8_LDB
#undef PG8_MMA
#undef PG8_WAIT_V
#undef PG8_WAIT_L
#undef PG8_BAR
#undef PG8_SCHED
}template <class Epi, class Sched, bool ALIGN_EPI = false, bool SP2 = false>
__device__ __forceinline__ void gemm_phase_gather(PG8_LAS unsigned char* lds, const Gemm g, const Sched& S, const Epi& E, const int tid_arg, const unsigned* __restrict__ rowoff) {
    int tid_ = tid_arg; asm volatile("" : "+v"(tid_));
    const int tid = tid_, wid = __builtin_amdgcn_readfirstlane(tid >> 6), lane = tid & 63, wr = wid >> 2, wc = wid & 3, fr = lane & 15, fq = lane >> 4;
    const int K = g.K, nt = K / BK;
    unsigned voffA[2], voffB[2]; int rA[2]; unsigned cAoff[2];
#pragma unroll
    for (int i = 0; i < 2; ++i) { int R, C; stage_rc(tid * 16 + i * 8192, R, C); const int Rb = Epi::PERM ? ((R & ~31) + perm32(R & 31)) : R;
        voffA[i] = (unsigned)(R * K + C) * 2u; voffB[i] = (unsigned)(Rb * K + C) * 2u; rA[i] = R; cAoff[i] = (unsigned)C * 2u; }
    const size_t kstep = (size_t)(BK * 2);
    const size_t hstep = (size_t)HALF * K * 2;
    const size_t tstep = 2 * hstep;
    const unsigned ldsw = (unsigned)wid * 1024u;
    const int aoff = lds_byte(wr * 64 + fr, fq * 8), boff = lds_byte(wc * 32 + fr, fq * 8);
#define PG8_SA(b, h) (((b) * 2 + (h)) * HTB)
#define PG8_SB(b, h) ((4 + (b) * 2 + (h)) * HTB)
#define PG8_STAGE(bufoff, gbase, voff) do { _Pragma("unroll") for (int _i = 0; _i < 2; ++_i) \
        __builtin_amdgcn_global_load_lds((const unsigned*)((const char*)(gbase) + (voff)[_i]), (PG8_LAS unsigned*)(lds + (bufoff) + ldsw + _i * 8192), 16, 0, 0); } while (0)
#define PG8_LDA(dst, b, h) do { _Pragma("unroll") for (int m = 0; m < 4; ++m) _Pragma("unroll") for (int k = 0; k < 2; ++k) dst[m][k] = *(const PG8_LAS bf16x8*)(lds + PG8_SA(b, h) + aoff + m * 2048 + k * 1024); } while (0)
#define PG8_LDB(dst, b, h) do { _Pragma("unroll") for (int n = 0; n < 2; ++n) _Pragma("unroll") for (int k = 0; k < 2; ++k) dst[n][k] = *(const PG8_LAS bf16x8*)(lds + PG8_SB(b, h) + boff + n * 2048 + k * 1024); } while (0)
#define PG8_MMA(ai, bj, At, Bt) do { __builtin_amdgcn_s_setprio(1); _Pragma("unroll") for (int m = 0; m < 4; ++m) _Pragma("unroll") for (int n = 0; n < 2; ++n) _Pragma("unroll") for (int k = 0; k < 2; ++k) \
        acc[ai][bj][m][n] = __builtin_amdgcn_mfma_f32_16x16x32_bf16(Bt[n][k], At[m][k], acc[ai][bj][m][n], 0, 0, 0); __builtin_amdgcn_s_setprio(0); } while (0)
#define PG8_WAIT_V(n) asm volatile("s_waitcnt vmcnt(" #n ")" ::: "memory")
#define PG8_WAIT_L(n) asm volatile("s_waitcnt lgkmcnt(" #n ")" ::: "memory")
#define PG8_BAR __builtin_amdgcn_s_barrier()
#define PG8_SCHED __builtin_amdgcn_sched_barrier(0)
    Unit cur, nxt; int ui = 0;
    if (!S.next(0, cur)) return;
    f32x4 acc[2][2][4][2];
#pragma unroll
    for (int a = 0; a < 2; ++a)
#pragma unroll
        for (int b = 0; b < 2; ++b)
#pragma unroll
            for (int m = 0; m < 4; ++m)
#pragma unroll
                for (int n = 0; n < 2; ++n) acc[a][b][m][n] = (f32x4){0.f, 0.f, 0.f, 0.f};
    bf16x8 At[4][2], B0[2][2], B1[2][2];
    const char* cA = (const char*)g.A; const char* cB = (const char*)g.Bt + (size_t)cur.pn * tstep;
    unsigned v0[2], v1[2], n0[2], n1[2];
#define PG8_LOADOFF(D0, D1, PM) do { _Pragma("unroll") for (int _i = 0; _i < 2; ++_i) { D0[_i] = rowoff[256 * (PM) + rA[_i]] + cAoff[_i]; D1[_i] = rowoff[256 * (PM) + 128 + rA[_i]] + cAoff[_i]; } } while (0)
    PG8_LOADOFF(v0, v1, cur.pm);
#pragma unroll
    for (int _i = 0; _i < 2; ++_i) { n0[_i] = v0[_i]; n1[_i] = v1[_i]; }
    S.a_ready(cur);
    if constexpr (SP2) {
        PG8_STAGE(PG8_SB(0, 0), cB, voffB); PG8_STAGE(PG8_SB(0, 1), cB + hstep, voffB); PG8_STAGE(PG8_SA(0, 0), cA, v0); PG8_STAGE(PG8_SA(0, 1), cA, v1);
        if (wr == 1) PG8_BAR;
        PG8_WAIT_V(2); PG8_BAR;
        PG8_STAGE(PG8_SB(1, 0), cB + kstep, voffB); PG8_STAGE(PG8_SA(1, 0), cA + kstep, v0); PG8_STAGE(PG8_SB(1, 1), cB + hstep + kstep, voffB);
        PG8_WAIT_V(6); PG8_BAR;
    } else {
        PG8_STAGE(PG8_SB(0, 0), cB, voffB); PG8_STAGE(PG8_SA(0, 0), cA, v0); PG8_STAGE(PG8_SB(0, 1), cB + hstep, voffB); PG8_STAGE(PG8_SA(0, 1), cA, v1);
        if (wr == 1) PG8_BAR;
        PG8_WAIT_V(4); PG8_BAR;
        PG8_STAGE(PG8_SB(1, 0), cB + kstep, voffB); PG8_STAGE(PG8_SA(1, 0), cA + kstep, v0); PG8_STAGE(PG8_SB(1, 1), cB + hstep + kstep, voffB);
        PG8_WAIT_V(6); PG8_BAR;
    }
    for (;;) {
        const bool has_next = S.next(ui + 1, nxt);
        if (has_next) PG8_LOADOFF(n0, n1, nxt.pm);
        const char* nA = cA; const char* nB = has_next ? (const char*)g.Bt + (size_t)nxt.pn * tstep : cB;
        for (int t = 0; t < nt; t += 2) {
            const bool last = (t == nt - 2);
            const char* a1 = cA + (size_t)(t + 1) * kstep;
            const char* a2 = last ? nA : cA + (size_t)(t + 2) * kstep; const char* b2 = last ? nB : cB + (size_t)(t + 2) * kstep;
            const char* a3 = a2 + kstep; const char* b3 = b2 + kstep;
            unsigned o2a[2], o2b[2];
#pragma unroll
            for (int _i = 0; _i < 2; ++_i) { o2a[_i] = last ? n0[_i] : v0[_i]; o2b[_i] = last ? n1[_i] : v1[_i]; }
            if (last && has_next) S.a_ready(nxt);
            if constexpr (SP2) {
            PG8_LDB(B0, 0, 0); PG8_LDB(B1, 0, 1); PG8_SCHED; PG8_LDA(At, 0, 0); PG8_STAGE(PG8_SA(1, 1), a1, v1);
            PG8_WAIT_V(8); PG8_WAIT_L(0); PG8_BAR; PG8_MMA(0, 0, At, B0); PG8_MMA(0, 1, At, B1); PG8_BAR; PG8_SCHED;
            PG8_LDA(At, 0, 1); PG8_STAGE(PG8_SB(0, 0), b2, voffB); PG8_STAGE(PG8_SB(0, 1), b2 + hstep, voffB); PG8_STAGE(PG8_SA(0, 0), a2, o2a);
            PG8_WAIT_V(8); PG8_WAIT_L(0); PG8_BAR; PG8_MMA(1, 0, At, B0); PG8_MMA(1, 1, At, B1); PG8_BAR; PG8_SCHED;
            PG8_LDB(B0, 1, 0); PG8_LDB(B1, 1, 1); PG8_SCHED; PG8_LDA(At, 1, 0); PG8_STAGE(PG8_SA(0, 1), a2, o2b);
            PG8_WAIT_V(8); PG8_WAIT_L(0); PG8_BAR; PG8_MMA(0, 0, At, B0); PG8_MMA(0, 1, At, B1); PG8_BAR; PG8_SCHED;
            PG8_LDA(At, 1, 1); PG8_STAGE(PG8_SB(1, 0), b3, voffB); PG8_STAGE(PG8_SB(1, 1), b3 + hstep, voffB); PG8_STAGE(PG8_SA(1, 0), a3, o2a);
            PG8_WAIT_V(8); PG8_WAIT_L(0); PG8_BAR; PG8_MMA(1, 0, At, B0); PG8_MMA(1, 1, At, B1); PG8_BAR; PG8_SCHED;
            } else {
            PG8_LDB(B0, 0, 0); PG8_SCHED; PG8_LDA(At, 0, 0); PG8_STAGE(PG8_SA(1, 1), a1, v1);
            PG8_WAIT_L(8); PG8_BAR; PG8_WAIT_L(0); PG8_MMA(0, 0, At, B0); PG8_BAR; PG8_SCHED;
            PG8_LDB(B1, 0, 1); PG8_STAGE(PG8_SB(0, 0), b2, voffB);
            PG8_BAR; PG8_WAIT_L(0); PG8_MMA(0, 1, At, B1); PG8_BAR;
            PG8_LDA(At, 0, 1); PG8_STAGE(PG8_SA(0, 0), a2, o2a);
            PG8_BAR; PG8_WAIT_L(0); PG8_MMA(1, 0, At, B0); PG8_BAR; PG8_SCHED;
            PG8_STAGE(PG8_SB(0, 1), b2 + hstep, voffB);
            PG8_WAIT_V(6); PG8_BAR; PG8_MMA(1, 1, At, B1); PG8_BAR;
            PG8_LDB(B0, 1, 0); PG8_SCHED; PG8_LDA(At, 1, 0); PG8_STAGE(PG8_SA(0, 1), a2, o2b);
            PG8_WAIT_L(8); PG8_BAR; PG8_WAIT_L(0); PG8_MMA(0, 0, At, B0); PG8_BAR; PG8_SCHED;
            PG8_LDB(B1, 1, 1); PG8_STAGE(PG8_SB(1, 0), b3, voffB);
            PG8_BAR; PG8_WAIT_L(0); PG8_MMA(0, 1, At, B1); PG8_BAR;
            PG8_LDA(At, 1, 1); PG8_STAGE(PG8_SA(1, 0), a3, o2a);
            PG8_BAR; PG8_WAIT_L(0); PG8_MMA(1, 0, At, B0); PG8_BAR; PG8_SCHED;
            PG8_STAGE(PG8_SB(1, 1), b3 + hstep, voffB);
            PG8_WAIT_V(6); PG8_BAR; PG8_MMA(1, 1, At, B1); PG8_BAR;
            }
        }
        if constexpr (ALIGN_EPI) { if (wr == 0) PG8_BAR; }
        if constexpr (!Epi::AFTER_DRAIN) { E(acc, cur, wr, wc, fr, fq); S.done(cur); }
        if (!has_next) break;
#pragma unroll
        for (int a = 0; a < 2; ++a)
#pragma unroll
            for (int b = 0; b < 2; ++b)
#pragma unroll
                for (int m = 0; m < 4; ++m)
#pragma unroll
                    for (int n = 0; n < 2; ++n) acc[a][b][m][n] = (f32x4){0.f, 0.f, 0.f, 0.f};
        cur = nxt; cA = nA; cB = nB; ++ui;
#pragma unroll
        for (int _i = 0; _i < 2; ++_i) { v0[_i] = n0[_i]; v1[_i] = n1[_i]; }
        if constexpr (ALIGN_EPI) { if (wr == 1) PG8_BAR; }
    }
    PG8_WAIT_V(0);
    if constexpr (!ALIGN_EPI) { if (wr == 0) PG8_BAR; }
    PG8_BAR;
    if constexpr (Epi::AFTER_DRAIN) { E.fused(acc, cur, wr, wc, fr, fq, lds, wid, lane); S.done(cur); }
#undef PG8_LOADOFF
#undef PG8_SA
#undef PG8_SB
#undef PG8_STAGE
#undef PG8_LDA
#undef PG8_LDB
#undef PG8_MMA
#undef PG8_WAIT_V
#undef PG8_WAIT_L
#undef PG8_BAR
#undef PG8_SCHED
}template <class Epi, class Sched, bool ALIGN_EPI = false, bool SP2 = false>
__device__ __forceinline__ void gemm_phase_gather_i8(PG8_LAS unsigned char* lds, const Gemm g, const Sched& S, const Epi& E, const int tid_arg, const unsigned* __restrict__ rowoff) {
    int tid_ = tid_arg; asm volatile("" : "+v"(tid_));
    const int tid = tid_, wid = __builtin_amdgcn_readfirstlane(tid >> 6), lane = tid & 63, wr = wid >> 2, wc = wid & 3, fr = lane & 15, fq = lane >> 4;
    const int K = g.K, nt = K / BK;
    unsigned voffA[2], voffB[2]; int rA[2]; unsigned cAoff[2];
#pragma unroll
    for (int i = 0; i < 2; ++i) { int R, C; stage_rc(tid * 16 + i * 8192, R, C); const int Rb = Epi::PERM ? ((R & ~31) + perm32(R & 31)) : R;
        voffA[i] = (unsigned)(R * K + C) * 2u; voffB[i] = (unsigned)(Rb * K + C) * 2u; rA[i] = R; cAoff[i] = (unsigned)C * 2u; }
    const size_t kstep = (size_t)(BK * 2);
    const size_t hstep = (size_t)HALF * K * 2;
    const size_t tstep = 2 * hstep;
    const unsigned ldsw = (unsigned)wid * 1024u;
    const int aoff = lds_byte(wr * 64 + fr, fq * 8), boff = lds_byte(wc * 32 + fr, fq * 8);
#define PG8_SA(b, h) (((b) * 2 + (h)) * HTB)
#define PG8_SB(b, h) ((4 + (b) * 2 + (h)) * HTB)
#define PG8_STAGE(bufoff, gbase, voff) do { _Pragma("unroll") for (int _i = 0; _i < 2; ++_i) \
        __builtin_amdgcn_global_load_lds((const unsigned*)((const char*)(gbase) + (voff)[_i]), (PG8_LAS unsigned*)(lds + (bufoff) + ldsw + _i * 8192), 16, 0, 0); } while (0)
#define PG8_LDA(dst, b, h) do { _Pragma("unroll") for (int m = 0; m < 4; ++m) _Pragma("unroll") for (int k = 0; k < 2; ++k) dst[m][k] = *(const PG8_LAS bf16x8*)(lds + PG8_SA(b, h) + aoff + m * 2048 + k * 1024); } while (0)
#define PG8_LDB(dst, b, h) do { _Pragma("unroll") for (int n = 0; n < 2; ++n) _Pragma("unroll") for (int k = 0; k < 2; ++k) dst[n][k] = *(const PG8_LAS bf16x8*)(lds + PG8_SB(b, h) + boff + n * 2048 + k * 1024); } while (0)
#define PG8_MMA(ai, bj, At, Bt) do { __builtin_amdgcn_s_setprio(1); _Pragma("unroll") for (int m = 0; m < 4; ++m) _Pragma("unroll") for (int n = 0; n < 2; ++n) _Pragma("unroll") for (int k = 0; k < 2; ++k) \
        acc[ai][bj][m][n] = __builtin_amdgcn_mfma_i32_16x16x64_i8(__builtin_bit_cast(i32x4, Bt[n][k]), __builtin_bit_cast(i32x4, At[m][k]), acc[ai][bj][m][n], 0, 0, 0); __builtin_amdgcn_s_setprio(0); } while (0)
#define PG8_WAIT_V(n) asm volatile("s_waitcnt vmcnt(" #n ")" ::: "memory")
#define PG8_WAIT_L(n) asm volatile("s_waitcnt lgkmcnt(" #n ")" ::: "memory")
#define PG8_BAR __builtin_amdgcn_s_barrier()
#define PG8_SCHED __builtin_amdgcn_sched_barrier(0)
    Unit cur, nxt; int ui = 0;
    if (!S.next(0, cur)) return;
    i32x4 acc[2][2][4][2];
#pragma unroll
    for (int a = 0; a < 2; ++a)
#pragma unroll
        for (int b = 0; b < 2; ++b)
#pragma unroll
            for (int m = 0; m < 4; ++m)
#pragma unroll
                for (int n = 0; n < 2; ++n) acc[a][b][m][n] = (i32x4){0, 0, 0, 0};
    bf16x8 At[4][2], B0[2][2], B1[2][2];
    const char* cA = (const char*)g.A; const char* cB = (const char*)g.Bt + (size_t)cur.pn * tstep;
    unsigned v0[2], v1[2], n0[2], n1[2];
#define PG8_LOADOFF(D0, D1, PM) do { _Pragma("unroll") for (int _i = 0; _i < 2; ++_i) { D0[_i] = rowoff[256 * (PM) + rA[_i]] + cAoff[_i]; D1[_i] = rowoff[256 * (PM) + 128 + rA[_i]] + cAoff[_i]; } } while (0)
    PG8_LOADOFF(v0, v1, cur.pm);
#pragma unroll
    for (int _i = 0; _i < 2; ++_i) { n0[_i] = v0[_i]; n1[_i] = v1[_i]; }
    S.a_ready(cur);
    if constexpr (SP2) {
        PG8_STAGE(PG8_SB(0, 0), cB, voffB); PG8_STAGE(PG8_SB(0, 1), cB + hstep, voffB); PG8_STAGE(PG8_SA(0, 0), cA, v0); PG8_STAGE(PG8_SA(0, 1), cA, v1);
        if (wr == 1) PG8_BAR;
        PG8_WAIT_V(2); PG8_BAR;
        PG8_STAGE(PG8_SB(1, 0), cB + kstep, voffB); PG8_STAGE(PG8_SA(1, 0), cA + kstep, v0); PG8_STAGE(PG8_SB(1, 1), cB + hstep + kstep, voffB);
        PG8_WAIT_V(6); PG8_BAR;
    } else {
        PG8_STAGE(PG8_SB(0, 0), cB, voffB); PG8_STAGE(PG8_SA(0, 0), cA, v0); PG8_STAGE(PG8_SB(0, 1), cB + hstep, voffB); PG8_STAGE(PG8_SA(0, 1), cA, v1);
        if (wr == 1) PG8_BAR;
        PG8_WAIT_V(4); PG8_BAR;
        PG8_STAGE(PG8_SB(1, 0), cB + kstep, voffB); PG8_STAGE(PG8_SA(1, 0), cA + kstep, v0); PG8_STAGE(PG8_SB(1, 1), cB + hstep + kstep, voffB);
        PG8_WAIT_V(6); PG8_BAR;
    }
    for (;;) {
        const bool has_next = S.next(ui + 1, nxt);
        if (has_next) PG8_LOADOFF(n0, n1, nxt.pm);
        const char* nA = cA; const char* nB = has_next ? (const char*)g.Bt + (size_t)nxt.pn * tstep : cB;
        for (int t = 0; t < nt; t += 2) {
            const bool last = (t == nt - 2);
            const char* a1 = cA + (size_t)(t + 1) * kstep;
            const char* a2 = last ? nA : cA + (size_t)(t + 2) * kstep; const char* b2 = last ? nB : cB + (size_t)(t + 2) * kstep;
            const char* a3 = a2 + kstep; const char* b3 = b2 + kstep;
            unsigned o2a[2], o2b[2];
#pragma unroll
            for (int _i = 0; _i < 2; ++_i) { o2a[_i] = last ? n0[_i] : v0[_i]; o2b[_i] = last ? n1[_i] : v1[_i]; }
            if (last && has_next) S.a_ready(nxt);
            if constexpr (SP2) {
            PG8_LDB(B0, 0, 0); PG8_LDB(B1, 0, 1); PG8_SCHED; PG8_LDA(At, 0, 0); PG8_STAGE(PG8_SA(1, 1), a1, v1);
            PG8_WAIT_V(8); PG8_WAIT_L(0); PG8_BAR; PG8_MMA(0, 0, At, B0); PG8_MMA(0, 1, At, B1); PG8_BAR; PG8_SCHED;
            PG8_LDA(At, 0, 1); PG8_STAGE(PG8_SB(0, 0), b2, voffB); PG8_STAGE(PG8_SB(0, 1), b2 + hstep, voffB); PG8_STAGE(PG8_SA(0, 0), a2, o2a);
            PG8_WAIT_V(8); PG8_WAIT_L(0); PG8_BAR; PG8_MMA(1, 0, At, B0); PG8_MMA(1, 1, At, B1); PG8_BAR; PG8_SCHED;
            PG8_LDB(B0, 1, 0); PG8_LDB(B1, 1, 1); PG8_SCHED; PG8_LDA(At, 1, 0); PG8_STAGE(PG8_SA(0, 1), a2, o2b);
            PG8_WAIT_V(8); PG8_WAIT_L(0); PG8_BAR; PG8_MMA(0, 0, At, B0); PG8_MMA(0, 1, At, B1); PG8_BAR; PG8_SCHED;
            PG8_LDA(At, 1, 1); PG8_STAGE(PG8_SB(1, 0), b3, voffB); PG8_STAGE(PG8_SB(1, 1), b3 + hstep, voffB); PG8_STAGE(PG8_SA(1, 0), a3, o2a);
            PG8_WAIT_V(8); PG8_WAIT_L(0); PG8_BAR; PG8_MMA(1, 0, At, B0); PG8_MMA(1, 1, At, B1); PG8_BAR; PG8_SCHED;
            } else {
            PG8_LDB(B0, 0, 0); PG8_SCHED; PG8_LDA(At, 0, 0); PG8_STAGE(PG8_SA(1, 1), a1, v1);
            PG8_WAIT_L(8); PG8_BAR; PG8_WAIT_L(0); PG8_MMA(0, 0, At, B0); PG8_BAR; PG8_SCHED;
            PG8_LDB(B1, 0, 1); PG8_STAGE(PG8_SB(0, 0), b2, voffB);
            PG8_BAR; PG8_WAIT_L(0); PG8_MMA(0, 1, At, B1); PG8_BAR;
            PG8_LDA(At, 0, 1); PG8_STAGE(PG8_SA(0, 0), a2, o2a);
            PG8_BAR; PG8_WAIT_L(0); PG8_MMA(1, 0, At, B0); PG8_BAR; PG8_SCHED;
            PG8_STAGE(PG8_SB(0, 1), b2 + hstep, voffB);
            PG8_WAIT_V(6); PG8_BAR; PG8_MMA(1, 1, At, B1); PG8_BAR;
            PG8_LDB(B0, 1, 0); PG8_SCHED; PG8_LDA(At, 1, 0); PG8_STAGE(PG8_SA(0, 1), a2, o2b);
            PG8_WAIT_L(8); PG8_BAR; PG8_WAIT_L(0); PG8_MMA(0, 0, At, B0); PG8_BAR; PG8_SCHED;
            PG8_LDB(B1, 1, 1); PG8_STAGE(PG8_SB(1, 0), b3, voffB);
            PG8_BAR; PG8_WAIT_L(0); PG8_MMA(0, 1, At, B1); PG8_BAR;
            PG8_LDA(At, 1, 1); PG8_STAGE(PG8_SA(1, 0), a3, o2a);
            PG8_BAR; PG8_WAIT_L(0); PG8_MMA(1, 0, At, B0); PG8_BAR; PG8_SCHED;
            PG8_STAGE(PG8_SB(1, 1), b3 + hstep, voffB);
            PG8_WAIT_V(6); PG8_BAR; PG8_MMA(1, 1, At, B1); PG8_BAR;
            }
        }
        if constexpr (ALIGN_EPI) { if (wr == 0) PG8_BAR; }
        if constexpr (!Epi::AFTER_DRAIN) { E(acc, cur, wr, wc, fr, fq); S.done(cur); }
        if (!has_next) break;
#pragma unroll
        for (int a = 0; a < 2; ++a)
#pragma unroll
            for (int b = 0; b < 2; ++b)
#pragma unroll
                for (int m = 0; m < 4; ++m)
#pragma unroll
                    for (int n = 0; n < 2; ++n) acc[a][b][m][n] = (i32x4){0, 0, 0, 0};
        cur = nxt; cA = nA; cB = nB; ++ui;
#pragma unroll
        for (int _i = 0; _i < 2; ++_i) { v0[_i] = n0[_i]; v1[_i] = n1[_i]; }
        if constexpr (ALIGN_EPI) { if (wr == 1) PG8_BAR; }
    }
    PG8_WAIT_V(0);
    if constexpr (!ALIGN_EPI) { if (wr == 0) PG8_BAR; }
    PG8_BAR;
    if constexpr (Epi::AFTER_DRAIN) { E.fused(acc, cur, wr, wc, fr, fq, lds, wid, lane); S.done(cur); }
#undef PG8_LOADOFF
#undef PG8_SA
#undef PG8_SB
#undef PG8_STAGE
#undef PG8_LDA
#undef PG8_LDB
#undef PG8_MMA
#undef PG8_WAIT_V
#undef PG8_WAIT_L
#undef PG8_BAR
#undef PG8_SCHED
}template <class Epi, class Sched, bool ALIGN_EPI = false, bool SP2 = false>
__device__ __forceinline__ void gemm_phase_i8(PG8_LAS unsigned char* lds, const Gemm g, const Sched& S, const Epi& E, const int tid_arg) {
    int tid_ = tid_arg; asm volatile("" : "+v"(tid_));
    const int tid = tid_, wid = __builtin_amdgcn_readfirstlane(tid >> 6), lane = tid & 63, wr = wid >> 2, wc = wid & 3, fr = lane & 15, fq = lane >> 4;
    const int K = g.K, nt = K / BK;
    unsigned voffA[2], voffB[2];
#pragma unroll
    for (int i = 0; i < 2; ++i) { int R, C; stage_rc(tid * 16 + i * 8192, R, C); const int Rb = Epi::PERM ? ((R & ~31) + perm32(R & 31)) : R;
        voffA[i] = (unsigned)(R * K + C) * 2u; voffB[i] = (unsigned)(Rb * K + C) * 2u; }
    const size_t kstep = (size_t)(BK * 2);
    const size_t hstep = (size_t)HALF * K * 2;
    const size_t tstep = 2 * hstep;
    const unsigned ldsw = (unsigned)wid * 1024u;
    const int aoff = lds_byte(wr * 64 + fr, fq * 8), boff = lds_byte(wc * 32 + fr, fq * 8);
#define PG8_SA(b, h) (((b) * 2 + (h)) * HTB)
#define PG8_SB(b, h) ((4 + (b) * 2 + (h)) * HTB)
#define PG8_STAGE(bufoff, gbase, voff) do { _Pragma("unroll") for (int _i = 0; _i < 2; ++_i) \
        __builtin_amdgcn_global_load_lds((const unsigned*)((const char*)(gbase) + (voff)[_i]), (PG8_LAS unsigned*)(lds + (bufoff) + ldsw + _i * 8192), 16, 0, 0); } while (0)
#define PG8_LDA(dst, b, h) do { _Pragma("unroll") for (int m = 0; m < 4; ++m) _Pragma("unroll") for (int k = 0; k < 2; ++k) dst[m][k] = *(const PG8_LAS bf16x8*)(lds + PG8_SA(b, h) + aoff + m * 2048 + k * 1024); } while (0)
#define PG8_LDB(dst, b, h) do { _Pragma("unroll") for (int n = 0; n < 2; ++n) _Pragma("unroll") for (int k = 0; k < 2; ++k) dst[n][k] = *(const PG8_LAS bf16x8*)(lds + PG8_SB(b, h) + boff + n * 2048 + k * 1024); } while (0)
#define PG8_MMA(ai, bj, At, Bt) do { __builtin_amdgcn_s_setprio(1); _Pragma("unroll") for (int m = 0; m < 4; ++m) _Pragma("unroll") for (int n = 0; n < 2; ++n) _Pragma("unroll") for (int k = 0; k < 2; ++k) \
        acc[ai][bj][m][n] = __builtin_amdgcn_mfma_i32_16x16x64_i8(__builtin_bit_cast(i32x4, Bt[n][k]), __builtin_bit_cast(i32x4, At[m][k]), acc[ai][bj][m][n], 0, 0, 0); __builtin_amdgcn_s_setprio(0); } while (0)
#define PG8_WAIT_V(n) asm volatile("s_waitcnt vmcnt(" #n ")" ::: "memory")
#define PG8_WAIT_L(n) asm volatile("s_waitcnt lgkmcnt(" #n ")" ::: "memory")
#define PG8_BAR __builtin_amdgcn_s_barrier()
#define PG8_SCHED __builtin_amdgcn_sched_barrier(0)
    Unit cur, nxt; int ui = 0;
    if (!S.next(0, cur)) return;
    i32x4 acc[2][2][4][2];
#pragma unroll
    for (int a = 0; a < 2; ++a)
#pragma unroll
        for (int b = 0; b < 2; ++b)
#pragma unroll
            for (int m = 0; m < 4; ++m)
#pragma unroll
                for (int n = 0; n < 2; ++n) acc[a][b][m][n] = (i32x4){0, 0, 0, 0};
    bf16x8 At[4][2], B0[2][2], B1[2][2];
    const char* cA = (const char*)g.A + (size_t)cur.pm * tstep; const char* cB = (const char*)g.Bt + (size_t)cur.pn * tstep;
    S.a_ready(cur);
    if constexpr (SP2) {
        PG8_STAGE(PG8_SB(0, 0), cB, voffB); PG8_STAGE(PG8_SB(0, 1), cB + hstep, voffB); PG8_STAGE(PG8_SA(0, 0), cA, voffA); PG8_STAGE(PG8_SA(0, 1), cA + hstep, voffA);
        if (wr == 1) PG8_BAR;
        PG8_WAIT_V(2); PG8_BAR;
        PG8_STAGE(PG8_SB(1, 0), cB + kstep, voffB); PG8_STAGE(PG8_SA(1, 0), cA + kstep, voffA); PG8_STAGE(PG8_SB(1, 1), cB + hstep + kstep, voffB);
        PG8_WAIT_V(6); PG8_BAR;
    } else {
        PG8_STAGE(PG8_SB(0, 0), cB, voffB); PG8_STAGE(PG8_SA(0, 0), cA, voffA); PG8_STAGE(PG8_SB(0, 1), cB + hstep, voffB); PG8_STAGE(PG8_SA(0, 1), cA + hstep, voffA);
        if (wr == 1) PG8_BAR;
        PG8_WAIT_V(4); PG8_BAR;
        PG8_STAGE(PG8_SB(1, 0), cB + kstep, voffB); PG8_STAGE(PG8_SA(1, 0), cA + kstep, voffA); PG8_STAGE(PG8_SB(1, 1), cB + hstep + kstep, voffB);
        PG8_WAIT_V(6); PG8_BAR;
    }
    for (;;) {
        const bool has_next = S.next(ui + 1, nxt);
        const char* nA = has_next ? (const char*)g.A + (size_t)nxt.pm * tstep : cA; const char* nB = has_next ? (const char*)g.Bt + (size_t)nxt.pn * tstep : cB;
        for (int t = 0; t < nt; t += 2) {
            const bool last = (t == nt - 2);
            const char* a1 = cA + (size_t)(t + 1) * kstep;
            const char* a2 = last ? nA : cA + (size_t)(t + 2) * kstep; const char* b2 = last ? nB : cB + (size_t)(t + 2) * kstep;
            const char* a3 = a2 + kstep; const char* b3 = b2 + kstep;
            if (last && has_next) S.a_ready(nxt);
            if constexpr (SP2) {
            PG8_LDB(B0, 0, 0); PG8_LDB(B1, 0, 1); PG8_SCHED; PG8_LDA(At, 0, 0); PG8_STAGE(PG8_SA(1, 1), a1 + hstep, voffA);
            PG8_WAIT_V(8); PG8_WAIT_L(0); PG8_BAR; PG8_MMA(0, 0, At, B0); PG8_MMA(0, 1, At, B1); PG8_BAR; PG8_SCHED;
            PG8_LDA(At, 0, 1); PG8_STAGE(PG8_SB(0, 0), b2, voffB); PG8_STAGE(PG8_SB(0, 1), b2 + hstep, voffB); PG8_STAGE(PG8_SA(0, 0), a2, voffA);
            PG8_WAIT_V(8); PG8_WAIT_L(0); PG8_BAR; PG8_MMA(1, 0, At, B0); PG8_MMA(1, 1, At, B1); PG8_BAR; PG8_SCHED;
            PG8_LDB(B0, 1, 0); PG8_LDB(B1, 1, 1); PG8_SCHED; PG8_LDA(At, 1, 0); PG8_STAGE(PG8_SA(0, 1), a2 + hstep, voffA);
            PG8_WAIT_V(8); PG8_WAIT_L(0); PG8_BAR; PG8_MMA(0, 0, At, B0); PG8_MMA(0, 1, At, B1); PG8_BAR; PG8_SCHED;
            PG8_LDA(At, 1, 1); PG8_STAGE(PG8_SB(1, 0), b3, voffB); PG8_STAGE(PG8_SB(1, 1), b3 + hstep, voffB); PG8_STAGE(PG8_SA(1, 0), a3, voffA);
            PG8_WAIT_V(8); PG8_WAIT_L(0); PG8_BAR; PG8_MMA(1, 0, At, B0); PG8_MMA(1, 1, At, B1); PG8_BAR; PG8_SCHED;
            } else {
            PG8_LDB(B0, 0, 0); PG8_SCHED; PG8_LDA(At, 0, 0); PG8_STAGE(PG8_SA(1, 1), a1 + hstep, voffA);
            PG8_WAIT_L(8); PG8_BAR; PG8_WAIT_L(0); PG8_MMA(0, 0, At, B0); PG8_BAR; PG8_SCHED;
            PG8_LDB(B1, 0, 1); PG8_STAGE(PG8_SB(0, 0), b2, voffB);
            PG8_BAR; PG8_WAIT_L(0); PG8_MMA(0, 1, At, B1); PG8_BAR;
            PG8_LDA(At, 0, 1); PG8_STAGE(PG8_SA(0, 0), a2, voffA);
            PG8_BAR; PG8_WAIT_L(0); PG8_MMA(1, 0, At, B0); PG8_BAR; PG8_SCHED;
            PG8_STAGE(PG8_SB(0, 1), b2 + hstep, voffB);
            PG8_WAIT_V(6); PG8_BAR; PG8_MMA(1, 1, At, B1); PG8_BAR;
            PG8_LDB(B0, 1, 0); PG8_SCHED; PG8_LDA(At, 1, 0); PG8_STAGE(PG8_SA(0, 1), a2 + hstep, voffA);
            PG8_WAIT_L(8); PG8_BAR; PG8_WAIT_L(0); PG8_MMA(0, 0, At, B0); PG8_BAR; PG8_SCHED;
            PG8_LDB(B1, 1, 1); PG8_STAGE(PG8_SB(1, 0), b3, voffB);
            PG8_BAR; PG8_WAIT_L(0); PG8_MMA(0, 1, At, B1); PG8_BAR;
            PG8_LDA(At, 1, 1); PG8_STAGE(PG8_SA(1, 0), a3, voffA);
            PG8_BAR; PG8_WAIT_L(0); PG8_MMA(1, 0, At, B0); PG8_BAR; PG8_SCHED;
            PG8_STAGE(PG8_SB(1, 1), b3 + hstep, voffB);
            PG8_WAIT_V(6); PG8_BAR; PG8_MMA(1, 1, At, B1); PG8_BAR;
            }
        }
        if constexpr (ALIGN_EPI) { if (wr == 0) PG8_BAR; }
        if constexpr (!Epi::AFTER_DRAIN) { E(acc, cur, wr, wc, fr, fq); S.done(cur); }
        if (!has_next) break;
#pragma unroll
        for (int a = 0; a < 2; ++a)
#pragma unroll
            for (int b = 0; b < 2; ++b)
#pragma unroll
                for (int m = 0; m < 4; ++m)
#pragma unroll
                    for (int n = 0; n < 2; ++n) acc[a][b][m][n] = (i32x4){0, 0, 0, 0};
        cur = nxt; cA = nA; cB = nB; ++ui;
        if constexpr (ALIGN_EPI) { if (wr == 1) PG8_BAR; }
    }
    PG8_WAIT_V(0);
    if constexpr (!ALIGN_EPI) { if (wr == 0) PG8_BAR; }
    PG8_BAR;
    if constexpr (Epi::AFTER_DRAIN) { E.fused(acc, cur, wr, wc, fr, fq, lds, wid, lane); S.done(cur); }
#undef PG8_SA
#undef PG8_SB
#undef PG8_STAGE
#undef PG8_LDA
#undef PG8_LDB
#undef PG8_MMA
#undef PG8_WAIT_V
#undef PG8_WAIT_L
#undef PG8_BAR
#undef PG8_SCHED
}}

#ifndef PROBE_MASK
#define PROBE_MASK 0
#endif
#ifndef PROBE_TMASK
#define PROBE_TMASK 0
#endif
namespace mk {
using pg8::bf16_t; using pg8::bf16x8; using pg8::f32x4; using pg8::u32x4; using pg8::Unit;
typedef float f32x16 __attribute__((ext_vector_type(16)));
typedef short s16x4 __attribute__((ext_vector_type(4)));
typedef unsigned u32x2 __attribute__((ext_vector_type(2)));
typedef float f32x2_t __attribute__((ext_vector_type(2)));
typedef __bf16 bf16x2_t __attribute__((ext_vector_type(2)));

constexpr int D = 1024, NB = 16, SEQ = 2048, CTXL = 256, DEPTH = 4;
constexpr int NL = NB * SEQ, NC = NB * CTXL, NT = NL + NC;
constexpr int PIN = 3088, NPROJ = 3072;
constexpr int NE = 16, DE = 1408;
constexpr int NTILE = 288, YROWS = NTILE * 256;
constexpr float EPS = 1e-6f;
constexpr float LOG2E = 1.4426950408889634f;
constexpr int NWAVES = 8, NTHREADS = 512;

constexpr size_t al256(size_t x) { return (x + 255) & ~(size_t)255; }
constexpr size_t WS_CTL = 0, CTL_BYTES = 2u << 20;
constexpr size_t WS_AMAXIN = 98304;
constexpr size_t CTL_ZERO_BYTES = WS_AMAXIN + (size_t)4 * 3072 * 4;
constexpr size_t WS_MOD = CTL_BYTES,                      MOD_BYTES = (size_t)DEPTH * 17 * 6144 * 4;
constexpr size_t WS_ROPE = al256(WS_MOD + MOD_BYTES),     ROPE_BYTES = (size_t)2 * 2048 * 32 * 4;
constexpr size_t WS_QKW = al256(WS_ROPE + ROPE_BYTES),    QKW_BYTES = (size_t)DEPTH * 128 * 4;
constexpr size_t WS_WT = al256(WS_QKW + QKW_BYTES),      WT_BYTES = (size_t)DEPTH * 2 * 16 * 1024 * 4;
constexpr size_t WS_WIN = al256(WS_WT + WT_BYTES),     WIN_BYTES = (size_t)DEPTH * NPROJ * D * 2;
constexpr size_t WS_WOUT = al256(WS_WIN + WIN_BYTES),     WOUT_BYTES = (size_t)DEPTH * D * D * 2;
constexpr size_t WS_WGU = al256(WS_WOUT + WOUT_BYTES),    WGU_BYTES = (size_t)DEPTH * NE * 2816 * D * 2;
constexpr size_t WS_WD = al256(WS_WGU + WGU_BYTES),       WD_BYTES = (size_t)DEPTH * NE * D * DE * 2;
constexpr size_t WS_HA = al256(WS_WD + WD_BYTES),         HA_BYTES = (size_t)NT * D * 2;
constexpr size_t WS_XB = al256(WS_HA + HA_BYTES),         XB_BYTES = (size_t)NT * D * 2;
constexpr size_t WS_DT = al256(WS_XB + XB_BYTES),     DT_BYTES = (size_t)NT * 16 * 4;
constexpr size_t WS_AFF = al256(WS_DT + DT_BYTES),        AFF_BYTES = (size_t)NT * 16 * 4;
constexpr size_t WS_GATE = al256(WS_AFF + AFF_BYTES),     GATE_BYTES = (size_t)YROWS * 4;
constexpr size_t WS_INV = al256(WS_GATE + GATE_BYTES),    INV_BYTES = (size_t)NT * 16 * 4;
constexpr size_t WS_ROFF = al256(WS_INV + INV_BYTES),    ROFF_BYTES = (size_t)YROWS * 4;
constexpr size_t WS_SW = al256(WS_ROFF + ROFF_BYTES),     SW_BYTES = (size_t)DEPTH * NE * 2816 * 4;
constexpr size_t WS_HQ = al256(WS_SW + SW_BYTES),         HQ_BYTES = (size_t)NT * D;
constexpr size_t WS_SA = al256(WS_HQ + HQ_BYTES),         SA_BYTES = (size_t)NT * 4;
constexpr size_t WS_SAY = al256(WS_SA + SA_BYTES),        SAY_BYTES = (size_t)YROWS * 4;
constexpr size_t WS_SAH = al256(WS_SAY + SAY_BYTES),      SAH_BYTES = (size_t)NT * 4;
constexpr size_t WS_SWIN = al256(WS_SAH + SAH_BYTES),     SWIN_BYTES = (size_t)DEPTH * NPROJ * 4;
constexpr size_t WS_U = al256(WS_SWIN + SWIN_BYTES);
constexpr size_t U_Q = 0,                                 QKVZ_BYTES = (size_t)NT * 512 * 2;
constexpr size_t U_K = U_Q + QKVZ_BYTES, U_V = U_K + QKVZ_BYTES, U_Z = U_V + QKVZ_BYTES;
constexpr size_t U_XBC = U_Z + QKVZ_BYTES,                XBC_BYTES = (size_t)NT * 1024 * 2;
constexpr size_t U_XBCC = U_XBC + XBC_BYTES;
constexpr size_t U_GM = U_XBCC + XBC_BYTES,               GM_BYTES = (size_t)288 * 2 * 128 * 128 * 2;
constexpr size_t U_YF = U_GM + GM_BYTES, U_YB = U_YF + QKVZ_BYTES;
constexpr size_t U_A2 = U_YB + QKVZ_BYTES;
constexpr size_t U_MIX_END = U_A2 + XBC_BYTES;
constexpr size_t U_XE = 0,                                XE_BYTES = (size_t)YROWS * D * 2;
constexpr size_t U_HID = U_XE + XE_BYTES,                 HID_BYTES = (size_t)YROWS * DE * 2;
constexpr size_t U_Y = U_HID + HID_BYTES;
constexpr size_t U_MOE_END = U_Y + XE_BYTES;
constexpr size_t WS_END = WS_U + (U_MIX_END > U_MOE_END ? U_MIX_END : U_MOE_END);

constexpr int CW_BAR = 0;
constexpr int CW_WQ = 16384;
constexpr int CW_CVQ = 12288;
constexpr int CW_DONE = 14336;
constexpr int CW_ZERO = 8192;

constexpr int LDS_BYTES = 155648;
constexpr int MISC_OFF = 154624;

__device__ __forceinline__ unsigned pk2(float lo, float hi) { f32x2_t v = {lo, hi}; bf16x2_t b = __builtin_convertvector(v, bf16x2_t); return __builtin_bit_cast(unsigned, b); }
__device__ __forceinline__ float bflo(unsigned w) { return __uint_as_float(w << 16); }
__device__ __forceinline__ float bfhi(unsigned w) { return __uint_as_float(w & 0xffff0000u); }
__device__ __forceinline__ float bf1(unsigned short h) { return __uint_as_float((unsigned)h << 16); }
__device__ __forceinline__ unsigned short f2bf(float f) { return (unsigned short)(pk2(f, 0.f) & 0xffffu); }
__device__ __forceinline__ float silu_f(float x) { return x / (1.f + __expf(-x)); }
__device__ __forceinline__ int lane_id_v() { int l; asm volatile("v_mbcnt_lo_u32_b32 %0, -1, 0\n\tv_mbcnt_hi_u32_b32 %0, -1, %0" : "=v"(l)); return l; }
__device__ __forceinline__ float shx(float v, int m, int lane) { return __int_as_float(__builtin_amdgcn_ds_bpermute((lane ^ m) << 2, __float_as_int(v))); }
__device__ __forceinline__ float shl_from(float v, int src_lane) { return __int_as_float(__builtin_amdgcn_ds_bpermute(src_lane << 2, __float_as_int(v))); }
__device__ __forceinline__ int shl_from_i(int v, int src_lane) { return __builtin_amdgcn_ds_bpermute(src_lane << 2, v); }
__device__ __forceinline__ float wave_sum(float v) {
    const int l = lane_id_v();
#pragma unroll
    for (int o = 1; o < 64; o <<= 1) v += shx(v, o, l);
    return v;
}
__device__ __forceinline__ float wave_max(float v) {
    const int l = lane_id_v();
#pragma unroll
    for (int o = 1; o < 64; o <<= 1) v = fmaxf(v, shx(v, o, l));
    return v;
}
template <int CTRL> __device__ __forceinline__ float dpp_f(float v) { return __int_as_float(__builtin_amdgcn_update_dpp(0, __float_as_int(v), CTRL, 0xf, 0xf, true)); }
__device__ __forceinline__ float rl_f(float v, int l) { return __int_as_float(__builtin_amdgcn_readlane(__float_as_int(v), l)); }
__device__ __forceinline__ float wave_sum_dpp(float v) {
    v += dpp_f<0xB1>(v); v += dpp_f<0x4E>(v); v += dpp_f<0x141>(v); v += dpp_f<0x140>(v);
    return (rl_f(v, 0) + rl_f(v, 16)) + (rl_f(v, 32) + rl_f(v, 48));
}
__device__ __forceinline__ float wave_max_dpp(float v) {
    v = fmaxf(v, dpp_f<0xB1>(v)); v = fmaxf(v, dpp_f<0x4E>(v)); v = fmaxf(v, dpp_f<0x141>(v)); v = fmaxf(v, dpp_f<0x140>(v));
    return fmaxf(fmaxf(rl_f(v, 0), rl_f(v, 16)), fmaxf(rl_f(v, 32), rl_f(v, 48)));
}
#define LDS_WAIT() asm volatile("s_waitcnt lgkmcnt(0)" ::: "memory")
__device__ __forceinline__ void lds_barrier() { asm volatile("s_waitcnt lgkmcnt(0)" ::: "memory"); __builtin_amdgcn_s_barrier(); asm volatile("" ::: "memory"); }
__device__ __forceinline__ u32x4 pack8(f32x4 a, f32x4 b) { u32x4 w; w.x = pk2(a[0], a[1]); w.y = pk2(a[2], a[3]); w.z = pk2(b[0], b[1]); w.w = pk2(b[2], b[3]); return w; }

__device__ __forceinline__ float reduce16(float (&v)[16], int lane) {
    { const bool b = (lane & 32) != 0;
#pragma unroll
      for (int i = 0; i < 8; ++i) { const float send = b ? v[i] : v[i + 8], keep = b ? v[i + 8] : v[i]; v[i] = keep + shx(send, 32, lane); } }
    { const bool b = (lane & 16) != 0;
#pragma unroll
      for (int i = 0; i < 4; ++i) { const float send = b ? v[i] : v[i + 4], keep = b ? v[i + 4] : v[i]; v[i] = keep + shx(send, 16, lane); } }
    { const bool b = (lane & 8) != 0;
#pragma unroll
      for (int i = 0; i < 2; ++i) { const float send = b ? v[i] : v[i + 2], keep = b ? v[i + 2] : v[i]; v[i] = keep + shx(send, 8, lane); } }
    { const bool b = (lane & 4) != 0; const float send = b ? v[0] : v[1], keep = b ? v[1] : v[0]; v[0] = keep + shx(send, 4, lane); }
    float t = v[0]; t += shx(t, 1, lane); t += shx(t, 2, lane); return t;
}
__device__ __forceinline__ int colidx16(int lane) { return ((lane >> 5) & 1) * 8 + ((lane >> 4) & 1) * 4 + ((lane >> 3) & 1) * 2 + ((lane >> 2) & 1); }
__device__ __forceinline__ int laneof16(int c) { return ((c >> 3) & 1) * 32 + ((c >> 2) & 1) * 16 + ((c >> 1) & 1) * 8 + (c & 1) * 4; }

__device__ __forceinline__ bf16x8 frag_rm(LAS const unsigned char* base, int stride, int row0, int k0, int lane) {
    return *(LAS const bf16x8*)(base + (row0 + (lane & 31)) * stride + (k0 + 8 * (lane >> 5)) * 2);
}
__device__ __forceinline__ bf16x8 frag_tr(LAS const unsigned char* base, int stride, int k0, int col0, int lane) {
    const int h = lane >> 5, blk = (lane >> 4) & 1, q = (lane & 15) >> 2, p = lane & 3;
    LAS const unsigned char* a = base + (k0 + 8 * h + q) * stride + (col0 + 16 * blk + 4 * p) * 2;
    const s16x4 lo = __builtin_bit_cast(s16x4, __builtin_amdgcn_ds_read_tr16_b64_v4i16((LAS s16x4*)a));
    const s16x4 hi = __builtin_bit_cast(s16x4, __builtin_amdgcn_ds_read_tr16_b64_v4i16((LAS s16x4*)(a + 4 * stride)));
    return (bf16x8){lo[0], lo[1], lo[2], lo[3], hi[0], hi[1], hi[2], hi[3]};
}
__device__ __forceinline__ bf16x8 frag_tr_acc(LAS const unsigned char* base, int stride, int k0, int col0, int lane) {
    const int h = lane >> 5, blk = (lane >> 4) & 1, q = (lane & 15) >> 2, p = lane & 3;
    LAS const unsigned char* a = base + (k0 + 4 * h + q) * stride + (col0 + 16 * blk + 4 * p) * 2;
    const s16x4 lo = __builtin_bit_cast(s16x4, __builtin_amdgcn_ds_read_tr16_b64_v4i16((LAS s16x4*)a));
    const s16x4 hi = __builtin_bit_cast(s16x4, __builtin_amdgcn_ds_read_tr16_b64_v4i16((LAS s16x4*)(a + 8 * stride)));
    return (bf16x8){lo[0], lo[1], lo[2], lo[3], hi[0], hi[1], hi[2], hi[3]};
}
__device__ __forceinline__ int accrow(int t, int h) { return (t & 3) + 8 * (t >> 2) + 4 * h; }
#define MFMA32(a, b, c) __builtin_amdgcn_mfma_f32_32x32x16_bf16((a), (b), (c), 0, 0, 0)

struct Frame {
    LAS unsigned char* lds;
    int tid, lane, wave, G, blk;
};
__device__ __forceinline__ unsigned long long karg64(int byteoff) {
    unsigned long long p; auto ka = __builtin_amdgcn_kernarg_segment_ptr();
    asm volatile("s_load_dwordx2 %0, %1, %2\n\ts_waitcnt lgkmcnt(0)" : "=s"(p) : "s"(ka), "i"(byteoff) : "memory");
    return p;
}
#define INP(i)  ((const float*)(const GAS float*)karg64(8 * (i)))
#define OUTP()  ((float*)(GAS float*)karg64(232))
#define WSP()   ((unsigned char*)(GAS unsigned char*)karg64(240))
#define F_CTL   ((unsigned*)(WSP() + WS_CTL))
#define F_MOD   ((float*)(WSP() + WS_MOD))
#define F_ROPEC ((float*)(WSP() + WS_ROPE))
#define F_ROPES ((float*)(WSP() + WS_ROPE) + 2048 * 32)
#define F_QKW   ((float*)(WSP() + WS_QKW))
#define F_WT    ((float*)(WSP() + WS_WT))
#define F_WIN   ((bf16_t*)(WSP() + WS_WIN))
#define F_WOUT  ((bf16_t*)(WSP() + WS_WOUT))
#define F_WGU   ((bf16_t*)(WSP() + WS_WGU))
#define F_WGUQ  ((signed char*)(WSP() + WS_WGU))
#define F_WD    ((bf16_t*)(WSP() + WS_WD))
#define F_HA    ((bf16_t*)(WSP() + WS_HA))
#define F_XB    ((bf16_t*)(WSP() + WS_XB))
#define F_DT    ((float*)(WSP() + WS_DT))
#define F_AFF   ((float*)(WSP() + WS_AFF))
#define F_GATE  ((float*)(WSP() + WS_GATE))
#define F_INV   ((int*)(WSP() + WS_INV))
#define F_ROFF  ((unsigned*)(WSP() + WS_ROFF))
#define F_AMAXIN ((unsigned*)(WSP() + WS_AMAXIN))
#define F_SAH   ((float*)(WSP() + WS_SAH))
#define F_SWIN  ((float*)(WSP() + WS_SWIN))
#define F_HAQ   ((signed char*)(WSP() + WS_HA))
#define F_WINQ  ((signed char*)(WSP() + WS_WIN))
#define F_SW    ((float*)(WSP() + WS_SW))
#define F_HQ    ((signed char*)(WSP() + WS_HQ))
#define F_SA    ((float*)(WSP() + WS_SA))
#define F_SAY   ((float*)(WSP() + WS_SAY))
#define F_Q     ((bf16_t*)(WSP() + WS_U + U_Q))
#define F_K     ((bf16_t*)(WSP() + WS_U + U_K))
#define F_V     ((bf16_t*)(WSP() + WS_U + U_V))
#define F_Z     ((bf16_t*)(WSP() + WS_U + U_Z))
#define F_XBC   ((bf16_t*)(WSP() + WS_U + U_XBC))
#define F_XBCC  ((bf16_t*)(WSP() + WS_U + U_XBCC))
#define F_GM    ((bf16_t*)(WSP() + WS_U + U_GM))
#define F_YF    ((bf16_t*)(WSP() + WS_U + U_YF))
#define F_YB    ((bf16_t*)(WSP() + WS_U + U_YB))
#define F_A2    ((bf16_t*)(WSP() + WS_U + U_A2))
#define F_XE    ((bf16_t*)(WSP() + WS_U + U_XE))
#define F_HID   ((bf16_t*)(WSP() + WS_U + U_HID))
#define F_Y     ((bf16_t*)(WSP() + WS_U + U_Y))
enum { I_X = 0, I_C, I_CTX, I_CCTX, I_WMOD, I_BMOD, I_N1W, I_N2W, I_WIN, I_QNW, I_KNW, I_LQ1, I_LK1, I_LQ2, I_LK2, I_SUBLN, I_CONVW, I_CONVB,
       I_DTBF, I_DTBB, I_ALOGF, I_ALOGB, I_DSKIP, I_SSDNW, I_WOUT, I_WR, I_WG, I_WU, I_WDN };

constexpr int CT_STR = 144;
__device__ __forceinline__ int inv_perm32(int x) { return 16 * ((x >> 2) & 1) + 4 * (x >> 3) + (x & 3); }
__device__ __forceinline__ int cvt_row_of_col(int c, int kperm) { return (c & 32) + (kperm ? inv_perm32(c & 31) : (c & 31)); }
__device__ __forceinline__ unsigned pack_i8x4(float a, float b, float c, float d, float inv) {
    const unsigned ua = __float_as_uint(fmaf(a, inv, 12582912.f)), ub = __float_as_uint(fmaf(b, inv, 12582912.f)), uc = __float_as_uint(fmaf(c, inv, 12582912.f)), ud = __float_as_uint(fmaf(d, inv, 12582912.f));
    const unsigned p01 = __builtin_amdgcn_perm(ub, ua, 0x0c0c0400u), p23 = __builtin_amdgcn_perm(ud, uc, 0x0c0c0400u);
    return __builtin_amdgcn_perm(p23, p01, 0x05040100u);
}
__device__ __forceinline__ unsigned pack_i8x4s(float a, float ia, float b, float ib, float c, float ic, float d, float id) {
    const unsigned ua = __float_as_uint(fmaf(a, ia, 12582912.f)), ub = __float_as_uint(fmaf(b, ib, 12582912.f)), uc = __float_as_uint(fmaf(c, ic, 12582912.f)), ud = __float_as_uint(fmaf(d, id, 12582912.f));
    const unsigned p01 = __builtin_amdgcn_perm(ub, ua, 0x0c0c0400u), p23 = __builtin_amdgcn_perm(ud, uc, 0x0c0c0400u);
    return __builtin_amdgcn_perm(p23, p01, 0x05040100u);
}
__device__ __forceinline__ void cvt_item64(const float* __restrict__ src, int ld, int c0a, int c0b, int kperm, int k0, bf16_t* __restrict__ dst, int K, LAS float* scr, int lane) {
    LAS unsigned char* T = (LAS unsigned char*)scr;
    { const int cq = lane & 15, rq = lane >> 4, col = ((cq >> 3) ? c0b : c0a) + 4 * (cq & 7);
      f32x4 v[16];
#pragma unroll
      for (int i = 0; i < 16; ++i) v[i] = __builtin_nontemporal_load((const f32x4*)(src + (size_t)(k0 + 4 * i + rq) * ld + col));
#pragma unroll
      for (int i = 0; i < 16; ++i) *(LAS u32x2*)(T + (4 * i + rq) * CT_STR + 8 * cq) = (u32x2){pk2(v[i][0], v[i][1]), pk2(v[i][2], v[i][3])}; }
    LDS_WAIT();
    const int h = lane >> 5;
#pragma unroll
    for (int kk = 0; kk < 4; ++kk)
#pragma unroll
        for (int cc = 0; cc < 2; ++cc) { const bf16x8 f = frag_tr(T, CT_STR, 16 * kk, 32 * cc, lane); const int n = cvt_row_of_col(32 * cc + (lane & 31), kperm);
            __builtin_nontemporal_store(__builtin_bit_cast(u32x4, f), (u32x4*)(dst + (size_t)n * K + k0 + 16 * kk + 8 * h)); }
    LDS_WAIT();
}
__device__ __forceinline__ void cvt_item64_i8(const float* __restrict__ src, int ld, int c0a, int c0b, int kperm, int k0, signed char* __restrict__ dst, int Kb, const unsigned* __restrict__ amax, float* sw,
                                              LAS float* scr, int lane) {
    LAS unsigned char* T = (LAS unsigned char*)scr;
    { const int cq = lane & 15, rq = lane >> 4, col = ((cq >> 3) ? c0b : c0a) + 4 * (cq & 7);
      f32x4 v[16];
#pragma unroll
      for (int i = 0; i < 16; ++i) v[i] = __builtin_nontemporal_load((const f32x4*)(src + (size_t)(k0 + 8 * (i >> 1) + 2 * rq + (i & 1)) * ld + col));
      const f32x4 am = __builtin_bit_cast(f32x4, *(const u32x4*)(amax + col)); f32x4 inv;
#pragma unroll
      for (int c = 0; c < 4; ++c) inv[c] = am[c] > 0.f ? 127.f / am[c] : 0.f;
#pragma unroll
      for (int ii = 0; ii < 8; ++ii) *(LAS u32x2*)(T + (4 * ii + rq) * CT_STR + 8 * cq) =
          (u32x2){pack_i8x4s(v[2 * ii][0], inv[0], v[2 * ii + 1][0], inv[0], v[2 * ii][1], inv[1], v[2 * ii + 1][1], inv[1]), pack_i8x4s(v[2 * ii][2], inv[2], v[2 * ii + 1][2], inv[2], v[2 * ii][3], inv[3], v[2 * ii + 1][3], inv[3])}; }
    LDS_WAIT();
    const int h = lane >> 5;
#pragma unroll
    for (int kk = 0; kk < 2; ++kk)
#pragma unroll
        for (int cc = 0; cc < 2; ++cc) { const bf16x8 f = frag_tr(T, CT_STR, 16 * kk, 32 * cc, lane); const int n = cvt_row_of_col(32 * cc + (lane & 31), kperm);
            __builtin_nontemporal_store(__builtin_bit_cast(u32x4, f), (u32x4*)(dst + (size_t)n * Kb + k0 + 32 * kk + 16 * h)); }
    if (sw) { const int colsrc = ((lane & 32) ? c0b : c0a) + (kperm ? pg8::perm32(lane & 31) : (lane & 31)); sw[lane] = __uint_as_float(amax[colsrc]) * (1.f / 127.f); }
    LDS_WAIT();
}
constexpr int AM_IN_ITEMS = DEPTH * 48 * 4;
__device__ __forceinline__ void amax_block(const float* src, int ld, unsigned* dst, int lane) {
    const int rq = lane >> 4, cq = lane & 15;
    f32x4 m = {0.f, 0.f, 0.f, 0.f};
    for (int i = 0; i < 64; i += 16) {
        f32x4 v[16];
#pragma unroll
        for (int q = 0; q < 16; ++q) v[q] = *(const f32x4*)(src + (size_t)(4 * (i + q) + rq) * ld + 4 * cq);
#pragma unroll
        for (int q = 0; q < 16; ++q) { m[0] = fmaxf(m[0], fabsf(v[q][0])); m[1] = fmaxf(m[1], fabsf(v[q][1])); m[2] = fmaxf(m[2], fabsf(v[q][2])); m[3] = fmaxf(m[3], fabsf(v[q][3])); }
    }
#pragma unroll
    for (int cidx = 0; cidx < 4; ++cidx) { m[cidx] = fmaxf(m[cidx], shx(m[cidx], 16, lane)); m[cidx] = fmaxf(m[cidx], shx(m[cidx], 32, lane)); }
    if (rq == 0) {
#pragma unroll
        for (int cidx = 0; cidx < 4; ++cidx) (void)__hip_atomic_fetch_max(dst + 4 * cq + cidx, __float_as_uint(m[cidx]), __ATOMIC_RELAXED, __HIP_MEMORY_SCOPE_AGENT); }
}
__device__ __forceinline__ void amax_in_item(const float* win, unsigned* amaxp, int it, int lane) {
    const int kq = it & 3; int r = it >> 2; const int cb = r % 48, l = r / 48;
    amax_block(win + (size_t)l * D * PIN + (size_t)(256 * kq) * PIN + cb * 64, PIN, amaxp + (size_t)l * NPROJ + cb * 64, lane);
}
constexpr int CV_WIN = 48 * 16, CV_WOUT = 16 * 16, CV_WGU = NE * 44 * 16, CV_WD = NE * 16 * 22, CV_LAYER = CV_WIN + CV_WOUT + CV_WGU + CV_WD;

__device__ __forceinline__ void cvt_layer_item(const Frame& F, int l, int r, LAS float* scr) {
    const int lane = F.lane;
    if (r < CV_WIN) { const int GI = r % 48, kb = r / 48, gI = 2 * GI, pn = gI >> 3, gg = gI & 7; int c0a, c0b, kp;
        if (pn < 4) { c0a = 256 * pn + 64 * (gg & 3) + 32 * (gg >> 2); c0b = 256 * pn + 64 * ((gg + 1) & 3) + 32 * ((gg + 1) >> 2); kp = 0; } else { c0a = 32 * gI; c0b = c0a + 32; kp = 1; }
        cvt_item64_i8(INP(I_WIN) + (size_t)l * D * PIN, PIN, c0a, c0b, kp, 64 * kb, F_WINQ + ((size_t)l * NPROJ + 32 * gI) * D, D, F_AMAXIN + (size_t)l * NPROJ,
                      kb == 0 ? F_SWIN + (size_t)l * NPROJ + 32 * gI : (float*)nullptr, scr, lane); return; }
    r -= CV_WIN;
    if (r < CV_WOUT) { const int GI = r % 16, kb = r / 16;
        cvt_item64(INP(I_WOUT) + (size_t)l * D * D, D, 64 * GI, 64 * GI + 32, 1, 64 * kb, F_WOUT + ((size_t)l * D + 64 * GI) * D, D, scr, lane); return; }
    r -= CV_WOUT;
    r -= CV_WGU;
    { const int e = r / 352, r2 = r % 352, GI = r2 % 16, kb = r2 / 16;
        cvt_item64(INP(I_WDN) + (size_t)(l * NE + e) * DE * D, D, 64 * GI, 64 * GI + 32, 1, 64 * kb, F_WD + ((size_t)(l * NE + e) * D + 64 * GI) * DE, DE, scr, lane); }
}
__device__ __forceinline__ void cvt_wgu_block(const Frame& F, int l, int it) {
    const int lane = F.lane, wave = F.wave, cq = lane & 15, rq = lane >> 4;
    const int e = it / 44, GI = it % 44, gI = 2 * GI, j = gI >> 3, gg = gI & 7;
    const float* src = (gg < 4 ? INP(I_WG) : INP(I_WU)) + (size_t)(l * NE + e) * D * DE + 128 * j + 32 * (gg & 3) + (size_t)(128 * wave + 2 * rq) * DE + 4 * cq;
    signed char* dst = F_WGUQ + ((size_t)(l * NE + e) * 2816 + 32 * gI) * D + 128 * wave;
    LAS unsigned char* T = F.lds + wave * 17408;
    LAS float* am = (LAS float*)(F.lds + 8 * 17408);
    f32x4 v0[16], v1[16];
#pragma unroll
    for (int i = 0; i < 16; ++i) v0[i] = __builtin_nontemporal_load((const f32x4*)(src + (size_t)(8 * (i >> 1) + (i & 1)) * DE));
#pragma unroll
    for (int i = 0; i < 16; ++i) v1[i] = __builtin_nontemporal_load((const f32x4*)(src + (size_t)(64 + 8 * (i >> 1) + (i & 1)) * DE));
    f32x4 m = {0.f, 0.f, 0.f, 0.f};
#pragma unroll
    for (int i = 0; i < 16; ++i)
#pragma unroll
        for (int c = 0; c < 4; ++c) m[c] = fmaxf(m[c], fmaxf(fabsf(v0[i][c]), fabsf(v1[i][c])));
#pragma unroll
    for (int c = 0; c < 4; ++c) { m[c] = fmaxf(m[c], shx(m[c], 16, lane)); m[c] = fmaxf(m[c], shx(m[c], 32, lane)); }
    if (rq == 0) *(LAS f32x4*)(am + wave * 64 + 4 * cq) = m;
    __syncthreads();
    f32x4 a = *(LAS const f32x4*)(am + 4 * cq);
#pragma unroll
    for (int w = 1; w < 8; ++w) { const f32x4 b = *(LAS const f32x4*)(am + w * 64 + 4 * cq);
#pragma unroll
        for (int c = 0; c < 4; ++c) a[c] = fmaxf(a[c], b[c]); }
    f32x4 inv;
#pragma unroll
    for (int c = 0; c < 4; ++c) inv[c] = a[c] > 0.f ? 127.f / a[c] : 0.f;
    if (wave == 0) { const int lc = (lane & 32) + pg8::perm32(lane & 31); float an = am[lc];
#pragma unroll
        for (int w = 1; w < 8; ++w) an = fmaxf(an, am[w * 64 + lc]);
        F_SW[(size_t)(l * NE + e) * 2816 + 32 * gI + lane] = an * (1.f / 127.f); }
    const int h = lane >> 5;
#pragma unroll
    for (int tl = 0; tl < 2; ++tl) {
#pragma unroll
        for (int ii = 0; ii < 8; ++ii) { const f32x4 ve = tl ? v1[2 * ii] : v0[2 * ii], vo = tl ? v1[2 * ii + 1] : v0[2 * ii + 1];
            *(LAS u32x2*)(T + (4 * ii + rq) * CT_STR + 8 * cq) = (u32x2){pack_i8x4s(ve[0], inv[0], vo[0], inv[0], ve[1], inv[1], vo[1], inv[1]), pack_i8x4s(ve[2], inv[2], vo[2], inv[2], ve[3], inv[3], vo[3], inv[3])}; }
        LDS_WAIT();
#pragma unroll
        for (int kk = 0; kk < 2; ++kk)
#pragma unroll
            for (int cc = 0; cc < 2; ++cc) { const bf16x8 f = frag_tr(T, CT_STR, 16 * kk, 32 * cc, lane); const int n = cvt_row_of_col(32 * cc + (lane & 31), 1);
                __builtin_nontemporal_store(__builtin_bit_cast(u32x4, f), (u32x4*)(dst + (size_t)n * D + 64 * tl + 32 * kk + 16 * h)); }
        LDS_WAIT();
    }
}
constexpr int CV_SMALL = CV_WIN + CV_WOUT;
constexpr int CVB_WGU = NE * 44, CVB = CVB_WGU + CV_WD / 8;
__device__ __forceinline__ void cvt_small(const Frame& F, int l) {
    LAS float* scr = (LAS float*)(F.lds + F.wave * 17408);
    for (int it = F.blk * NWAVES + F.wave; it < CV_SMALL; it += F.G * NWAVES) cvt_layer_item(F, l, it, scr);
}
__device__ __forceinline__ void p0_prologue(const Frame& F) {
    const int gw = F.blk * NWAVES + F.wave, NGW = F.G * NWAVES, lane = F.lane, wave = F.wave;
    {
        LAS float* S = (LAS float*)F.lds;
        LAS float* red = (LAS float*)(F.lds + 69632);
        { const float* const cp = INP(I_C); const float* const ccp = INP(I_CCTX);
          for (int i = F.tid; i < 17 * 1024; i += NTHREADS) { const int r = i >> 10, k = i & 1023; const float c = (r < 16) ? cp[r * D + k] : ccp[k]; S[i] = silu_f(c); } }
        __syncthreads();
        const float* const wmod = INP(I_WMOD); const float* const bmod = INP(I_BMOD); float* const modp = F_MOD;
        for (int it = F.blk; it < DEPTH * 96; it += F.G) {
            const int l = it / 96, cb = it % 96, col = cb * 64 + lane;
            const float* wm = wmod + (size_t)l * D * 6144 + (size_t)(128 * wave) * 6144 + col;
            float acc[17];
#pragma unroll
            for (int r = 0; r < 17; ++r) acc[r] = 0.f;
            for (int k = 0; k < 128; k += 8) {
                float w[8];
#pragma unroll
                for (int q = 0; q < 8; ++q) w[q] = wm[(size_t)(k + q) * 6144];
#pragma unroll
                for (int r = 0; r < 17; ++r) { const f32x4 s0 = *(LAS const f32x4*)(S + r * 1024 + 128 * wave + k), s1 = *(LAS const f32x4*)(S + r * 1024 + 128 * wave + k + 4);
                    acc[r] += s0[0] * w[0] + s0[1] * w[1] + s0[2] * w[2] + s0[3] * w[3] + s1[0] * w[4] + s1[1] * w[5] + s1[2] * w[6] + s1[3] * w[7]; }
            }
#pragma unroll
            for (int r = 0; r < 17; ++r) red[(wave * 17 + r) * 64 + lane] = acc[r];
            __syncthreads();
            for (int o = F.tid; o < 17 * 64; o += NTHREADS) { const int r = o >> 6, cc = o & 63; float a = 0.f;
#pragma unroll
                for (int w = 0; w < 8; ++w) a += red[(w * 17 + r) * 64 + cc];
                modp[((size_t)l * 17 + r) * 6144 + cb * 64 + cc] = a + bmod[l * 6144 + cb * 64 + cc]; }
            __syncthreads();
        }
    }
    { const float* const win = INP(I_WIN); unsigned* const amaxin = F_AMAXIN;
      for (int it = gw; it < AM_IN_ITEMS; it += NGW) amax_in_item(win, amaxin, it, lane); }
    float* const ropec = F_ROPEC; float* const ropes = F_ROPES;
    for (int gt = F.blk * NTHREADS + F.tid; gt < 64 * 16; gt += F.G * NTHREADS) {
        const int pos = gt >> 4, f = gt & 15;
        const float inv = powf(10000.0f, -(float)f / 16.0f); const float ang = (float)pos * inv;
        ropec[gt] = cosf(ang); ropes[gt] = sinf(ang);
    }
    if (F.blk == F.G - 1) { float* const qkw = F_QKW; const float* const qn = INP(I_QNW); const float* const kn = INP(I_KNW);
        for (int i = F.tid; i < DEPTH * 128; i += NTHREADS) { const int l = i >> 7, j = i & 127; qkw[i] = (j < 64) ? qn[l * 64 + j] : kn[l * 64 + j - 64]; } }
    { float* const wt = F_WT; const float* const win = INP(I_WIN); const float* const wr = INP(I_WR);
      for (int i = F.blk * NTHREADS + F.tid; i < DEPTH * 2 * 16 * 1024; i += F.G * NTHREADS) { const int l = i >> 15, w = (i >> 14) & 1, c = (i >> 10) & 15, k = i & 1023;
          wt[i] = w ? wr[((size_t)l * D + k) * NE + c] : win[((size_t)l * D + k) * PIN + NPROJ + c]; } }
}

__device__ __forceinline__ void load_thin_T(const Frame& F, const float* src, LAS float* T) {
    f32x4 t[8];
#pragma unroll
    for (int i = 0; i < 8; ++i) t[i] = *(const f32x4*)(src + 4 * (F.tid + 512 * i));
#pragma unroll
    for (int i = 0; i < 8; ++i) *(LAS f32x4*)(T + 4 * (F.tid + 512 * i)) = t[i];
    __syncthreads();
}
__device__ __forceinline__ float softplus_f(float x) { const float e = __expf(-fabsf(x)), u = 1.f + e; const float l = (u == 1.f) ? e : __logf(u) * (e * __builtin_amdgcn_rcpf(u - 1.f)); return fmaxf(x, 0.f) + l; }


constexpr int TH_STR = 2064;
constexpr int TH_THI = 0, TH_TLO = 16 * TH_STR, TH_HHI = 32 * TH_STR, TH_HLO = 48 * TH_STR, TH_PART = 64 * TH_STR;
static_assert(TH_PART + 8192 <= MISC_OFF, "thin lds");
__device__ __forceinline__ void load_thin_T_bf(const Frame& F, const float* src, LAS unsigned char* L) {
    f32x4 t[8];
#pragma unroll
    for (int i = 0; i < 8; ++i) t[i] = *(const f32x4*)(src + 4 * (F.tid + 512 * i));
#pragma unroll
    for (int i = 0; i < 8; ++i) { const int e = 4 * (F.tid + 512 * i), c = e >> 10, k = e & 1023;
        const u32x2 hi = {pk2(t[i][0], t[i][1]), pk2(t[i][2], t[i][3])};
        const u32x2 lo = {pk2(t[i][0] - bflo(hi.x), t[i][1] - bfhi(hi.x)), pk2(t[i][2] - bflo(hi.y), t[i][3] - bfhi(hi.y))};
        *(LAS u32x2*)(L + TH_THI + c * TH_STR + k * 2) = hi; *(LAS u32x2*)(L + TH_TLO + c * TH_STR + k * 2) = lo; }
    __syncthreads();
}
__device__ __forceinline__ void thin_stage_row(LAS unsigned char* L, int srow, const f32x4 (&h)[4], int lane) {
#pragma unroll
    for (int j = 0; j < 4; ++j) { const int k = 4 * (lane + 64 * j);
        const u32x2 hi = {pk2(h[j][0], h[j][1]), pk2(h[j][2], h[j][3])};
        const u32x2 lo = {pk2(h[j][0] - bflo(hi.x), h[j][1] - bfhi(hi.x)), pk2(h[j][2] - bflo(hi.y), h[j][3] - bfhi(hi.y))};
        *(LAS u32x2*)(L + TH_HHI + srow * TH_STR + k * 2) = hi; *(LAS u32x2*)(L + TH_HLO + srow * TH_STR + k * 2) = lo; }
}
__device__ __forceinline__ void thin_mfma_partial(LAS unsigned char* L, int wave, int lane) {
    const int fr = lane & 15, fq = lane >> 4;
    f32x4 acc = {0.f, 0.f, 0.f, 0.f};
#pragma unroll
    for (int s = 0; s < 4; ++s) { const int off = fr * TH_STR + (32 * (4 * wave + s) + 8 * fq) * 2;
        const bf16x8 ahi = *(LAS const bf16x8*)(L + TH_HHI + off), alo = *(LAS const bf16x8*)(L + TH_HLO + off);
        const bf16x8 bhi = *(LAS const bf16x8*)(L + TH_THI + off), blo = *(LAS const bf16x8*)(L + TH_TLO + off);
        acc = __builtin_amdgcn_mfma_f32_16x16x32_bf16(ahi, bhi, acc, 0, 0, 0);
        acc = __builtin_amdgcn_mfma_f32_16x16x32_bf16(ahi, blo, acc, 0, 0, 0);
        acc = __builtin_amdgcn_mfma_f32_16x16x32_bf16(alo, bhi, acc, 0, 0, 0); }
    LAS float* P = (LAS float*)(L + TH_PART) + wave * 256;
#pragma unroll
    for (int t2 = 0; t2 < 4; ++t2) P[(4 * fq + t2) * 16 + fr] = acc[t2];
}
__device__ __forceinline__ float thin_total(LAS unsigned char* L, int tid) {
    LAS const float* P = (LAS const float*)(L + TH_PART) + tid; float s = 0.f;
#pragma unroll
    for (int w = 0; w < 8; ++w) s += P[w * 256];
    return s;
}
__device__ __forceinline__ void p1_gather_issue(u32x2 (&wa)[4][4], u32x2 (&wb)[4][4], unsigned& maska, unsigned& maskb, int inva, int invb, const bf16_t* Yp, const bf16_t* zrow, int lane) {
    maska = (unsigned)__ballot(inva >= 0) & 0xffffu; maskb = (unsigned)__ballot(invb >= 0) & 0xffffu;
    const bf16_t* ypa[4]; const bf16_t* ypb[4];
#pragma unroll
    for (int q = 0; q < 4; ++q) {
        if (maska) { const int e = __builtin_ctz(maska); maska &= maska - 1; ypa[q] = Yp + (size_t)shl_from_i(inva, e) * D; } else ypa[q] = zrow;
        if (maskb) { const int e = __builtin_ctz(maskb); maskb &= maskb - 1; ypb[q] = Yp + (size_t)shl_from_i(invb, e) * D; } else ypb[q] = zrow; }
#pragma unroll
    for (int q = 0; q < 4; ++q)
#pragma unroll
        for (int j = 0; j < 4; ++j) { wa[q][j] = *(const u32x2*)(ypa[q] + 4 * (lane + 64 * j)); wb[q][j] = *(const u32x2*)(ypb[q] + 4 * (lane + 64 * j)); }
}
__device__ __forceinline__ void p1_gather_consume(f32x4 (&va)[4], f32x4 (&vb)[4], u32x2 (&wa)[4][4], u32x2 (&wb)[4][4], unsigned maska, unsigned maskb, int inva, int invb,
                                                  const bf16_t* Yp, const bf16_t* zrow, const f32x4 (&g2)[4], int lane) {
    f32x4 aa[4], ab[4];
#pragma unroll
    for (int j = 0; j < 4; ++j) { aa[j] = (f32x4){0.f, 0.f, 0.f, 0.f}; ab[j] = (f32x4){0.f, 0.f, 0.f, 0.f}; }
    for (;;) {
#pragma unroll
        for (int q = 0; q < 4; ++q)
#pragma unroll
            for (int j = 0; j < 4; ++j) { aa[j] += (f32x4){bflo(wa[q][j].x), bfhi(wa[q][j].x), bflo(wa[q][j].y), bfhi(wa[q][j].y)};
                ab[j] += (f32x4){bflo(wb[q][j].x), bfhi(wb[q][j].x), bflo(wb[q][j].y), bfhi(wb[q][j].y)}; }
        if (!(maska | maskb)) break;
        const bf16_t* ypa[4]; const bf16_t* ypb[4];
#pragma unroll
        for (int q = 0; q < 4; ++q) {
            if (maska) { const int e = __builtin_ctz(maska); maska &= maska - 1; ypa[q] = Yp + (size_t)shl_from_i(inva, e) * D; } else ypa[q] = zrow;
            if (maskb) { const int e = __builtin_ctz(maskb); maskb &= maskb - 1; ypb[q] = Yp + (size_t)shl_from_i(invb, e) * D; } else ypb[q] = zrow; }
#pragma unroll
        for (int q = 0; q < 4; ++q)
#pragma unroll
            for (int j = 0; j < 4; ++j) { wa[q][j] = *(const u32x2*)(ypa[q] + 4 * (lane + 64 * j)); wb[q][j] = *(const u32x2*)(ypb[q] + 4 * (lane + 64 * j)); }
    }
#pragma unroll
    for (int j = 0; j < 4; ++j) { va[j] += aa[j] * g2[j]; vb[j] += ab[j] * g2[j]; }
}
__device__ __forceinline__ void thin16x2(float (&d0)[16], float (&d1)[16], const f32x4 (&h0)[4], const f32x4 (&h1)[4], LAS const float* T, int lane) {
#pragma unroll
    for (int cg = 0; cg < 8; ++cg) {
#pragma unroll
        for (int cc = 0; cc < 2; ++cc) { const int c = 2 * cg + cc; float a0 = 0.f, a1 = 0.f;
#pragma unroll
            for (int j = 0; j < 4; ++j) { const f32x4 t = *(LAS const f32x4*)(T + c * 1024 + 4 * (lane + 64 * j));
                a0 += h0[j][0] * t[0] + h0[j][1] * t[1] + h0[j][2] * t[2] + h0[j][3] * t[3];
                a1 += h1[j][0] * t[0] + h1[j][1] * t[1] + h1[j][2] * t[2] + h1[j][3] * t[3]; }
            d0[c] = a0; d1[c] = a1; }
        asm volatile("" ::: "memory");
    }
}
__device__ __forceinline__ void p1_norm1(const Frame& F, int layer, int probe_rerun) {
    const bool fin = (layer == DEPTH);
    if (layer == 0 && !probe_rerun) { cvt_small(F, layer); __syncthreads(); }
    if (!fin) load_thin_T_bf(F, F_WT + (size_t)(layer * 2 + 0) * 16384, F.lds);
    const int gw = F.blk * NWAVES + F.wave, NGW = F.G * NWAVES, lane = F.lane;
    const int nrows = fin ? NL : NT;
    const int RW = 2 * ((nrows + 2 * NGW - 1) / (2 * NGW)), rbeg = gw * RW;
    const float* modl = F_MOD + (size_t)(fin ? 0 : layer) * 17 * 6144;
    const float* modp = F_MOD + (size_t)(layer > 0 ? layer - 1 : 0) * 17 * 6144;
    const float* n1w = INP(I_N1W) + (size_t)(fin ? 0 : layer) * D;
    float* const outp = OUTP(); bf16_t* const xb = F_XB; const bool srcf32 = (layer == 0 && !probe_rerun);
    const float* const srcl = INP(I_X); const float* const srcc = INP(I_CTX);
    const int* const invp = F_INV; const bf16_t* const Yp = F_Y; signed char* const HQp = F_HAQ; float* const SAp = F_SAH; float* const DTp = F_DT;
    const bf16_t* const zrow = (const bf16_t*)(F_CTL + CW_ZERO);
    const float* const dtbf = INP(I_DTBF) + (fin ? 0 : layer) * 8; const float* const dtbb = INP(I_DTBB) + (fin ? 0 : layer) * 8;
    const bool comb = (layer > 0 && !probe_rerun);
    f32x4 nva[4], nvb[4]; int nia = -1, nib = -1;
    f32x4 W1[4], S0[4], G2[4]; int cur_m = -1;
#pragma unroll
    for (int j = 0; j < 4; ++j) { W1[j] = (f32x4){0.f, 0.f, 0.f, 0.f}; S0[j] = W1[j]; G2[j] = W1[j]; }
#define P1_SRC(r) (((r) < NL) ? srcl + (size_t)(r) * D : srcc + (size_t)((r) - NL) * D)
#define P1_PRELOAD(r) do { const int ra_ = ((r) < nrows) ? (r) : 0, rb_ = ra_ + 1; \
        if (srcf32) { const float* sa_ = P1_SRC(ra_); const float* sb_ = P1_SRC(rb_); \
            _Pragma("unroll") for (int j = 0; j < 4; ++j) { nva[j] = *(const f32x4*)(sa_ + 4 * (lane + 64 * j)); nvb[j] = *(const f32x4*)(sb_ + 4 * (lane + 64 * j)); } } \
        else { const bf16_t* sa_ = xb + (size_t)ra_ * D; const bf16_t* sb_ = xb + (size_t)rb_ * D; \
            _Pragma("unroll") for (int j = 0; j < 4; ++j) { const u32x2 ta_ = *(const u32x2*)(sa_ + 4 * (lane + 64 * j)), tb_ = *(const u32x2*)(sb_ + 4 * (lane + 64 * j)); \
                nva[j][0] = __uint_as_float(ta_.x); nva[j][1] = __uint_as_float(ta_.y); nvb[j][0] = __uint_as_float(tb_.x); nvb[j][1] = __uint_as_float(tb_.y); } } \
        nia = (comb && lane < 16) ? invp[(size_t)ra_ * 16 + lane] : -1; nib = (comb && lane < 16) ? invp[(size_t)rb_ * 16 + lane] : -1; } while (0)
    P1_PRELOAD(rbeg);
    for (int pi = 0; pi < RW / 2; ++pi) {
        const int row0 = rbeg + 2 * pi; const bool vR = row0 < nrows; const int rowA = vR ? row0 : 0, rowB = rowA + 1;
        const int mR = (rowA < NL) ? (rowA >> 11) : 16;
        f32x4 va[4], vb[4]; const int ia = nia, ib = nib;
#pragma unroll
        for (int j = 0; j < 4; ++j) { va[j] = nva[j]; vb[j] = nvb[j]; }
        if (!srcf32) {
#pragma unroll
            for (int j = 0; j < 4; ++j) { const unsigned ax = __float_as_uint(nva[j][0]), ay = __float_as_uint(nva[j][1]), bx = __float_as_uint(nvb[j][0]), by = __float_as_uint(nvb[j][1]);
                va[j] = (f32x4){bflo(ax), bfhi(ax), bflo(ay), bfhi(ay)}; vb[j] = (f32x4){bflo(bx), bfhi(bx), bflo(by), bfhi(by)}; } }
        if (pi + 1 < RW / 2) P1_PRELOAD(row0 + 2);
        if (mR != cur_m) { cur_m = mR;
            const float* sh = modl + mR * 6144; const float* sc = sh + 1024; const float* g2 = modp + mR * 6144 + 5 * 1024;
#pragma unroll
            for (int j = 0; j < 4; ++j) { const int k = 4 * (lane + 64 * j);
                if (!fin) { W1[j] = *(const f32x4*)(n1w + k) * (*(const f32x4*)(sc + k) + 1.f); S0[j] = *(const f32x4*)(sh + k); }
                if (layer > 0) G2[j] = *(const f32x4*)(g2 + k); } }
        if (layer > 0) {
            { u32x2 gwa[4][4], gwb[4][4]; unsigned gma, gmb; p1_gather_issue(gwa, gwb, gma, gmb, ia, ib, Yp, zrow, lane); p1_gather_consume(va, vb, gwa, gwb, gma, gmb, ia, ib, Yp, zrow, G2, lane); }
            asm volatile("" ::: "memory");
            if (vR) {
            if (fin) { float* da_ = outp + (size_t)rowA * D; float* db_ = outp + (size_t)rowB * D;
#pragma unroll
                for (int j = 0; j < 4; ++j) { *(f32x4*)(da_ + 4 * (lane + 64 * j)) = va[j]; *(f32x4*)(db_ + 4 * (lane + 64 * j)) = vb[j]; } }
            else { bf16_t* da_ = xb + (size_t)rowA * D; bf16_t* db_ = xb + (size_t)rowB * D;
#pragma unroll
                for (int j = 0; j < 4; ++j) { *(u32x2*)(da_ + 4 * (lane + 64 * j)) = (u32x2){pk2(va[j][0], va[j][1]), pk2(va[j][2], va[j][3])};
                    *(u32x2*)(db_ + 4 * (lane + 64 * j)) = (u32x2){pk2(vb[j][0], vb[j][1]), pk2(vb[j][2], vb[j][3])}; } }
            }
        }
        if (fin) continue;
        float sa = 0.f, sb = 0.f;
#pragma unroll
        for (int j = 0; j < 4; ++j) { sa += va[j][0] * va[j][0] + va[j][1] * va[j][1] + va[j][2] * va[j][2] + va[j][3] * va[j][3];
            sb += vb[j][0] * vb[j][0] + vb[j][1] * vb[j][1] + vb[j][2] * vb[j][2] + vb[j][3] * vb[j][3]; }
        sa = wave_sum_dpp(sa); sb = wave_sum_dpp(sb);
        float ma = 0.f, mb = 0.f;
        { const float rsa = rsqrtf(sa * (1.f / D) + EPS), rsb = rsqrtf(sb * (1.f / D) + EPS);
#pragma unroll
          for (int j = 0; j < 4; ++j) {
              const f32x4 ha = va[j] * rsa * W1[j] + S0[j], hb = vb[j] * rsb * W1[j] + S0[j];
              ma = fmaxf(fmaxf(ma, fmaxf(fabsf(ha[0]), fabsf(ha[1]))), fmaxf(fabsf(ha[2]), fabsf(ha[3])));
              mb = fmaxf(fmaxf(mb, fmaxf(fabsf(hb[0]), fabsf(hb[1]))), fmaxf(fabsf(hb[2]), fabsf(hb[3])));
              va[j] = ha; vb[j] = hb; } }
        ma = wave_max_dpp(ma); mb = wave_max_dpp(mb);
        if (vR) { const float ia = ma > 0.f ? 127.f / ma : 0.f, ib = mb > 0.f ? 127.f / mb : 0.f;
#pragma unroll
          for (int j = 0; j < 4; ++j) { const int k = 4 * (lane + 64 * j);
              const unsigned qa = pack_i8x4(va[j][0], va[j][1], va[j][2], va[j][3], ia), qb = pack_i8x4(vb[j][0], vb[j][1], vb[j][2], vb[j][3], ib);
              *(unsigned*)(HQp + (size_t)rowA * D + k) = qa; *(unsigned*)(HQp + (size_t)rowB * D + k) = qb; }
          if (lane == 0) { SAp[rowA] = ma * (1.f / 127.f); SAp[rowB] = mb * (1.f / 127.f); } }
        asm volatile("" ::: "memory");
        thin_stage_row(F.lds, 2 * F.wave, va, lane); thin_stage_row(F.lds, 2 * F.wave + 1, vb, lane);
        lds_barrier();
        thin_mfma_partial(F.lds, F.wave, lane);
        lds_barrier();
        if (F.wave < 4) { const int t16 = F.wave * 64 + lane, srow = t16 >> 4, c = t16 & 15; const float tot = thin_total(F.lds, t16);
            const float bias = (c < 8) ? dtbf[c] : dtbb[c - 8]; const int grow = (F.blk * NWAVES + (srow >> 1)) * RW + 2 * pi + (srow & 1);
            if (grow < nrows) DTp[(size_t)grow * 16 + c] = softplus_f(tot + bias); }
    }
#undef P1_PRELOAD
#undef P1_SRC
}

__device__ __forceinline__ void p7_finish_row(float tot, int lane, int row, float* AFFp) {
    float lg[16]; float mx = -INFINITY;
#pragma unroll
    for (int c = 0; c < 16; ++c) { lg[c] = shl_from(tot, laneof16(c)); mx = fmaxf(mx, lg[c]); }
    float se = 0.f;
#pragma unroll
    for (int c = 0; c < 16; ++c) { lg[c] = __expf(lg[c] - mx); se += lg[c]; }
    float mine = 0.f;
#pragma unroll
    for (int c = 0; c < 16; ++c) mine = (lane == c) ? lg[c] : mine;
    if (lane < 16) {
        const float a = mine / se;
        if (row < NL) AFFp[((size_t)((row >> 11) * 16 + lane)) * 2048 + (row & 2047)] = a;
        else { const int r = row - NL; AFFp[(size_t)NL * 16 + ((size_t)((r >> 8) * 16 + lane)) * 256 + (r & 255)] = a; }
    }
}
__device__ __forceinline__ void p7_norm2(const Frame& F, int layer) {
    load_thin_T_bf(F, F_WT + (size_t)(layer * 2 + 1) * 16384, F.lds);
    const int gw = F.blk * NWAVES + F.wave, NGW = F.G * NWAVES, lane = F.lane;
    const int nrows = (layer < DEPTH - 1) ? NT : NL;
    const int RW = 2 * ((nrows + 2 * NGW - 1) / (2 * NGW)), rbeg = gw * RW;
    const float* modl = F_MOD + (size_t)layer * 17 * 6144;
    const float* n2w = INP(I_N2W) + (size_t)layer * D;
    const bf16_t* const xb = F_XB; signed char* const HQp = F_HQ; float* const SAp = F_SA; float* const AFFp = F_AFF;
    u32x2 nva[4], nvb[4];
    f32x4 W1[4], S0[4]; int cur_m = -1;
#pragma unroll
    for (int j = 0; j < 4; ++j) { W1[j] = (f32x4){0.f, 0.f, 0.f, 0.f}; S0[j] = W1[j]; }
#define P7_PRELOAD(r) do { const int ra_ = ((r) < nrows) ? (r) : 0; const bf16_t* sa_ = xb + (size_t)ra_ * D; const bf16_t* sb_ = sa_ + D; \
        _Pragma("unroll") for (int j = 0; j < 4; ++j) { nva[j] = *(const u32x2*)(sa_ + 4 * (lane + 64 * j)); nvb[j] = *(const u32x2*)(sb_ + 4 * (lane + 64 * j)); } } while (0)
    P7_PRELOAD(rbeg);
    for (int pi = 0; pi < RW / 2; ++pi) {
        const int row0 = rbeg + 2 * pi; const bool vR = row0 < nrows; const int rowA = vR ? row0 : 0, rowB = rowA + 1;
        const int mR = (rowA < NL) ? (rowA >> 11) : 16;
        f32x4 va[4], vb[4]; float sa = 0.f, sb = 0.f;
#pragma unroll
        for (int j = 0; j < 4; ++j) { va[j] = (f32x4){bflo(nva[j].x), bfhi(nva[j].x), bflo(nva[j].y), bfhi(nva[j].y)}; vb[j] = (f32x4){bflo(nvb[j].x), bfhi(nvb[j].x), bflo(nvb[j].y), bfhi(nvb[j].y)};
            sa += va[j][0] * va[j][0] + va[j][1] * va[j][1] + va[j][2] * va[j][2] + va[j][3] * va[j][3];
            sb += vb[j][0] * vb[j][0] + vb[j][1] * vb[j][1] + vb[j][2] * vb[j][2] + vb[j][3] * vb[j][3]; }
        if (pi + 1 < RW / 2) P7_PRELOAD(row0 + 2);
        if (mR != cur_m) { cur_m = mR; const float* sh = modl + mR * 6144 + 3 * 1024; const float* sc = sh + 1024;
#pragma unroll
            for (int j = 0; j < 4; ++j) { const int k = 4 * (lane + 64 * j); W1[j] = *(const f32x4*)(n2w + k) * (*(const f32x4*)(sc + k) + 1.f); S0[j] = *(const f32x4*)(sh + k); } }
        sa = wave_sum_dpp(sa); sb = wave_sum_dpp(sb);
        float ma = 0.f, mb = 0.f;
        { const float rsa = rsqrtf(sa * (1.f / D) + EPS), rsb = rsqrtf(sb * (1.f / D) + EPS);
#pragma unroll
          for (int j = 0; j < 4; ++j) {
              const f32x4 ha = va[j] * rsa * W1[j] + S0[j], hb = vb[j] * rsb * W1[j] + S0[j];
              ma = fmaxf(fmaxf(ma, fmaxf(fabsf(ha[0]), fabsf(ha[1]))), fmaxf(fabsf(ha[2]), fabsf(ha[3])));
              mb = fmaxf(fmaxf(mb, fmaxf(fabsf(hb[0]), fabsf(hb[1]))), fmaxf(fabsf(hb[2]), fabsf(hb[3])));
              va[j] = ha; vb[j] = hb; } }
        ma = wave_max_dpp(ma); mb = wave_max_dpp(mb);
        if (vR) { const float ia = ma > 0.f ? 127.f / ma : 0.f, ib = mb > 0.f ? 127.f / mb : 0.f;
#pragma unroll
          for (int j = 0; j < 4; ++j) { const int k = 4 * (lane + 64 * j);
              const unsigned qa = pack_i8x4(va[j][0], va[j][1], va[j][2], va[j][3], ia), qb = pack_i8x4(vb[j][0], vb[j][1], vb[j][2], vb[j][3], ib);
              *(unsigned*)(HQp + (size_t)rowA * D + k) = qa; *(unsigned*)(HQp + (size_t)rowB * D + k) = qb; }
          if (lane == 0) { SAp[rowA] = ma * (1.f / 127.f); SAp[rowB] = mb * (1.f / 127.f); } }
        asm volatile("" ::: "memory");
        thin_stage_row(F.lds, 2 * F.wave, va, lane); thin_stage_row(F.lds, 2 * F.wave + 1, vb, lane);
        lds_barrier();
        thin_mfma_partial(F.lds, F.wave, lane);
        lds_barrier();
        if (F.wave < 4) { const int t16 = F.wave * 64 + lane, srow = t16 >> 4, c = t16 & 15; const float lg = thin_total(F.lds, t16);
            float mx = lg;
#pragma unroll
            for (int o = 1; o < 16; o <<= 1) mx = fmaxf(mx, shx(mx, o, lane));
            const float ex = __expf(lg - mx); float se = ex;
#pragma unroll
            for (int o = 1; o < 16; o <<= 1) se += shx(se, o, lane);
            const int row = (F.blk * NWAVES + (srow >> 1)) * RW + 2 * pi + (srow & 1);
            if (row < nrows) { const float a = ex / se;
                if (row < NL) AFFp[((size_t)((row >> 11) * 16 + c)) * 2048 + (row & 2047)] = a;
                else { const int r = row - NL; AFFp[(size_t)NL * 16 + ((size_t)((r >> 8) * 16 + c)) * 256 + (r & 255)] = a; } } }
    }
#undef P7_PRELOAD
}

__device__ __forceinline__ void p5_ssd_post(const Frame& F, int layer) {
    const int gw = F.blk * NWAVES + F.wave, NGW = F.G * NWAVES, lane = F.lane;
    const int nrows = (layer < DEPTH - 1) ? NT : NL;
    const int c0 = 8 * lane;
    const float dsk = INP(I_DSKIP)[layer * 8 + (c0 >> 6)];
    const f32x4 w0 = *(const f32x4*)(INP(I_SSDNW) + layer * 512 + c0), w1 = *(const f32x4*)(INP(I_SSDNW) + layer * 512 + c0 + 4);
    const bf16_t* const YFp = F_YF; const bf16_t* const YBp = F_YB; const bf16_t* const XSp = F_XBCC; const bf16_t* const Zp = F_Z; bf16_t* const A2p = F_A2;
    u32x4 nyf[2], nyb[2], nxs[2], nz[2];
#define P5_LOAD(rr_) do { _Pragma("unroll") for (int q = 0; q < 2; ++q) { const int row = (rr_) + q; \
            nyf[q] = *(const u32x4*)(YFp + (size_t)row * 512 + c0); nyb[q] = *(const u32x4*)(YBp + (size_t)row * 512 + c0); \
            nxs[q] = *(const u32x4*)(XSp + (size_t)row * 1024 + c0); nz[q] = *(const u32x4*)(Zp + (size_t)row * 512 + c0); } } while (0)
    if (2 * gw < nrows) P5_LOAD(2 * gw);
    for (int r0 = 2 * gw; r0 < nrows; r0 += 2 * NGW) {
        u32x4 yf[2], yb[2], xs[2], z[2];
#pragma unroll
        for (int q = 0; q < 2; ++q) { yf[q] = nyf[q]; yb[q] = nyb[q]; xs[q] = nxs[q]; z[q] = nz[q]; }
        if (r0 + 2 * NGW < nrows) P5_LOAD(r0 + 2 * NGW);
#pragma unroll
        for (int q = 0; q < 2; ++q) { const int row = r0 + q;
            float g[8]; float ss = 0.f;
#pragma unroll
            for (int i = 0; i < 4; ++i) {
                const float y0 = bflo(yf[q][i]) + bflo(yb[q][i]) + dsk * bflo(xs[q][i]), y1 = bfhi(yf[q][i]) + bfhi(yb[q][i]) + dsk * bfhi(xs[q][i]);
                const float z0 = bflo(z[q][i]), z1 = bfhi(z[q][i]);
                g[2 * i] = y0 * z0 * __builtin_amdgcn_rcpf(1.f + __expf(-z0)); g[2 * i + 1] = y1 * z1 * __builtin_amdgcn_rcpf(1.f + __expf(-z1)); ss += g[2 * i] * g[2 * i] + g[2 * i + 1] * g[2 * i + 1]; }
#pragma unroll
            for (int o = 1; o < 32; o <<= 1) ss += shx(ss, o, lane);
            const float rstd = rsqrtf(ss * (1.f / 256.f) + EPS);
            u32x4 o; o.x = pk2(g[0] * rstd * w0[0], g[1] * rstd * w0[1]); o.y = pk2(g[2] * rstd * w0[2], g[3] * rstd * w0[3]);
            o.z = pk2(g[4] * rstd * w1[0], g[5] * rstd * w1[1]); o.w = pk2(g[6] * rstd * w1[2], g[7] * rstd * w1[3]);
            *(u32x4*)(A2p + (size_t)row * 1024 + 512 + c0) = o; }
    }
#undef P5_LOAD
}

struct EpiInProj {
    static constexpr bool PERM = false, AFTER_DRAIN = false;
    unsigned char* U; const float* qkw; const float* ropec; const float* ropes; const float* sah; const float* swin;
    __device__ __forceinline__ void operator()(const pg8::i32x4 (&acc)[2][2][4][2], const Unit& u, int wr, int wc, int fr, int fq) const {
        const int pn = u.pn;
        f32x4 swv[2][2];
#pragma unroll
        for (int bj = 0; bj < 2; ++bj)
#pragma unroll
            for (int n = 0; n < 2; ++n) swv[bj][n] = *(const f32x4*)(swin + pn * 256 + 128 * bj + 32 * wc + 16 * n + 4 * fq);
        if (pn < 4) {
            const bool isq = pn < 2; bf16_t* base = (bf16_t*)(U + (isq ? U_Q : U_K)); const float* nw = qkw + (isq ? 0 : 64); const float osc = isq ? 0.125f * LOG2E : 1.f;
            const int hg = 4 * (pn & 1) + wc;
            f32x4 w[2][2];
#pragma unroll
            for (int bj = 0; bj < 2; ++bj)
#pragma unroll
                for (int n = 0; n < 2; ++n) w[bj][n] = *(const f32x4*)(nw + 32 * bj + 16 * n + 4 * fq);
#pragma unroll
            for (int ai = 0; ai < 2; ++ai)
#pragma unroll
                for (int m = 0; m < 4; ++m) {
                    const int row = u.pm * 256 + ai * 128 + wr * 64 + m * 16 + fr;
                    float ss = 0.f; const float sa = sah[row]; f32x4 xf[2][2];
#pragma unroll
                    for (int bj = 0; bj < 2; ++bj)
#pragma unroll
                        for (int n = 0; n < 2; ++n) { f32x4 x;
#pragma unroll
                            for (int i = 0; i < 4; ++i) x[i] = (float)acc[ai][bj][m][n][i] * (sa * swv[bj][n][i]);
                            xf[bj][n] = x; ss += x[0] * x[0] + x[1] * x[1] + x[2] * x[2] + x[3] * x[3]; }
                    { const int ln = fq * 16 + fr; ss += shx(ss, 16, ln); ss += shx(ss, 32, ln); }
                    const float rstd = rsqrtf(ss * (1.f / 64.f) + EPS);
                    const bool lat = row < NL; const int tok = row & 2047;
#pragma unroll
                    for (int bj = 0; bj < 2; ++bj) {
                        f32x4 x1 = xf[bj][0] * rstd * w[bj][0], x2 = xf[bj][1] * rstd * w[bj][1];
                        if (lat) { const int pos = bj ? (tok & 63) : (tok >> 6); const f32x4 c = *(const f32x4*)(ropec + pos * 16 + 4 * fq), s = *(const f32x4*)(ropes + pos * 16 + 4 * fq);
                            const f32x4 o1 = x1 * c - x2 * s, o2 = x1 * s + x2 * c; x1 = o1; x2 = o2; }
                        x1 = x1 * osc; x2 = x2 * osc;
                        bf16_t* p = base + (size_t)row * 512 + 64 * hg + 32 * bj + 4 * fq;
                        *(u32x2*)p = (u32x2){pk2(x1[0], x1[1]), pk2(x1[2], x1[3])};
                        *(u32x2*)(p + 16) = (u32x2){pk2(x2[0], x2[1]), pk2(x2[2], x2[3])};
                    }
                }
        } else {
            size_t boff; int cb, ldc;
            if (pn < 6) { boff = U_V; cb = 256 * (pn - 4); ldc = 512; } else if (pn < 8) { boff = U_Z; cb = 256 * (pn - 6); ldc = 512; } else { boff = U_XBC; cb = 256 * (pn - 8); ldc = 1024; }
            bf16_t* base = (bf16_t*)(U + boff);
#pragma unroll
            for (int ai = 0; ai < 2; ++ai)
#pragma unroll
                for (int m = 0; m < 4; ++m) {
                    const int row = u.pm * 256 + ai * 128 + wr * 64 + m * 16 + fr; const float sa = sah[row];
#pragma unroll
                    for (int bj = 0; bj < 2; ++bj) { f32x4 x0, x1;
#pragma unroll
                        for (int i = 0; i < 4; ++i) { x0[i] = (float)acc[ai][bj][m][0][i] * (sa * swv[bj][0][i]); x1[i] = (float)acc[ai][bj][m][1][i] * (sa * swv[bj][1][i]); }
                        *(u32x4*)(base + (size_t)row * ldc + cb + 128 * bj + 32 * wc + 8 * fq) = pack8(x0, x1); }
                }
        }
    }
};
struct EpiOutProj {
    static constexpr bool PERM = false, AFTER_DRAIN = false;
    const float* sl; const float* sc; bf16_t* xb; const float* modl; float gscale; bool first;
    __device__ __forceinline__ void operator()(const f32x4 (&acc)[2][2][4][2], const Unit& u, int wr, int wc, int fr, int fq) const {
        const int row_t = u.pm * 256; const bool lat = row_t < NL; const int mrow = lat ? (row_t >> 11) : 16;
        const float* g = modl + mrow * 6144 + 2048;
        f32x4 gv[2][2];
#pragma unroll
        for (int bj = 0; bj < 2; ++bj)
#pragma unroll
            for (int n = 0; n < 2; ++n) gv[bj][n] = *(const f32x4*)(g + u.pn * 256 + 128 * bj + 32 * wc + 8 * fq + 4 * n) * gscale;
        if (first) {
            const float* xs = lat ? sl : sc - (size_t)NL * D;
#pragma unroll
            for (int ai = 0; ai < 2; ++ai) {
                f32x4 xv[4][2][2];
#pragma unroll
                for (int m = 0; m < 4; ++m) { const size_t ro = (size_t)(row_t + ai * 128 + wr * 64 + m * 16 + fr) * D + u.pn * 256 + 32 * wc + 8 * fq;
#pragma unroll
                    for (int bj = 0; bj < 2; ++bj)
#pragma unroll
                        for (int n = 0; n < 2; ++n) xv[m][bj][n] = *(const f32x4*)(xs + ro + 128 * bj + 4 * n); }
#pragma unroll
                for (int m = 0; m < 4; ++m) { const size_t ro = (size_t)(row_t + ai * 128 + wr * 64 + m * 16 + fr) * D + u.pn * 256 + 32 * wc + 8 * fq;
#pragma unroll
                    for (int bj = 0; bj < 2; ++bj) *(u32x4*)(xb + ro + 128 * bj) = pack8(xv[m][bj][0] + gv[bj][0] * acc[ai][bj][m][0], xv[m][bj][1] + gv[bj][1] * acc[ai][bj][m][1]); }
            }
        } else {
#pragma unroll
            for (int ai = 0; ai < 2; ++ai) {
                u32x4 xr[4][2];
#pragma unroll
                for (int m = 0; m < 4; ++m) { const size_t ro = (size_t)(row_t + ai * 128 + wr * 64 + m * 16 + fr) * D + u.pn * 256 + 32 * wc + 8 * fq;
#pragma unroll
                    for (int bj = 0; bj < 2; ++bj) xr[m][bj] = *(const u32x4*)(xb + ro + 128 * bj); }
#pragma unroll
                for (int m = 0; m < 4; ++m) { const size_t ro = (size_t)(row_t + ai * 128 + wr * 64 + m * 16 + fr) * D + u.pn * 256 + 32 * wc + 8 * fq;
#pragma unroll
                    for (int bj = 0; bj < 2; ++bj) { const u32x4 r = xr[m][bj];
                        const f32x4 x0 = {bflo(r.x), bfhi(r.x), bflo(r.y), bfhi(r.y)}, x1 = {bflo(r.z), bfhi(r.z), bflo(r.w), bfhi(r.w)};
                        *(u32x4*)(xb + ro + 128 * bj) = pack8(x0 + gv[bj][0] * acc[ai][bj][m][0], x1 + gv[bj][1] * acc[ai][bj][m][1]); } }
            }
        }
    }
};
struct EpiMoe1 {
    static constexpr bool PERM = false, AFTER_DRAIN = false;
    bf16_t* HID; const float* sw; const float* say;
    __device__ __forceinline__ void operator()(const pg8::i32x4 (&acc)[2][2][4][2], const Unit& u, int wr, int wc, int fr, int fq) const {
        const int j = u.pn % 11;
        f32x4 sg[2], su[2];
#pragma unroll
        for (int n = 0; n < 2; ++n) { sg[n] = *(const f32x4*)(sw + (size_t)u.pn * 256 + 32 * wc + 16 * n + 4 * fq); su[n] = *(const f32x4*)(sw + (size_t)u.pn * 256 + 128 + 32 * wc + 16 * n + 4 * fq); }
#pragma unroll
        for (int ai = 0; ai < 2; ++ai)
#pragma unroll
            for (int m = 0; m < 4; ++m) {
                const int row = u.pm * 256 + ai * 128 + wr * 64 + m * 16 + fr; const float sa = say[row];
                f32x4 h0, h1;
#pragma unroll
                for (int i = 0; i < 4; ++i) { const float g0 = (float)acc[ai][0][m][0][i] * (sa * sg[0][i]), g1 = (float)acc[ai][0][m][1][i] * (sa * sg[1][i]);
                    const float u0 = (float)acc[ai][1][m][0][i] * (sa * su[0][i]), u1 = (float)acc[ai][1][m][1][i] * (sa * su[1][i]);
                    h0[i] = g0 * __builtin_amdgcn_rcpf(1.f + __expf(-g0)) * u0; h1[i] = g1 * __builtin_amdgcn_rcpf(1.f + __expf(-g1)) * u1; }
                *(u32x4*)(HID + (size_t)row * DE + 128 * j + 32 * wc + 8 * fq) = pack8(h0, h1);
            }
    }
};
struct EpiMoe2 {
    static constexpr bool PERM = false, AFTER_DRAIN = false;
    bf16_t* Y; const float* gate;
    __device__ __forceinline__ void operator()(const f32x4 (&acc)[2][2][4][2], const Unit& u, int wr, int wc, int fr, int fq) const {
        const int jn = u.pn & 3;
#pragma unroll
        for (int ai = 0; ai < 2; ++ai)
#pragma unroll
            for (int m = 0; m < 4; ++m) {
                const int row = u.pm * 256 + ai * 128 + wr * 64 + m * 16 + fr; const float gt = gate[row];
#pragma unroll
                for (int bj = 0; bj < 2; ++bj) *(u32x4*)(Y + (size_t)row * D + 256 * jn + 128 * bj + 32 * wc + 8 * fq) = pack8(acc[ai][bj][m][0] * gt, acc[ai][bj][m][1] * gt);
            }
    }
};
struct SchedMoe1 {
    int G, c, ctx;
    __device__ __forceinline__ bool next(int i, Unit& u) const {
        if (G & 7) { const int L = i * G + c, nt = ctx ? 3168 : 2816; if (L >= nt) return false;
            if (L < 2816) { const int e = L / 176, rem = L % 176, j = rem >> 4, b = rem & 15; u.pm = b * 16 + e; u.pn = e * 11 + j; }
            else { const int LL = L - 2816, e = LL / 22, rem = LL % 22, j = rem >> 1, hf = rem & 1; u.pm = 256 + 2 * e + hf; u.pn = e * 11 + j; }
            return true; }
        const int W = G >> 3, x = c & 7, q = i * W + (c >> 3), nq = ctx ? 396 : 352;
        if (q >= nq) return false;
        if (q < 352) { const int el = q / 176, rem = q % 176, bg = rem / 44, rem2 = rem % 44, j = rem2 >> 2, bb = rem2 & 3, e = 2 * x + el, b = 4 * bg + bb; u.pm = b * 16 + e; u.pn = e * 11 + j; }
        else { const int qq = q - 352, el = qq / 22, rem = qq % 22, j = rem >> 1, hf = rem & 1, e = 2 * x + el; u.pm = 256 + 2 * e + hf; u.pn = e * 11 + j; }
        return true;
    }
    __device__ __forceinline__ void a_ready(const Unit&) const {}
    __device__ __forceinline__ void done(const Unit&) const {}
};
struct SchedMoe2 {
    int G, c, ctx;
    __device__ __forceinline__ bool next(int i, Unit& u) const {
        if (G & 7) { const int L = i * G + c, nt = ctx ? 1152 : 1024; if (L >= nt) return false;
            if (L < 1024) { const int e = L >> 6, rem = L & 63, j = rem >> 4, b = rem & 15; u.pm = b * 16 + e; u.pn = e * 4 + j; }
            else { const int LL = L - 1024, e = LL >> 3, rem = LL & 7, j = rem >> 1, hf = rem & 1; u.pm = 256 + 2 * e + hf; u.pn = e * 4 + j; }
            return true; }
        const int W = G >> 3, x = c & 7, q = i * W + (c >> 3), nq = ctx ? 144 : 128;
        if (q >= nq) return false;
        if (q < 128) { const int el = q >> 6, rem = q & 63, bg = rem >> 5, j = (rem & 31) >> 3, bb = rem & 7, e = 2 * x + el, b = 8 * bg + bb; u.pm = b * 16 + e; u.pn = e * 4 + j; }
        else { const int qq = q - 128, el = qq >> 3, rem = qq & 7, j = rem >> 1, hf = rem & 1, e = 2 * x + el; u.pm = 256 + 2 * e + hf; u.pn = e * 4 + j; }
        return true;
    }
    __device__ __forceinline__ void a_ready(const Unit&) const {}
    __device__ __forceinline__ void done(const Unit&) const {}
};

__device__ __forceinline__ void chunk_rows(int chunk, int& row0, int& slo, int& shi) {
    if (chunk < 256) { const int b = chunk >> 4, c = chunk & 15; slo = b * SEQ; shi = slo + SEQ; row0 = slo + 128 * c; }
    else { const int cc = chunk - 256, b = cc >> 1, c = cc & 1; slo = NL + b * CTXL; shi = slo + CTXL; row0 = slo + 128 * c; }
}
struct ConvW { f32x4 w[3][2]; f32x4 b[2]; };
__device__ __forceinline__ void conv_load_w(ConvW& cw, const float* convw, const float* convb, int ch0) {
#pragma unroll
    for (int t = 0; t < 3; ++t) { cw.w[t][0] = *(const f32x4*)(convw + t * 1024 + ch0); cw.w[t][1] = *(const f32x4*)(convw + t * 1024 + ch0 + 4); }
    cw.b[0] = *(const f32x4*)(convb + ch0); cw.b[1] = *(const f32x4*)(convb + ch0 + 4);
}
__device__ __forceinline__ float silu_fast(float x) { return x * __builtin_amdgcn_rcpf(1.f + __expf(-x)); }
__device__ __forceinline__ u32x4 conv8v(const ConvW& cw, const u32x4 xp, const u32x4 xc, const u32x4 xn) {
    float o[8];
#pragma unroll
    for (int i = 0; i < 4; ++i) {
        const int h = i >> 1, k = 2 * (i & 1);
        const float a0 = cw.b[h][k] + cw.w[0][h][k] * bflo(xp[i]) + cw.w[1][h][k] * bflo(xc[i]) + cw.w[2][h][k] * bflo(xn[i]);
        const float a1 = cw.b[h][k + 1] + cw.w[0][h][k + 1] * bfhi(xp[i]) + cw.w[1][h][k + 1] * bfhi(xc[i]) + cw.w[2][h][k + 1] * bfhi(xn[i]);
        o[2 * i] = silu_fast(a0); o[2 * i + 1] = silu_fast(a1);
    }
    u32x4 r; r.x = pk2(o[0], o[1]); r.y = pk2(o[2], o[3]); r.z = pk2(o[4], o[5]); r.w = pk2(o[6], o[7]); return r;
}
constexpr int CV_STRIDE = 272;
template <int R, bool TO_LDS>
__device__ __forceinline__ void conv_rows(const ConvW& cw, const bf16_t* __restrict__ XBCp, bf16_t* __restrict__ XBCCp, int rfirst, int row0, int slo, int shi, int ch0, LAS unsigned char* T, int tcol) {
    u32x4 x[R + 2];
#pragma unroll
    for (int i = 0; i < R + 2; ++i) { const int row = row0 + rfirst + i - 1; x[i] = (row >= slo && row < shi) ? *(const u32x4*)(XBCp + (size_t)row * 1024 + ch0) : (u32x4){0u, 0u, 0u, 0u}; }
#pragma unroll
    for (int i = 0; i < R; ++i) { const u32x4 v = conv8v(cw, x[i], x[i + 1], x[i + 2]); *(u32x4*)(XBCCp + (size_t)(row0 + rfirst + i) * 1024 + ch0) = v;
        if (TO_LDS) *(LAS u32x4*)(T + (rfirst + i) * CV_STRIDE + tcol * 16) = v; }
}
__device__ __forceinline__ void p3_conv(const Frame& F, int layer) {
    const float* convw = INP(I_CONVW) + (size_t)layer * 3 * 1024; const float* convb = INP(I_CONVB) + (size_t)layer * 1024;
    LAS unsigned char* Bt = F.lds; LAS unsigned char* Ct = F.lds + 128 * CV_STRIDE;
    const int tid = F.tid, lane = F.lane, wave = F.wave;
    const bf16_t* const XBCp = F_XBC; bf16_t* const XBCCp = F_XBCC; bf16_t* const GMp = F_GM;
    for (int u = F.blk; u < 288 * 3; u += F.G) {
        const int chunk = u / 3, part = u % 3; int row0, slo, shi; chunk_rows(chunk, row0, slo, shi);
        if (part == 0) {
            const int ch0 = 8 * (tid & 63), rg = tid >> 6; ConvW cw; conv_load_w(cw, convw, convb, ch0);
            conv_rows<16, false>(cw, XBCp, XBCCp, 16 * rg, row0, slo, shi, ch0, Bt, 0);
        } else {
            const int g = part - 1, cg = tid & 31, rg = tid >> 5;
            const int ch0 = (cg < 16) ? (512 + 128 * g + 8 * cg) : (768 + 128 * g + 8 * (cg - 16));
            ConvW cw; conv_load_w(cw, convw, convb, ch0);
            conv_rows<8, true>(cw, XBCp, XBCCp, 8 * rg, row0, slo, shi, ch0, (cg < 16) ? Bt : Ct, cg & 15);
            __syncthreads();
            bf16_t* gm = GMp + (size_t)(chunk * 2 + g) * 128 * 128;
#pragma unroll
            for (int i = 0; i < 2; ++i) { const int blk = 2 * wave + i, lb = blk >> 2, sb = blk & 3;
                f32x16 acc = {};
#pragma unroll
                for (int ks = 0; ks < 8; ++ks) acc = MFMA32(frag_rm(Ct, CV_STRIDE, 32 * lb, 16 * ks, lane), frag_rm(Bt, CV_STRIDE, 32 * sb, 16 * ks, lane), acc);
#pragma unroll
                for (int t = 0; t < 16; ++t) gm[(32 * lb + accrow(t, lane >> 5)) * 128 + 32 * sb + (lane & 31)] = f2bf(acc[t]);
            }
            __syncthreads();
        }
    }
}

constexpr int SS_XS = 0, SS_XS_STRIDE = 144;
constexpr int SS_BM = 18432;
constexpr int SS_CM = SS_BM + 34816;
constexpr int SS_GM = SS_CM + 34816;
constexpr int SS_H = SS_GM + 34816, SS_H_BYTES = 64 * 272;
constexpr int SS_SC = SS_H + SS_H_BYTES;
static_assert(SS_SC + 4 * 512 + 16 <= MISC_OFF, "ssd lds");
__device__ __forceinline__ int ssd_chunk_of(int dir, int b, int step) {
    if (dir == 0) return (step < 2) ? (256 + 2 * b + step) : (16 * b + (step - 2));
    return (step < 2) ? (256 + 2 * b + (1 - step)) : (16 * b + (17 - step));
}
__device__ __forceinline__ void ssd_unit(const Frame& F, int layer, int unit) {
    int tid_ = F.tid; asm volatile("" : "+v"(tid_));
    const int tid = tid_, lane = tid & 63, wave = __builtin_amdgcn_readfirstlane(tid >> 6);
    const int dir = unit & 1, hd = (unit >> 1) & 7, b = unit >> 4, g = hd >> 2;
    LAS unsigned char* L = F.lds;
    LAS float* acs = (LAS float*)(L + SS_SC); LAS float* dtv = acs + 128; LAS float* wrow = acs + 256; LAS float* erow = acs + 384; LAS float* aendp = acs + 512;
    const float a_coef = -__expf((dir ? INP(I_ALOGB) : INP(I_ALOGF))[layer * 8 + hd]);
    unsigned vz; asm volatile("v_mov_b32 %0, 0" : "=v"(vz));
    bf16_t* Yout = (dir ? F_YB : F_YF) + vz; const bf16_t* const XBCCp = F_XBCC + vz; const bf16_t* const GMp = F_GM + vz; const float* const DTp = F_DT + vz;
    f32x16 hacc = {};
    for (int prb = 0; prb < ((PROBE_MASK & 256) ? 2 : 1); ++prb) {
    for (int i = tid; i < SS_H_BYTES / 4; i += NTHREADS) ((LAS unsigned*)(L + SS_H))[i] = 0u;
    hacc = (f32x16){};
    u32x4 rx[2], rb[4], rc[4], rg[4]; float rd0 = 0.f, rd1 = 0.f;
#define SS_LOAD(step_) do { const int ck_ = ssd_chunk_of(dir, b, (step_)); int r0_, lo_, hi_; chunk_rows(ck_, r0_, lo_, hi_); \
        _Pragma("unroll") for (int i = 0; i < 2; ++i) { const int idx = tid + 512 * i, r = idx >> 3, ch = idx & 7; rx[i] = *(const u32x4*)(XBCCp + (size_t)(r0_ + r) * 1024 + hd * 64 + ch * 8); } \
        const bf16_t* gmp_ = GMp + (size_t)(ck_ * 2 + g) * 128 * 128; \
        _Pragma("unroll") for (int i = 0; i < 4; ++i) { const int idx = tid + 512 * i, r = idx >> 4, ch = idx & 15; \
            rb[i] = *(const u32x4*)(XBCCp + (size_t)(r0_ + r) * 1024 + 512 + 128 * g + ch * 8); rc[i] = *(const u32x4*)(XBCCp + (size_t)(r0_ + r) * 1024 + 768 + 128 * g + ch * 8); \
            rg[i] = *(const u32x4*)(gmp_ + r * 128 + ch * 8); } \
        if (wave == 7) { rd0 = DTp[(size_t)(r0_ + 2 * lane) * 16 + dir * 8 + hd]; rd1 = DTp[(size_t)(r0_ + 2 * lane + 1) * 16 + dir * 8 + hd]; } } while (0)
#define SS_STORE() do { \
        _Pragma("unroll") for (int i = 0; i < 2; ++i) { const int idx = tid + 512 * i, r = idx >> 3, ch = idx & 7; *(LAS u32x4*)(L + SS_XS + r * SS_XS_STRIDE + ch * 16) = rx[i]; } \
        _Pragma("unroll") for (int i = 0; i < 4; ++i) { const int idx = tid + 512 * i, r = idx >> 4, ch = idx & 15; \
            *(LAS u32x4*)(L + SS_BM + r * 272 + ch * 16) = rb[i]; *(LAS u32x4*)(L + SS_CM + r * 272 + ch * 16) = rc[i]; *(LAS u32x4*)(L + SS_GM + r * 272 + ch * 16) = rg[i]; } } while (0)
    SS_LOAD(0);
    SS_STORE();
    for (int step = 0; step < 18; ++step) {
        const int chunk = ssd_chunk_of(dir, b, step);
        int row0, slo, shi; chunk_rows(chunk, row0, slo, shi);
        int tid2 = tid, lane2 = lane; asm volatile("" : "+v"(tid2), "+v"(lane2));
        if (wave == 7) {
            const float d0 = rd0, d1 = rd1;
            const float da0 = d0 * a_coef, da1 = d1 * a_coef; const float ps = da0 + da1;
            float inc = ps; float c0v, c1v;
            if (dir == 0) {
#pragma unroll
                for (int o = 1; o < 64; o <<= 1) { const float t = shl_from(inc, lane2 - o); if (lane2 >= o) inc += t; }
                c0v = inc - da1; c1v = inc;
            } else {
#pragma unroll
                for (int o = 1; o < 64; o <<= 1) { const float t = shl_from(inc, lane2 + o); if (lane2 + o < 64) inc += t; }
                c0v = inc; c1v = inc - da0;
            }
            const float tot = shl_from(inc, dir ? 0 : 63);
            acs[2 * lane2] = c0v; acs[2 * lane2 + 1] = c1v; dtv[2 * lane2] = d0; dtv[2 * lane2 + 1] = d1;
            wrow[2 * lane2] = __expf(tot - c0v) * d0; wrow[2 * lane2 + 1] = __expf(tot - c1v) * d1;
            erow[2 * lane2] = __expf(c0v); erow[2 * lane2 + 1] = __expf(c1v);
            if (lane2 == 0) aendp[0] = __expf(tot);
        }
        if (step + 1 < 18) SS_LOAD(step + 1);
        lds_barrier();
        {
            u32x4 vg[4], vb[4]; float alr[4], wr_[4]; f32x4 ac0[4], ac1[4], dq0[4], dq1[4];
#pragma unroll
            for (int i = 0; i < 4; ++i) { const int idx = tid2 + 512 * i, r = idx >> 4, ch = idx & 15, s0 = ch * 8;
                vg[i] = *(LAS const u32x4*)(L + SS_GM + r * 272 + ch * 16); vb[i] = *(LAS const u32x4*)(L + SS_BM + r * 272 + ch * 16);
                alr[i] = acs[r]; wr_[i] = wrow[r];
                ac0[i] = *(LAS const f32x4*)(acs + s0); ac1[i] = *(LAS const f32x4*)(acs + s0 + 4); dq0[i] = *(LAS const f32x4*)(dtv + s0); dq1[i] = *(LAS const f32x4*)(dtv + s0 + 4); }
#pragma unroll
            for (int i = 0; i < 4; ++i) { const int idx = tid2 + 512 * i, r = idx >> 4, ch = idx & 15, s0 = ch * 8; float o[8];
#pragma unroll
                for (int e = 0; e < 8; ++e) { const int s = s0 + e; const bool ok = dir ? (s >= r) : (s <= r);
                    const float acv = (e < 4) ? ac0[i][e & 3] : ac1[i][e & 3], dtq = (e < 4) ? dq0[i][e & 3] : dq1[i][e & 3];
                    const float gv = (e & 1) ? bfhi(vg[i][e >> 1]) : bflo(vg[i][e >> 1]); o[e] = ok ? gv * __expf(alr[i] - acv) * dtq : 0.f; }
                u32x4 w; w.x = pk2(o[0], o[1]); w.y = pk2(o[2], o[3]); w.z = pk2(o[4], o[5]); w.w = pk2(o[6], o[7]); *(LAS u32x4*)(L + SS_GM + r * 272 + ch * 16) = w;
                u32x4 wb;
#pragma unroll
                for (int e = 0; e < 4; ++e) wb[e] = pk2(bflo(vb[i][e]) * wr_[i], bfhi(vb[i][e]) * wr_[i]);
                *(LAS u32x4*)(L + SS_BM + r * 272 + ch * 16) = wb; }
        }
        lds_barrier();
        {
            const int lb = wave >> 1, pb = wave & 1; f32x16 y = {}, yo = {};
            bf16x8 fa[8], fb[8];
#pragma unroll
            for (int ks = 0; ks < 8; ++ks) { fa[ks] = frag_rm(L + SS_GM, 272, 32 * lb, 16 * ks, lane); fb[ks] = frag_tr(L + SS_XS, SS_XS_STRIDE, 16 * ks, 32 * pb, lane); }
            __builtin_amdgcn_sched_barrier(0);
#pragma unroll
            for (int ks = 0; ks < 8; ++ks) y = MFMA32(fa[ks], fb[ks], y);
#pragma unroll
            for (int ks = 0; ks < 8; ++ks) { fa[ks] = frag_rm(L + SS_CM, 272, 32 * lb, 16 * ks, lane); fb[ks] = frag_rm(L + SS_H, 272, 32 * pb, 16 * ks, lane); }
            __builtin_amdgcn_sched_barrier(0);
#pragma unroll
            for (int ks = 0; ks < 8; ++ks) yo = MFMA32(fa[ks], fb[ks], yo);
            __builtin_amdgcn_sched_barrier(0);
#pragma unroll
            for (int t = 0; t < 16; ++t) { const int l = 32 * lb + accrow(t, lane >> 5); Yout[(size_t)(row0 + l) * 512 + hd * 64 + 32 * pb + (lane & 31)] = f2bf(y[t] + erow[l] * yo[t]); }
        }
        lds_barrier();
        {
            const int pb = wave & 1, nb = wave >> 1; const float dec = aendp[0];
            bf16x8 fa[8], fb[8];
#pragma unroll
            for (int ks = 0; ks < 8; ++ks) { fa[ks] = frag_tr(L + SS_XS, SS_XS_STRIDE, 16 * ks, 32 * pb, lane); fb[ks] = frag_tr(L + SS_BM, 272, 16 * ks, 32 * nb, lane); }
#pragma unroll
            for (int t = 0; t < 16; ++t) hacc[t] *= dec;
            __builtin_amdgcn_sched_barrier(0);
#pragma unroll
            for (int ks = 0; ks < 8; ++ks) hacc = MFMA32(fa[ks], fb[ks], hacc);
#pragma unroll
            for (int t = 0; t < 16; ++t) *(LAS bf16_t*)(L + SS_H + (32 * pb + accrow(t, lane >> 5)) * 272 + (32 * nb + (lane & 31)) * 2) = f2bf(hacc[t]);
        }
        lds_barrier();
        if (step + 1 < 18) SS_STORE();
    }
    __syncthreads();
    }
#undef SS_LOAD
#undef SS_STORE
    __syncthreads();
}

constexpr int AT_KSTR = 272, AT_VSTR = 320, AT_KBYTES = 64 * AT_KSTR, AT_VBYTES = 64 * AT_VSTR;
constexpr int AT_K = 0, AT_V = 2 * AT_KBYTES, AT_LX = AT_V + 2 * AT_VBYTES;
__device__ __forceinline__ void attn_unit(const Frame& F, int layer, int qrow0, int ntiles, int b, int head, float lam, float m2, float lam_init) {
    int tid_ = F.tid; asm volatile("" : "+v"(tid_));
    const int tid = tid_, lane = tid & 63, wave = __builtin_amdgcn_readfirstlane(tid >> 6), r32 = lane & 31, hh = lane >> 5;
    const int mp = wave & 1, qg = wave >> 1;
    LAS unsigned char* L = F.lds;
    const bf16_t* const Kp = F_K + head * 128; const bf16_t* const Vp = F_V + head * 128; bf16_t* const A2p = F_A2;
    bf16x8 qf[4];
    { const bf16_t* qp = F_Q + (size_t)(qrow0 + 32 * qg + r32) * 512 + head * 128 + mp * 64 + 8 * hh;
#pragma unroll
      for (int d0 = 0; d0 < 4; ++d0) qf[d0] = *(const bf16x8*)(qp + d0 * 16); }
    f32x16 o[4];
#pragma unroll
    for (int j = 0; j < 4; ++j) o[j] = (f32x16){};
    float lsum = 0.f;
    f32x16 negm;
    { float m2l = m2; asm volatile("" : "+v"(m2l));
#pragma unroll
      for (int t = 0; t < 16; ++t) negm[t] = -m2l; }
    u32x4 kreg[2], vreg[2];
    const int prow0 = tid >> 4, pch = tid & 15;
#define AT_KROW(t) (((t) < 4) ? (NL + b * CTXL + 64 * (t)) : (b * SEQ + 64 * ((t) - 4)))
#define AT_LOADK(t) do { const int kr_ = AT_KROW(t); _Pragma("unroll") for (int i_ = 0; i_ < 2; ++i_) kreg[i_] = *(const u32x4*)(Kp + (size_t)(kr_ + prow0 + 32 * i_) * 512 + pch * 8); } while (0)
#define AT_LOADV(t) do { const int kr_ = AT_KROW(t); _Pragma("unroll") for (int i_ = 0; i_ < 2; ++i_) vreg[i_] = *(const u32x4*)(Vp + (size_t)(kr_ + prow0 + 32 * i_) * 512 + pch * 8); } while (0)
#define AT_STOREK(st) do { _Pragma("unroll") for (int i_ = 0; i_ < 2; ++i_) *(LAS u32x4*)(L + AT_K + (st) * AT_KBYTES + (prow0 + 32 * i_) * AT_KSTR + pch * 16) = kreg[i_]; } while (0)
#define AT_STOREV(st) do { _Pragma("unroll") for (int i_ = 0; i_ < 2; ++i_) *(LAS u32x4*)(L + AT_V + (st) * AT_VBYTES + (prow0 + 32 * i_) * AT_VSTR + pch * 16) = vreg[i_]; } while (0)
#define AT_QK(SA, SB, st) do { LAS const unsigned char* Kt_ = L + AT_K + (st) * AT_KBYTES + r32 * AT_KSTR + (mp * 64 + 8 * hh) * 2; SA = negm; SB = negm; \
        _Pragma("unroll") for (int d0 = 0; d0 < 4; ++d0) { const bf16x8 ka = *(LAS const bf16x8*)(Kt_ + d0 * 32); const bf16x8 kb = *(LAS const bf16x8*)(Kt_ + 32 * AT_KSTR + d0 * 32); \
            __builtin_amdgcn_s_setprio(1); SA = MFMA32(ka, qf[d0], SA); SB = MFMA32(kb, qf[d0], SB); __builtin_amdgcn_s_setprio(0); } } while (0)
    AT_LOADK(0); AT_LOADV(0); AT_STOREK(0); AT_STOREV(0);
    if (ntiles > 1) { AT_LOADK(1); AT_STOREK(1); }
    __syncthreads();
    f32x16 sa, sb, na, nb;
    AT_QK(sa, sb, 0);
    lds_barrier();
    for (int t = 0; t < ntiles; ++t) {
        if (t + 2 < ntiles) AT_LOADK(t + 2);
        if (t + 1 < ntiles) AT_LOADV(t + 1);
        if (t + 1 < ntiles) AT_QK(na, nb, (t + 1) & 1);
        float ls = 0.f;
#pragma unroll
        for (int i = 0; i < 16; ++i) { sa[i] = __builtin_amdgcn_exp2f(sa[i]); sb[i] = __builtin_amdgcn_exp2f(sb[i]); ls += sa[i] + sb[i]; }
        lsum += ls;
        bf16x8 pk[4];
        { u32x4 w0, w1, w2, w3;
#pragma unroll
          for (int i = 0; i < 4; ++i) { w0[i] = pk2(sa[2 * i], sa[2 * i + 1]); w1[i] = pk2(sa[8 + 2 * i], sa[9 + 2 * i]); w2[i] = pk2(sb[2 * i], sb[2 * i + 1]); w3[i] = pk2(sb[8 + 2 * i], sb[9 + 2 * i]); }
          pk[0] = __builtin_bit_cast(bf16x8, w0); pk[1] = __builtin_bit_cast(bf16x8, w1); pk[2] = __builtin_bit_cast(bf16x8, w2); pk[3] = __builtin_bit_cast(bf16x8, w3); }
        LAS const unsigned char* Vt = L + AT_V + (t & 1) * AT_VBYTES;
        __builtin_amdgcn_sched_barrier(0);
        bf16x8 vfa[4], vfb[4];
#pragma unroll
        for (int j = 0; j < 4; ++j) vfa[j] = frag_tr_acc(Vt, AT_VSTR, 0, 32 * j, lane);
#pragma unroll
        for (int ks = 0; ks < 4; ks += 2) {
#pragma unroll
            for (int j = 0; j < 4; ++j) vfb[j] = frag_tr_acc(Vt, AT_VSTR, 16 * (ks + 1), 32 * j, lane);
            __builtin_amdgcn_s_setprio(1);
#pragma unroll
            for (int j = 0; j < 4; ++j) o[j] = MFMA32(pk[ks], vfa[j], o[j]);
            __builtin_amdgcn_s_setprio(0);
            __builtin_amdgcn_sched_barrier(0);
            if (ks + 2 < 4) {
#pragma unroll
                for (int j = 0; j < 4; ++j) vfa[j] = frag_tr_acc(Vt, AT_VSTR, 16 * (ks + 2), 32 * j, lane);
            }
            __builtin_amdgcn_s_setprio(1);
#pragma unroll
            for (int j = 0; j < 4; ++j) o[j] = MFMA32(pk[ks + 1], vfb[j], o[j]);
            __builtin_amdgcn_s_setprio(0);
            __builtin_amdgcn_sched_barrier(0);
        }
        if (t + 2 < ntiles) AT_STOREK(t & 1);
        if (t + 1 < ntiles) AT_STOREV((t + 1) & 1);
        __syncthreads();
        sa = na; sb = nb;
    }
#undef AT_LOADK
#undef AT_LOADV
#undef AT_STOREK
#undef AT_STOREV
#undef AT_QK
#undef AT_KROW
    int lane_e = lane; asm volatile("" : "+v"(lane_e));
#define r32 r32e
#define hh hhe
    const int r32e = lane_e & 31, hhe = lane_e >> 5;
    LAS float* lx = (LAS float*)(L + AT_LX + wave * 256);
    { const float l0 = lsum + shx(lsum, 32, lane_e); if (hh == 0) lx[r32] = (mp ? lam : 1.f) / l0; }
    LDS_WAIT();
    LAS float* X = (LAS float*)(L + qg * 16384);
    float isc[16];
#pragma unroll
    for (int t = 0; t < 16; ++t) isc[t] = lx[accrow(t, hh)];
    if (mp == 1) {
#pragma unroll
        for (int t = 0; t < 16; ++t)
#pragma unroll
            for (int j = 0; j < 4; ++j) X[accrow(t, hh) * 128 + 32 * j + r32] = o[j][t] * isc[t];
    }
    __syncthreads();
    if (mp == 0) {
        const float* sw = INP(I_SUBLN) + layer * 128;
        float swv[4];
#pragma unroll
        for (int j = 0; j < 4; ++j) swv[j] = sw[32 * j + r32] * (1.f - lam_init);
#pragma unroll
        for (int t = 0; t < 16; ++t) {
            const int q = accrow(t, hh);
            float v[4]; float ss = 0.f;
#pragma unroll
            for (int j = 0; j < 4; ++j) { v[j] = o[j][t] * isc[t] - X[q * 128 + 32 * j + r32]; ss += v[j] * v[j]; }
#pragma unroll
            for (int of = 1; of < 32; of <<= 1) ss += shx(ss, of, lane_e);
            const float rstd = rsqrtf(ss * (1.f / 128.f) + EPS);
            bf16_t* op = A2p + (size_t)(qrow0 + 32 * qg + q) * 1024 + head * 128 + r32;
#pragma unroll
            for (int j = 0; j < 4; ++j) op[32 * j] = f2bf(v[j] * rstd * swv[j]);
        }
    }
#undef r32
#undef hh
    __syncthreads();
}

__device__ __forceinline__ void p4_mixer(const Frame& F, int layer, int rep) {
    const int lane = F.lane;
    const float lam_init = 0.8f - 0.6f * __expf(-0.3f * (float)layer);
    const float p1 = wave_sum(INP(I_LQ1)[layer * 64 + lane] * INP(I_LK1)[layer * 64 + lane]);
    const float p2 = wave_sum(INP(I_LQ2)[layer * 64 + lane] * INP(I_LK2)[layer * 64 + lane]);
    const float lam = __expf(p1) - __expf(p2) + lam_init;
    const float qmx = wave_max(fabsf(INP(I_QNW)[layer * 64 + lane])), kmx = wave_max(fabsf(INP(I_KNW)[layer * 64 + lane]));
    const float m2 = 8.f * qmx * kmx * LOG2E * 1.01f;
    const int na = (layer < DEPTH - 1) ? 128 + 16 : 128;
    const int ncv = (CVB + ((layer + 1 < DEPTH) ? CV_SMALL / 8 : 0)) / 8;
    const int nq = 32 + na + ncv;
    volatile LAS unsigned* bc = (volatile LAS unsigned*)(F.lds + MISC_OFF) + 16;
    const int myx = (int)(__builtin_amdgcn_s_getreg((3 << 11) | 20) & 7u);
    unsigned* const wq = F_CTL + CW_WQ + 1024 * (layer + 4 * rep);
    for (int qi = 0; qi < 8; ++qi) {
        const int x = (myx + qi) & 7;
        for (;;) {
            if (F.tid == 0) bc[0] = __hip_atomic_fetch_add(wq + 64 * x, 1u, __ATOMIC_RELAXED, __HIP_MEMORY_SCOPE_AGENT);
            __syncthreads();
            const int it = (int)bc[0];
            __syncthreads();
            if (it >= nq) break;
            if (it < 32) {
#ifndef SKIP_SSD
                const int grp = 4 * x + (it >> 3), m = it & 7, b = grp >> 1, g = grp & 1, hd = 4 * g + (m >> 1), dir = m & 1;
                ssd_unit(F, layer, (b << 4) | (hd << 1) | dir);
#endif
            } else {
                const int p = it - 32; int a = -1, cv = -1;
                if (p < 2 * na) { if (p & 1) cv = p >> 1; else a = p >> 1; } else cv = p - na;
                if (cv >= 0) { const int g = x + 8 * cv; Frame Fc = F; Fc.lane = lane_id_v(); Fc.tid = Fc.wave * 64 + Fc.lane;
                    if (g < CVB_WGU) cvt_wgu_block(Fc, layer, g);
                    else if (g < CVB) cvt_layer_item(Fc, layer, CV_SMALL + CV_WGU + 8 * (g - CVB_WGU) + Fc.wave, (LAS float*)(Fc.lds + Fc.wave * 17408));
                    else cvt_layer_item(Fc, layer + 1, 8 * (g - CVB) + Fc.wave, (LAS float*)(Fc.lds + Fc.wave * 17408)); }
#ifndef SKIP_ATT
                else
                for (int pr = 0; pr < ((PROBE_MASK & 512) ? 2 : 1); ++pr)
                if (a < 128) { const int c = 8 * (a >> 4) + x, qb = a & 15, b = c >> 2, head = c & 3; attn_unit(F, layer, b * SEQ + 128 * qb, 36, b, head, lam, m2, lam_init); }
                else { const int a2 = a - 128, c = 8 * (a2 >> 1) + x, qb = a2 & 1, b = c >> 2, head = c & 3; attn_unit(F, layer, NL + b * CTXL + 128 * qb, 4, b, head, lam, m2, lam_init); }
#endif
            }
        }
    }
}

__device__ __forceinline__ void p8_topk(const Frame& F, int layer) {
    const int tid = F.tid, lane = F.lane, wave = F.wave;
    LAS unsigned* cnt = (LAS unsigned*)F.lds;
    LAS unsigned* cg = cnt + 48;
    LAS unsigned* ce = cnt + 80;
    LAS int* sidx = (LAS int*)(F.lds + 1024);
    const int nunits = (layer < DEPTH - 1) ? 512 : 256;
    const float* const AFFp = F_AFF; float* const GATEp = F_GATE; int* const INVp = F_INV; unsigned* const ROFFp = F_ROFF; const float* const SAp = F_SA; float* const SAYp = F_SAY;
    const unsigned long long lt_mask = (lane == 0) ? 0ull : (~0ull >> (64 - lane));
    for (int u = F.blk; u < nunits; u += F.G) {
        const bool lat = u < 256; const int uu = lat ? u : u - 256, b = uu >> 4, e = uu & 15;
        const int n = lat ? SEQ : CTXL, cap = lat ? 256 : 32;
        const float* av = lat ? AFFp + (size_t)uu * 2048 : AFFp + (size_t)NL * 16 + (size_t)uu * 256;
        const int rowb = lat ? b * SEQ : NL + b * CTXL;
        const int yb = lat ? (b * 16 + e) * 256 : (256 + 2 * e + (b >> 3)) * 256 + (b & 7) * 32;
        unsigned v[4];
#pragma unroll
        for (int k = 0; k < 4; ++k) { const int i = tid + 512 * k; v[k] = (i < n) ? __float_as_uint(av[i]) : 0u; }
        unsigned T = 0u;
        {
            unsigned c = 0;
#pragma unroll
            for (int k = 0; k < 4; ++k) c += (unsigned)__popcll(__ballot(v[k] >= 0x40000000u));
            if (lane == 0) cnt[24 + wave] = c;
            __syncthreads();
            unsigned tot = 0;
#pragma unroll
            for (int w = 0; w < 8; ++w) tot += cnt[24 + w];
            if (tot >= (unsigned)cap) T = 0x40000000u;
        }
        for (int bit = 28; bit >= 0; bit -= 2) {
            const unsigned c1 = T | (1u << bit), c2 = T | (2u << bit), c3 = T | (3u << bit); const int par = (bit >> 1) & 1;
            unsigned n1 = 0, n2 = 0, n3 = 0;
#pragma unroll
            for (int k = 0; k < 4; ++k) { n1 += (unsigned)__popcll(__ballot(v[k] >= c1)); n2 += (unsigned)__popcll(__ballot(v[k] >= c2)); n3 += (unsigned)__popcll(__ballot(v[k] >= c3)); }
            if (lane == 0) { cnt[par * 24 + wave] = n1; cnt[par * 24 + 8 + wave] = n2; cnt[par * 24 + 16 + wave] = n3; }
            __syncthreads();
            unsigned t1 = 0, t2 = 0, t3 = 0;
#pragma unroll
            for (int w = 0; w < 8; ++w) { t1 += cnt[par * 24 + w]; t2 += cnt[par * 24 + 8 + w]; t3 += cnt[par * 24 + 16 + w]; }
            if (t3 >= (unsigned)cap) T = c3; else if (t2 >= (unsigned)cap) T = c2; else if (t1 >= (unsigned)cap) T = c1;
        }
        unsigned pg[4], pe[4]; bool isg[4], ise[4];
#pragma unroll
        for (int k = 0; k < 4; ++k) { isg[k] = v[k] > T; ise[k] = v[k] == T;
            const unsigned long long mg = __ballot(isg[k]), me = __ballot(ise[k]);
            pg[k] = (unsigned)__popcll(mg & lt_mask); pe[k] = (unsigned)__popcll(me & lt_mask);
            if (lane == 0) { cg[k * 8 + wave] = (unsigned)__popcll(mg); ce[k * 8 + wave] = (unsigned)__popcll(me); } }
        __syncthreads();
        unsigned totg = 0;
#pragma unroll
        for (int j = 0; j < 32; ++j) totg += cg[j];
        unsigned bg = 0, be = 0;
#pragma unroll
        for (int k = 0; k < 4; ++k) {
#pragma unroll
            for (int w = 0; w < 8; ++w) { const bool before = w < wave; if (before) { bg += cg[k * 8 + w]; be += ce[k * 8 + w]; } }
            const int i = tid + 512 * k;
            if (i < n) {
                int slot = -1;
                if (isg[k]) slot = (int)(bg + pg[k]);
                else if (ise[k]) { const unsigned r = be + pe[k]; if (totg + r < (unsigned)cap) slot = (int)(totg + r); }
                const int row = rowb + i;
                if (slot >= 0) { ROFFp[yb + slot] = (unsigned)row * (unsigned)D; SAYp[yb + slot] = SAp[row]; GATEp[yb + slot] = __uint_as_float(v[k]); INVp[(size_t)row * 16 + e] = yb + slot; } else INVp[(size_t)row * 16 + e] = -1;
            }
#pragma unroll
            for (int w = 0; w < 8; ++w) { const bool rest = w >= wave; if (rest) { bg += cg[k * 8 + w]; be += ce[k * 8 + w]; } }
        }
        __syncthreads();
    }
}
}

#define XB_TMO      128
#define XB_XCNT(j)  (256  + 64 * (j))
#define XB_XSUB(j)  (1280 + 64 * (j))
#define XB_XGEN(j)  (2304 + 64 * (j))
#define XB_TOP      3328
#define XB_TOPGEN   3392
#define XCD_BAR_WORDS 3456
#define XB_SPIN_CAP (1u << 22)

__device__ __forceinline__ unsigned xb_ld(unsigned* p)              { return __hip_atomic_load(p, __ATOMIC_RELAXED, __HIP_MEMORY_SCOPE_AGENT); }
__device__ __forceinline__ unsigned xb_add(unsigned* p, unsigned v) { return __hip_atomic_fetch_add(p, v, __ATOMIC_RELAXED, __HIP_MEMORY_SCOPE_AGENT); }
__device__ __forceinline__ unsigned xb_xcc_id() { return (unsigned)__builtin_amdgcn_s_getreg((3 << 11) | 20) & 0xFu; }
#define XB_SPIN(cond, bar) do { unsigned _sp = 0; while (cond) { __builtin_amdgcn_s_sleep(1); \
    if ((++_sp & 255u) == 0u) { if (xb_ld(&(bar)[XB_TMO])) break; if (_sp > XB_SPIN_CAP) { atomicAdd(&(bar)[XB_TMO], 1u); break; } } } } while (0)

struct XcdBarrier { unsigned* bar; unsigned x; volatile LAS unsigned* st; };

__device__ __forceinline__ XcdBarrier xcd_barrier_post(unsigned* bar, volatile LAS unsigned* st) {
    XcdBarrier b; b.bar = bar; b.x = xb_xcc_id(); b.st = st;
    if (threadIdx.x == 0) (void)xb_add(&bar[XB_XCNT(b.x)], 1u);
    return b;
}
__device__ __forceinline__ void xcd_barrier_complete(unsigned* bar, unsigned x, unsigned& nloc, unsigned& nx) {
    const unsigned G = gridDim.x * gridDim.y * gridDim.z;
    unsigned sum, cnt, mine, sp = 0u;
    for (;;) {
        sum = 0u; cnt = 0u; mine = 0u;
#pragma unroll
        for (unsigned j = 0; j < 16; ++j) { const unsigned c = xb_ld(&bar[XB_XCNT(j)]); sum += c; cnt += (c > 0u) ? 1u : 0u; mine = (j == x) ? c : mine; }
        if (sum == G) break;
        __builtin_amdgcn_s_sleep(1);
        if ((++sp & 255u) == 0u) { if (xb_ld(&bar[XB_TMO])) break; if (sp > XB_SPIN_CAP) { atomicAdd(&bar[XB_TMO], 1u); break; } }
    }
    nloc = mine > 0u ? mine : 1u; nx = cnt > 0u ? cnt : 1u;
}
__device__ __forceinline__ void xcd_barrier(const XcdBarrier& b) {
    asm volatile("s_waitcnt vmcnt(0)" ::: "memory");
    __syncthreads();
    if (threadIdx.x == 0) {
        unsigned* bar = b.bar;
        __builtin_amdgcn_s_waitcnt(0);
        unsigned nloc = b.st[0], nx = b.st[1];
        if (nloc == 0u) { xcd_barrier_complete(bar, b.x, nloc, nx); b.st[0] = nloc; b.st[1] = nx; }
        const unsigned old = xb_add(&bar[XB_XSUB(b.x)], 1u);
        const unsigned gen = old / nloc;
        if (old + 1u == (gen + 1u) * nloc) {
            __builtin_amdgcn_fence(__ATOMIC_RELEASE, "agent");
            asm volatile("s_waitcnt vmcnt(0)" ::: "memory");
            const unsigned og = xb_add(&bar[XB_TOP], 1u);
            const unsigned tg = og / nx;
            if (og + 1u == (tg + 1u) * nx) xb_add(&bar[XB_TOPGEN], 1u);
            else XB_SPIN(xb_ld(&bar[XB_TOPGEN]) == tg, bar);
            __builtin_amdgcn_fence(__ATOMIC_ACQUIRE, "agent");
            xb_add(&bar[XB_XGEN(b.x)], 1u);
            asm volatile("s_waitcnt vmcnt(0)" ::: "memory");
        } else {
            XB_SPIN(xb_ld(&bar[XB_XGEN(b.x)]) == gen, bar);
            __builtin_amdgcn_fence(__ATOMIC_ACQUIRE, "agent");
            asm volatile("s_waitcnt vmcnt(0)" ::: "memory");
        }
    }
    __syncthreads();
}


namespace mk {
__device__ __forceinline__ void g_inproj(const Frame& F, int layer) {
    pg8::Gemm g{(const bf16_t*)F_HAQ, (const bf16_t*)(F_WINQ + (size_t)layer * NPROJ * D), NT, NPROJ, D / 2}; pg8::StaticOrder S; S.init(NT, NPROJ, F.G, F.blk);
    EpiInProj E{WSP() + WS_U, F_QKW + layer * 128, F_ROPEC, F_ROPES, F_SAH, F_SWIN + (size_t)layer * NPROJ};
    pg8::gemm_phase_i8<EpiInProj, pg8::StaticOrder, true, true>(F.lds, g, S, E, F.tid);
}
__device__ __forceinline__ void g_outproj(const Frame& F, int layer, float gscale) {
    const int M = (layer < DEPTH - 1) ? NT : NL;
    pg8::Gemm g{F_A2, F_WOUT + (size_t)layer * D * D, M, D, D}; pg8::StaticOrder S; S.init(M, D, F.G, F.blk);
    const bool first = (layer == 0 && gscale != 0.f);
    EpiOutProj E{INP(I_X), INP(I_CTX), F_XB, F_MOD + (size_t)layer * 17 * 6144, gscale, first};
    pg8::gemm_phase<EpiOutProj, pg8::StaticOrder, true, true>(F.lds, g, S, E, F.tid);
}
__device__ __forceinline__ void g_moe1(const Frame& F, int layer) {
    pg8::Gemm g{(const bf16_t*)F_HQ, (const bf16_t*)(F_WGUQ + (size_t)layer * NE * 2816 * D), YROWS, NE * 2816, D / 2}; SchedMoe1 S{F.G, F.blk, (layer < DEPTH - 1) ? 1 : 0};
    EpiMoe1 E{F_HID, F_SW + (size_t)layer * NE * 2816, F_SAY};
    pg8::gemm_phase_gather_i8<EpiMoe1, SchedMoe1, true, true>(F.lds, g, S, E, F.tid, F_ROFF);
}
__device__ __forceinline__ void g_moe2(const Frame& F, int layer) {
    pg8::Gemm g{F_HID, F_WD + (size_t)layer * NE * D * DE, YROWS, NE * D, DE}; SchedMoe2 S{F.G, F.blk, (layer < DEPTH - 1) ? 1 : 0};
    EpiMoe2 E{F_Y, F_GATE};
    pg8::gemm_phase<EpiMoe2, SchedMoe2, true, true>(F.lds, g, S, E, F.tid);
}
}

#ifndef PROBE_MASK
#define PROBE_MASK 0
#endif
#ifndef PROBE_GEMM
#define PROBE_GEMM 0
#endif
#ifndef PROBE_P4
#define PROBE_P4 0
#endif
#ifndef PROBE_ROW
#define PROBE_ROW 0
#endif
#ifndef PROBE_TMASK
#define PROBE_TMASK 0
#endif
#ifndef MK_PER_PHASE
#define MK_PER_PHASE 0
#endif
constexpr int N_PHASES = 1 + 10 * mk::DEPTH + 1;
struct Args { const float* in[29]; float* out; unsigned char* ws; int ph_lo, ph_hi; };

__global__ void __launch_bounds__(512, 2) mk_fwd(Args args) {
    using namespace mk;
    extern __shared__ __attribute__((aligned(16))) unsigned char lds_raw[];
    Frame F0;
    F0.lds = (LAS unsigned char*)lds_raw;
    F0.tid = threadIdx.x; F0.lane = F0.tid & 63; F0.wave = __builtin_amdgcn_readfirstlane(F0.tid >> 6); F0.G = gridDim.x; F0.blk = blockIdx.x;
    const int wave0 = F0.wave;
    volatile LAS unsigned* MISC = (volatile LAS unsigned*)(F0.lds + MISC_OFF);
    for (int u = F0.tid; u < (LDS_BYTES - MISC_OFF) / 4; u += NTHREADS) MISC[u] = 0u;
    __syncthreads();
    XcdBarrier bar; bar.bar = F_CTL + CW_BAR; bar.x = 0; bar.st = nullptr;
    if (!MK_PER_PHASE) bar = xcd_barrier_post(F_CTL + CW_BAR, MISC + 8);

    const int lo = args.ph_lo, hi = args.ph_hi;
    int ph = 0;
    unsigned long long tacc = 0, tph0 = 0; int pcl = 0;
#define PCL(c) pcl = (c);
#define PH_BEGIN if (PROBE_TMASK) tph0 = __builtin_amdgcn_s_memrealtime(); if (ph >= lo && ph < hi) { Frame F; F.lds = (LAS unsigned char*)lds_raw; F.G = gridDim.x; F.blk = blockIdx.x; F.wave = wave0; \
        F.lane = mk::lane_id_v(); asm volatile("" : "+s"(F.G), "+s"(F.blk), "+s"(F.wave)); F.tid = F.wave * 64 + F.lane;
#define PH_END   if (!MK_PER_PHASE && ph + 1 < hi) xcd_barrier(bar); else __syncthreads(); } ++ph; if (PROBE_TMASK && ((PROBE_TMASK >> pcl) & 1)) tacc += __builtin_amdgcn_s_memrealtime() - tph0;

    PCL(0) PH_BEGIN p0_prologue(F); PH_END
    if (PROBE_MASK & 128) { --ph; PH_BEGIN p0_prologue(F); PH_END }
    for (int layer = 0; layer < DEPTH; ++layer) {
        if (PROBE_MASK & 4096) { for (int e_ = 0; e_ < 8; ++e_) { --ph; PH_BEGIN PH_END } ++ph; --ph; }
        PCL(1) PH_BEGIN p1_norm1(F, layer, 0); PH_END
        if (PROBE_MASK & 2048) { --ph; PH_BEGIN p1_norm1(F, layer, 1); PH_END }
        PCL(2) PH_BEGIN g_inproj(F, layer); PH_END
        if (PROBE_GEMM || (PROBE_MASK & 16)) { --ph; PH_BEGIN g_inproj(F, layer); PH_END }
        PCL(3) PH_BEGIN p3_conv(F, layer); PH_END
        if (PROBE_ROW || (PROBE_MASK & 1)) { --ph; PH_BEGIN p3_conv(F, layer); PH_END }
        PCL(4) PH_BEGIN p4_mixer(F, layer, 0); PH_END
        if (PROBE_P4) { --ph; PH_BEGIN p4_mixer(F, layer, 1); PH_END }
        PCL(5) PH_BEGIN p5_ssd_post(F, layer); PH_END
        if (PROBE_ROW || (PROBE_MASK & 2)) { --ph; PH_BEGIN p5_ssd_post(F, layer); PH_END }
        PCL(6) PH_BEGIN g_outproj(F, layer, 1.f); PH_END
        if (PROBE_MASK & 1024) { --ph; PH_BEGIN g_outproj(F, layer, 0.f); PH_END }
        PCL(7) PH_BEGIN p7_norm2(F, layer); PH_END
        if (PROBE_ROW || (PROBE_MASK & 4)) { --ph; PH_BEGIN p7_norm2(F, layer); PH_END }
        PCL(8) PH_BEGIN p8_topk(F, layer); PH_END
        if (PROBE_ROW || (PROBE_MASK & 8)) { --ph; PH_BEGIN p8_topk(F, layer); PH_END }
        PCL(9) PH_BEGIN g_moe1(F, layer); PH_END
        if (PROBE_GEMM || (PROBE_MASK & 32)) { --ph; PH_BEGIN g_moe1(F, layer); PH_END }
        PCL(10) PH_BEGIN g_moe2(F, layer); PH_END
        if (PROBE_GEMM || (PROBE_MASK & 64)) { --ph; PH_BEGIN g_moe2(F, layer); PH_END }
    }
    PCL(11) PH_BEGIN p1_norm1(F, DEPTH, 0); PH_END
#undef PH_BEGIN
#undef PH_END
    if (PROBE_TMASK && blockIdx.x == 0) { const unsigned long long te = __builtin_amdgcn_s_memrealtime(); while (__builtin_amdgcn_s_memrealtime() - te < 9ull * tacc) __builtin_amdgcn_s_sleep(8); }
}

extern "C" void kernel_launch(void* const* d_in, const int* in_sizes, int n_in, void* d_out, int out_size, void* d_ws, size_t ws_size, hipStream_t stream) {
    static int grid = 0;
    if (grid == 0) {
        if (n_in != 29 || out_size != mk::NL * mk::D || ws_size < mk::WS_END) { fprintf(stderr, "kernel_launch: unexpected shapes: n_in %d out %d ws %zu (need %zu)\n", n_in, out_size, ws_size, (size_t)mk::WS_END); grid = -1; return; }
        int dev = 0, cus = 0, per_cu = 0;
        if (hipGetDevice(&dev) != hipSuccess || hipDeviceGetAttribute(&cus, hipDeviceAttributeMultiprocessorCount, dev) != hipSuccess) { grid = -1; return; }
        if (hipFuncSetAttribute((const void*)mk_fwd, hipFuncAttributeMaxDynamicSharedMemorySize, mk::LDS_BYTES) != hipSuccess) { fprintf(stderr, "kernel_launch: hipFuncSetAttribute failed\n"); grid = -1; return; }
        if (hipOccupancyMaxActiveBlocksPerMultiprocessor(&per_cu, (const void*)mk_fwd, mk::NTHREADS, mk::LDS_BYTES) != hipSuccess || per_cu < 1) { fprintf(stderr, "kernel_launch: occupancy query says %d\n", per_cu); }
        (void)hipGetLastError();
        grid = cus;
    }
    if (grid < 0) return;
    (void)hipMemsetAsync((char*)d_ws + mk::WS_CTL, 0, mk::CTL_ZERO_BYTES, stream);
    Args a{};
    for (int i = 0; i < 29; ++i) a.in[i] = (const float*)d_in[i];
    a.out = (float*)d_out; a.ws = (unsigned char*)d_ws;
#if MK_PER_PHASE
    for (int p = 0; p < N_PHASES; ++p) { a.ph_lo = p; a.ph_hi = p + 1; hipLaunchKernelGGL(mk_fwd, dim3(grid), dim3(mk::NTHREADS), mk::LDS_BYTES, stream, a); }
#else
    a.ph_lo = 0; a.ph_hi = N_PHASES;
    hipLaunchKernelGGL(mk_fwd, dim3(grid), dim3(mk::NTHREADS), mk::LDS_BYTES, stream, a);
#endif
}
```

```cpp
#include <hip/hip_runtime.h>
#include <cstdio>
#include <cstdint>
#include <cmath>

#define LAS __attribute__((address_space(3)))
#define GAS __attribute__((address_space(1)))

namespace pg8 {
#define PG8_LAS __attribute__((address_space(3)))
typedef unsigned short bf16_t;
typedef short bf16x8 __attribute__((ext_vector_type(8)));
typedef float f32x4 __attribute__((ext_vector_type(4)));
typedef unsigned u32x4 __attribute__((ext_vector_type(4)));
typedef int i32x4 __attribute__((ext_vector_type(4)));
constexpr int BM = 256, BK = 64, HALF = 128, HTB = HALF * BK * 2  , STAGE_BYTES = 8 * HTB, NXCD = 8, WGM = 8;

__host__ __device__ __forceinline__ int lds_byte(int r, int c) { const int st = (r >> 4) * 2 + (c >> 5), rr = r & 15, cc = c & 31, ob = rr * 64 + cc * 2; return st * 1024 + (ob ^ (((ob >> 9) & 1) << 5)); }
__host__ __device__ __forceinline__ void stage_rc(int b, int& R, int& C) { const int st = b / 1024, sb = b % 1024, swz = sb ^ (((sb >> 9) & 1) << 5); R = (st >> 1) * 16 + swz / 64; C = (st & 1) * 32 + (swz % 64) / 2; }
__host__ __device__ __forceinline__ int perm32(int rho) { const int n = rho >> 4, i = rho & 15; return 8 * (i >> 2) + 4 * n + (i & 3); }

struct Unit { int pm, pn; };
struct Gemm { const bf16_t* A; const bf16_t* Bt; int M, N, K; };

struct StaticOrder {
    int nM, nN, nwg, G, c;
    __host__ __device__ void init(int M, int N, int G_, int c_) { nM = M / BM; nN = N / BM; nwg = nM * nN; G = G_; c = c_; }
    __host__ __device__ bool next(int i, Unit& u) const {
        const long L = (long)i * G + c; if (L >= nwg) return false;
        int wgid = (int)L; { const int q = nwg / NXCD, r = nwg % NXCD, xcd = wgid % NXCD, off = wgid / NXCD; wgid = (xcd < r ? xcd * (q + 1) : r * (q + 1) + (xcd - r) * q) + off; }
        const int nig = WGM * nN, gid = wgid / nig, fm = gid * WGM, gsz = (nM - fm) < WGM ? (nM - fm) : WGM;
        u.pm = fm + ((wgid % nig) % gsz); u.pn = (wgid % nig) / gsz; return true;
    }
    __device__ __forceinline__ void a_ready(const Unit&) const {}
    __device__ __forceinline__ void done(const Unit&) const {}
};

template <class Epi, class Sched, bool ALIGN_EPI = false, bool SP2 = false>
__device__ __forceinline__ void gemm_phase(PG8_LAS unsigned char* lds, const Gemm g, const Sched& S, const Epi& E, const int tid_arg) {
    int tid_ = tid_arg; asm volatile("" : "+v"(tid_));
    const int tid = tid_, wid = __builtin_amdgcn_readfirstlane(tid >> 6), lane = tid & 63, wr = wid >> 2, wc = wid & 3, fr = lane & 15, fq = lane >> 4;
    const int K = g.K, nt = K / BK;
    unsigned voffA[2], voffB[2];
#pragma unroll
    for (int i = 0; i < 2; ++i) { int R, C; stage_rc(tid * 16 + i * 8192, R, C); const int Rb = Epi::PERM ? ((R & ~31) + perm32(R & 31)) : R;
        voffA[i] = (unsigned)(R * K + C) * 2u; voffB[i] = (unsigned)(Rb * K + C) * 2u; }
    const size_t kstep = (size_t)(BK * 2);
    const size_t hstep = (size_t)HALF * K * 2;
    const size_t tstep = 2 * hstep;
    const unsigned ldsw = (unsigned)wid * 1024u;
    const int aoff = lds_byte(wr * 64 + fr, fq * 8), boff = lds_byte(wc * 32 + fr, fq * 8);
#define PG8_SA(b, h) (((b) * 2 + (h)) * HTB)
#define PG8_SB(b, h) ((4 + (b) * 2 + (h)) * HTB)
#define PG8_STAGE(bufoff, gbase, voff) do { _Pragma("unroll") for (int _i = 0; _i < 2; ++_i) \
        __builtin_amdgcn_global_load_lds((const unsigned*)((const char*)(gbase) + (voff)[_i]), (PG8_LAS unsigned*)(lds + (bufoff) + ldsw + _i * 8192), 16, 0, 0); } while (0)
#define PG8_LDA(dst, b, h) do { _Pragma("unroll") for (int m = 0; m < 4; ++m) _Pragma("unroll") for (int k = 0; k < 2; ++k) dst[m][k] = *(const PG8_LAS bf16x8*)(lds + PG8_SA(b, h) + aoff + m * 2048 + k * 1024); } while (0)
#define PG8_LDB(dst, b, h) do { _Pragma("unroll") for (int n = 0; n < 2; ++n) _Pragma("unroll") for (int k = 0; k < 2; ++k) dst[n][k] = *(const PG8_LAS bf16x8*)(lds + PG8_SB(b, h) + boff + n * 2048 + k * 1024); } while (0)
#define PG8_MMA(ai, bj, At, Bt) do { __builtin_amdgcn_s_setprio(1); _Pragma("unroll") for (int m = 0; m < 4; ++m) _Pragma("unroll") for (int n = 0; n < 2; ++n) _Pragma("unroll") for (int k = 0; k < 2; ++k) \
        acc[ai][bj][m][n] = __builtin_amdgcn_mfma_f32_16x16x32_bf16(Bt[n][k], At[m][k], acc[ai][bj][m][n], 0, 0, 0); __builtin_amdgcn_s_setprio(0); } while (0)
#define PG8_WAIT_V(n) asm volatile("s_waitcnt vmcnt(" #n ")" ::: "memory")
#define PG8_WAIT_L(n) asm volatile("s_waitcnt lgkmcnt(" #n ")" ::: "memory")
#define PG8_BAR __builtin_amdgcn_s_barrier()
#define PG8_SCHED __builtin_amdgcn_sched_barrier(0)
    Unit cur, nxt; int ui = 0;
    if (!S.next(0, cur)) return;
    f32x4 acc[2][2][4][2];
#pragma unroll
    for (int a = 0; a < 2; ++a)
#pragma unroll
        for (int b = 0; b < 2; ++b)
#pragma unroll
            for (int m = 0; m < 4; ++m)
#pragma unroll
                for (int n = 0; n < 2; ++n) acc[a][b][m][n] = (f32x4){0.f, 0.f, 0.f, 0.f};
    bf16x8 At[4][2], B0[2][2], B1[2][2];
    const char* cA = (const char*)g.A + (size_t)cur.pm * tstep; const char* cB = (const char*)g.Bt + (size_t)cur.pn * tstep;
    S.a_ready(cur);
    if constexpr (SP2) {
        PG8_STAGE(PG8_SB(0, 0), cB, voffB); PG8_STAGE(PG8_SB(0, 1), cB + hstep, voffB); PG8_STAGE(PG8_SA(0, 0), cA, voffA); PG8_STAGE(PG8_SA(0, 1), cA + hstep, voffA);
        if (wr == 1) PG8_BAR;
        PG8_WAIT_V(2); PG8_BAR;
        PG8_STAGE(PG8_SB(1, 0), cB + kstep, voffB); PG8_STAGE(PG8_SA(1, 0), cA + kstep, voffA); PG8_STAGE(PG8_SB(1, 1), cB + hstep + kstep, voffB);
        PG8_WAIT_V(6); PG8_BAR;
    } else {
        PG8_STAGE(PG8_SB(0, 0), cB, voffB); PG8_STAGE(PG8_SA(0, 0), cA, voffA); PG8_STAGE(PG8_SB(0, 1), cB + hstep, voffB); PG8_STAGE(PG8_SA(0, 1), cA + hstep, voffA);
        if (wr == 1) PG8_BAR;
        PG8_WAIT_V(4); PG8_BAR;
        PG8_STAGE(PG8_SB(1, 0), cB + kstep, voffB); PG8_STAGE(PG8_SA(1, 0), cA + kstep, voffA); PG8_STAGE(PG8_SB(1, 1), cB + hstep + kstep, voffB);
        PG8_WAIT_V(6); PG8_BAR;
    }
    for (;;) {
        const bool has_next = S.next(ui + 1, nxt);
        const char* nA = has_next ? (const char*)g.A + (size_t)nxt.pm * tstep : cA; const char* nB = has_next ? (const char*)g.Bt + (size_t)nxt.pn * tstep : cB;
        for (int t = 0; t < nt; t += 2) {
            const bool last = (t == nt - 2);
            const char* a1 = cA + (size_t)(t + 1) * kstep;
            const char* a2 = last ? nA : cA + (size_t)(t + 2) * kstep; const char* b2 = last ? nB : cB + (size_t)(t + 2) * kstep;
            const char* a3 = a2 + kstep; const char* b3 = b2 + kstep;
            if (last && has_next) S.a_ready(nxt);
            if constexpr (SP2) {
            PG8_LDB(B0, 0, 0); PG8_LDB(B1, 0, 1); PG8_SCHED; PG8_LDA(At, 0, 0); PG8_STAGE(PG8_SA(1, 1), a1 + hstep, voffA);
            PG8_WAIT_V(8); PG8_WAIT_L(0); PG8_BAR; PG8_MMA(0, 0, At, B0); PG8_MMA(0, 1, At, B1); PG8_BAR; PG8_SCHED;
            PG8_LDA(At, 0, 1); PG8_STAGE(PG8_SB(0, 0), b2, voffB); PG8_STAGE(PG8_SB(0, 1), b2 + hstep, voffB); PG8_STAGE(PG8_SA(0, 0), a2, voffA);
            PG8_WAIT_V(8); PG8_WAIT_L(0); PG8_BAR; PG8_MMA(1, 0, At, B0); PG8_MMA(1, 1, At, B1); PG8_BAR; PG8_SCHED;
            PG8_LDB(B0, 1, 0); PG8_LDB(B1, 1, 1); PG8_SCHED; PG8_LDA(At, 1, 0); PG8_STAGE(PG8_SA(0, 1), a2 + hstep, voffA);
            PG8_WAIT_V(8); PG8_WAIT_L(0); PG8_BAR; PG8_MMA(0, 0, At, B0); PG8_MMA(0, 1, At, B1); PG8_BAR; PG8_SCHED;
            PG8_LDA(At, 1, 1); PG8_STAGE(PG8_SB(1, 0), b3, voffB); PG8_STAGE(PG8_SB(1, 1), b3 + hstep, voffB); PG8_STAGE(PG8_SA(1, 0), a3, voffA);
            PG8_WAIT_V(8); PG8_WAIT_L(0); PG8_BAR; PG8_MMA(1, 0, At, B0); PG8_MMA(1, 1, At, B1); PG8_BAR; PG8_SCHED;
            } else {
            PG8_LDB(B0, 0, 0); PG8_SCHED; PG8_LDA(At, 0, 0); PG8_STAGE(PG8_SA(1, 1), a1 + hstep, voffA);
            PG8_WAIT_L(8); PG8_BAR; PG8_WAIT_L(0); PG8_MMA(0, 0, At, B0); PG8_BAR; PG8_SCHED;
            PG8_LDB(B1, 0, 1); PG8_STAGE(PG8_SB(0, 0), b2, voffB);
            PG8_BAR; PG8_WAIT_L(0); PG8_MMA(0, 1, At, B1); PG8_BAR;
            PG8_LDA(At, 0, 1); PG8_STAGE(PG8_SA(0, 0), a2, voffA);
            PG8_BAR; PG8_WAIT_L(0); PG8_MMA(1, 0, At, B0); PG8_BAR; PG8_SCHED;
            PG8_STAGE(PG8_SB(0, 1), b2 + hstep, voffB);
            PG8_WAIT_V(6); PG8_BAR; PG8_MMA(1, 1, At, B1); PG8_BAR;
            PG8_LDB(B0, 1, 0); PG8_SCHED; PG8_LDA(At, 1, 0); PG8_STAGE(PG8_SA(0, 1), a2 + hstep, voffA);
            PG8_WAIT_L(8); PG8_BAR; PG8_WAIT_L(0); PG8_MMA(0, 0, At, B0); PG8_BAR; PG8_SCHED;
            PG8_LDB(B1, 1, 1); PG8_STAGE(PG8_SB(1, 0), b3, voffB);
            PG8_BAR; PG8_WAIT_L(0); PG8_MMA(0, 1, At, B1); PG8_BAR;
            PG8_LDA(At, 1, 1); PG8_STAGE(PG8_SA(1, 0), a3, voffA);
            PG8_BAR; PG8_WAIT_L(0); PG8_MMA(1, 0, At, B0); PG8_BAR; PG8_SCHED;
            PG8_STAGE(PG8_SB(1, 1), b3 + hstep, voffB);
            PG8_WAIT_V(6); PG8_BAR; PG8_MMA(1, 1, At, B1); PG8_BAR;
            }
        }
        if constexpr (ALIGN_EPI) { if (wr == 0) PG8_BAR; }
        if constexpr (!Epi::AFTER_DRAIN) { E(acc, cur, wr, wc, fr, fq); S.done(cur); }
        if (!has_next) break;
#pragma unroll
        for (int a = 0; a < 2; ++a)
#pragma unroll
            for (int b = 0; b < 2; ++b)
#pragma unroll
                for (int m = 0; m < 4; ++m)
#pragma unroll
                    for (int n = 0; n < 2; ++n) acc[a][b][m][n] = (f32x4){0.f, 0.f, 0.f, 0.f};
        cur = nxt; cA = nA; cB = nB; ++ui;
        if constexpr (ALIGN_EPI) { if (wr == 1) PG8_BAR; }
    }
    PG8_WAIT_V(0);
    if constexpr (!ALIGN_EPI) { if (wr == 0) PG8_BAR; }
    PG8_BAR;
    if constexpr (Epi::AFTER_DRAIN) { E.fused(acc, cur, wr, wc, fr, fq, lds, wid, lane); S.done(cur); }
#undef PG8_SA
#undef PG8_SB
#undef PG8_STAGE
#undef PG8_LDA
#undef PG8_LDB
#undef PG8_MMA
#undef PG8_WAIT_V
#undef PG8_WAIT_L
#undef PG8_BAR
#undef PG8_SCHED
}template <class Epi, class Sched, bool ALIGN_EPI = false, bool SP2 = false>
__device__ __forceinline__ void gemm_phase_gather(PG8_LAS unsigned char* lds, const Gemm g, const Sched& S, const Epi& E, const int tid_arg, const unsigned* __restrict__ rowoff) {
    int tid_ = tid_arg; asm volatile("" : "+v"(tid_));
    const int tid = tid_, wid = __builtin_amdgcn_readfirstlane(tid >> 6), lane = tid & 63, wr = wid >> 2, wc = wid & 3, fr = lane & 15, fq = lane >> 4;
    const int K = g.K, nt = K / BK;
    unsigned voffA[2], voffB[2]; int rA[2]; unsigned cAoff[2];
#pragma unroll
    for (int i = 0; i < 2; ++i) { int R, C; stage_rc(tid * 16 + i * 8192, R, C); const int Rb = Epi::PERM ? ((R & ~31) + perm32(R & 31)) : R;
        voffA[i] = (unsigned)(R * K + C) * 2u; voffB[i] = (unsigned)(Rb * K + C) * 2u; rA[i] = R; cAoff[i] = (unsigned)C * 2u; }
    const size_t kstep = (size_t)(BK * 2);
    const size_t hstep = (size_t)HALF * K * 2;
    const size_t tstep = 2 * hstep;
    const unsigned ldsw = (unsigned)wid * 1024u;
    const int aoff = lds_byte(wr * 64 + fr, fq * 8), boff = lds_byte(wc * 32 + fr, fq * 8);
#define PG8_SA(b, h) (((b) * 2 + (h)) * HTB)
#define PG8_SB(b, h) ((4 + (b) * 2 + (h)) * HTB)
#define PG8_STAGE(bufoff, gbase, voff) do { _Pragma("unroll") for (int _i = 0; _i < 2; ++_i) \
        __builtin_amdgcn_global_load_lds((const unsigned*)((const char*)(gbase) + (voff)[_i]), (PG8_LAS unsigned*)(lds + (bufoff) + ldsw + _i * 8192), 16, 0, 0); } while (0)
#define PG8_LDA(dst, b, h) do { _Pragma("unroll") for (int m = 0; m < 4; ++m) _Pragma("unroll") for (int k = 0; k < 2; ++k) dst[m][k] = *(const PG8_LAS bf16x8*)(lds + PG8_SA(b, h) + aoff + m * 2048 + k * 1024); } while (0)
#define PG8_LDB(dst, b, h) do { _Pragma("unroll") for (int n = 0; n < 2; ++n) _Pragma("unroll") for (int k = 0; k < 2; ++k) dst[n][k] = *(const PG8_LAS bf16x8*)(lds + PG8_SB(b, h) + boff + n * 2048 + k * 1024); } while (0)
#define PG8_MMA(ai, bj, At, Bt) do { __builtin_amdgcn_s_setprio(1); _Pragma("unroll") for (int m = 0; m < 4; ++m) _Pragma("unroll") for (int n = 0; n < 2; ++n) _Pragma("unroll") for (int k = 0; k < 2; ++k) \
        acc[ai][bj][m][n] = __builtin_amdgcn_mfma_f32_16x16x32_bf16(Bt[n][k], At[m][k], acc[ai][bj][m][n], 0, 0, 0); __builtin_amdgcn_s_setprio(0); } while (0)
#define PG8_WAIT_V(n) asm volatile("s_waitcnt vmcnt(" #n ")" ::: "memory")
#define PG8_WAIT_L(n) asm volatile("s_waitcnt lgkmcnt(" #n ")" ::: "memory")
#define PG8_BAR __builtin_amdgcn_s_barrier()
#define PG8_SCHED __builtin_amdgcn_sched_barrier(0)
    Unit cur, nxt; int ui = 0;
    if (!S.next(0, cur)) return;
    f32x4 acc[2][2][4][2];
#pragma unroll
    for (int a = 0; a < 2; ++a)
#pragma unroll
        for (int b = 0; b < 2; ++b)
#pragma unroll
            for (int m = 0; m < 4; ++m)
#pragma unroll
                for (int n = 0; n < 2; ++n) acc[a][b][m][n] = (f32x4){0.f, 0.f, 0.f, 0.f};
    bf16x8 At[4][2], B0[2][2], B1[2][2];
    const char* cA = (const char*)g.A; const char* cB = (const char*)g.Bt + (size_t)cur.pn * tstep;
    unsigned v0[2], v1[2], n0[2], n1[2];
#define PG8_LOADOFF(D0, D1, PM) do { _Pragma("unroll") for (int _i = 0; _i < 2; ++_i) { D0[_i] = rowoff[256 * (PM) + rA[_i]] + cAoff[_i]; D1[_i] = rowoff[256 * (PM) + 128 + rA[_i]] + cAoff[_i]; } } while (0)
    PG8_LOADOFF(v0, v1, cur.pm);
#pragma unroll
    for (int _i = 0; _i < 2; ++_i) { n0[_i] = v0[_i]; n1[_i] = v1[_i]; }
    S.a_ready(cur);
    if constexpr (SP2) {
        PG8_STAGE(PG8_SB(0, 0), cB, voffB); PG8_STAGE(PG8_SB(0, 1), cB + hstep, voffB); PG8_STAGE(PG8_SA(0, 0), cA, v0); PG8_STAGE(PG8_SA(0, 1), cA, v1);
        if (wr == 1) PG8_BAR;
        PG8_WAIT_V(2); PG8_BAR;
        PG8_STAGE(PG8_SB(1, 0), cB + kstep, voffB); PG8_STAGE(PG8_SA(1, 0), cA + kstep, v0); PG8_STAGE(PG8_SB(1, 1), cB + hstep + kstep, voffB);
        PG8_WAIT_V(6); PG8_BAR;
    } else {
        PG8_STAGE(PG8_SB(0, 0), cB, voffB); PG8_STAGE(PG8_SA(0, 0), cA, v0); PG8_STAGE(PG8_SB(0, 1), cB + hstep, voffB); PG8_STAGE(PG8_SA(0, 1), cA, v1);
        if (wr == 1) PG8_BAR;
        PG8_WAIT_V(4); PG8_BAR;
        PG8_STAGE(PG8_SB(1, 0), cB + kstep, voffB); PG8_STAGE(PG8_SA(1, 0), cA + kstep, v0); PG8_STAGE(PG8_SB(1, 1), cB + hstep + kstep, voffB);
        PG8_WAIT_V(6); PG8_BAR;
    }
    for (;;) {
        const bool has_next = S.next(ui + 1, nxt);
        if (has_next) PG8_LOADOFF(n0, n1, nxt.pm);
        const char* nA = cA; const char* nB = has_next ? (const char*)g.Bt + (size_t)nxt.pn * tstep : cB;
        for (int t = 0; t < nt; t += 2) {
            const bool last = (t == nt - 2);
            const char* a1 = cA + (size_t)(t + 1) * kstep;
            const char* a2 = last ? nA : cA + (size_t)(t + 2) * kstep; const char* b2 = last ? nB : cB + (size_t)(t + 2) * kstep;
            const char* a3 = a2 + kstep; const char* b3 = b2 + kstep;
            unsigned o2a[2], o2b[2];
#pragma unroll
            for (int _i = 0; _i < 2; ++_i) { o2a[_i] = last ? n0[_i] : v0[_i]; o2b[_i] = last ? n1[_i] : v1[_i]; }
            if (last && has_next) S.a_ready(nxt);
            if constexpr (SP2) {
            PG8_LDB(B0, 0, 0); PG8_LDB(B1, 0, 1); PG8_SCHED; PG8_LDA(At, 0, 0); PG8_STAGE(PG8_SA(1, 1), a1, v1);
            PG8_WAIT_V(8); PG8_WAIT_L(0); PG8_BAR; PG8_MMA(0, 0, At, B0); PG8_MMA(0, 1, At, B1); PG8_BAR; PG8_SCHED;
            PG8_LDA(At, 0, 1); PG8_STAGE(PG8_SB(0, 0), b2, voffB); PG8_STAGE(PG8_SB(0, 1), b2 + hstep, voffB); PG8_STAGE(PG8_SA(0, 0), a2, o2a);
            PG8_WAIT_V(8); PG8_WAIT_L(0); PG8_BAR; PG8_MMA(1, 0, At, B0); PG8_MMA(1, 1, At, B1); PG8_BAR; PG8_SCHED;
            PG8_LDB(B0, 1, 0); PG8_LDB(B1, 1, 1); PG8_SCHED; PG8_LDA(At, 1, 0); PG8_STAGE(PG8_SA(0, 1), a2, o2b);
            PG8_WAIT_V(8); PG8_WAIT_L(0); PG8_BAR; PG8_MMA(0, 0, At, B0); PG8_MMA(0, 1, At, B1); PG8_BAR; PG8_SCHED;
            PG8_LDA(At, 1, 1); PG8_STAGE(PG8_SB(1, 0), b3, voffB); PG8_STAGE(PG8_SB(1, 1), b3 + hstep, voffB); PG8_STAGE(PG8_SA(1, 0), a3, o2a);
            PG8_WAIT_V(8); PG8_WAIT_L(0); PG8_BAR; PG8_MMA(1, 0, At, B0); PG8_MMA(1, 1, At, B1); PG8_BAR; PG8_SCHED;
            } else {
            PG8_LDB(B0, 0, 0); PG8_SCHED; PG8_LDA(At, 0, 0); PG8_STAGE(PG8_SA(1, 1), a1, v1);
            PG8_WAIT_L(8); PG8_BAR; PG8_WAIT_L(0); PG8_MMA(0, 0, At, B0); PG8_BAR; PG8_SCHED;
            PG8_LDB(B1, 0, 1); PG8_STAGE(PG8_SB(0, 0), b2, voffB);
            PG8_BAR; PG8_WAIT_L(0); PG8_MMA(0, 1, At, B1); PG8_BAR;
            PG8_LDA(At, 0, 1); PG8_STAGE(PG8_SA(0, 0), a2, o2a);
            PG8_BAR; PG8_WAIT_L(0); PG8_MMA(1, 0, At, B0); PG8_BAR; PG8_SCHED;
            PG8_STAGE(PG8_SB(0, 1), b2 + hstep, voffB);
            PG8_WAIT_V(6); PG8_BAR; PG8_MMA(1, 1, At, B1); PG8_BAR;
            PG8_LDB(B0, 1, 0); PG8_SCHED; PG8_LDA(At, 1, 0); PG8_STAGE(PG8_SA(0, 1), a2, o2b);
            PG8_WAIT_L(8); PG8_BAR; PG8_WAIT_L(0); PG8_MMA(0, 0, At, B0); PG8_BAR; PG8_SCHED;
            PG8_LDB(B1, 1, 1); PG8_STAGE(PG8_SB(1, 0), b3, voffB);
            PG8_BAR; PG8_WAIT_L(0); PG8_MMA(0, 1, At, B1); PG8_BAR;
            PG8_LDA(At, 1, 1); PG8_STAGE(PG8_SA(1, 0), a3, o2a);
            PG8_BAR; PG8_WAIT_L(0); PG8_MMA(1, 0, At, B0); PG8_BAR; PG8_SCHED;
            PG8_STAGE(PG8_SB(1, 1), b3 + hstep, voffB);
            PG8_WAIT_V(6); PG8_BAR; PG8_MMA(1, 1, At, B1); PG8_BAR;
            }
        }
        if constexpr (ALIGN_EPI) { if (wr == 0) PG8_BAR; }
        if constexpr (!Epi::AFTER_DRAIN) { E(acc, cur, wr, wc, fr, fq); S.done(cur); }
        if (!has_next) break;
#pragma unroll
        for (int a = 0; a < 2; ++a)
#pragma unroll
            for (int b = 0; b < 2; ++b)
#pragma unroll
                for (int m = 0; m < 4; ++m)
#pragma unroll
                    for (int n = 0; n < 2; ++n) acc[a][b][m][n] = (f32x4){0.f, 0.f, 0.f, 0.f};
        cur = nxt; cA = nA; cB = nB; ++ui;
#pragma unroll
        for (int _i = 0; _i < 2; ++_i) { v0[_i] = n0[_i]; v1[_i] = n1[_i]; }
        if constexpr (ALIGN_EPI) { if (wr == 1) PG8_BAR; }
    }
    PG8_WAIT_V(0);
    if constexpr (!ALIGN_EPI) { if (wr == 0) PG8_BAR; }
    PG8_BAR;
    if constexpr (Epi::AFTER_DRAIN) { E.fused(acc, cur, wr, wc, fr, fq, lds, wid, lane); S.done(cur); }
#undef PG8_LOADOFF
#undef PG8_SA
#undef PG8_SB
#undef PG8_STAGE
#undef PG8_LDA
#undef PG8_LDB
#undef PG8_MMA
#undef PG8_WAIT_V
#undef PG8_WAIT_L
#undef PG8_BAR
#undef PG8_SCHED
}template <class Epi, class Sched, bool ALIGN_EPI = false, bool SP2 = false>
__device__ __forceinline__ void gemm_phase_gather_i8(PG8_LAS unsigned char* lds, const Gemm g, const Sched& S, const Epi& E, const int tid_arg, const unsigned* __restrict__ rowoff) {
    int tid_ = tid_arg; asm volatile("" : "+v"(tid_));
    const int tid = tid_, wid = __builtin_amdgcn_readfirstlane(tid >> 6), lane = tid & 63, wr = wid >> 2, wc = wid & 3, fr = lane & 15, fq = lane >> 4;
    const int K = g.K, nt = K / BK;
    unsigned voffA[2], voffB[2]; int rA[2]; unsigned cAoff[2];
#pragma unroll
    for (int i = 0; i < 2; ++i) { int R, C; stage_rc(tid * 16 + i * 8192, R, C); const int Rb = Epi::PERM ? ((R & ~31) + perm32(R & 31)) : R;
        voffA[i] = (unsigned)(R * K + C) * 2u; voffB[i] = (unsigned)(Rb * K + C) * 2u; rA[i] = R; cAoff[i] = (unsigned)C * 2u; }
    const size_t kstep = (size_t)(BK * 2);
    const size_t hstep = (size_t)HALF * K * 2;
    const size_t tstep = 2 * hstep;
    const unsigned ldsw = (unsigned)wid * 1024u;
    const int aoff = lds_byte(wr * 64 + fr, fq * 8), boff = lds_byte(wc * 32 + fr, fq * 8);
#define PG8_SA(b, h) (((b) * 2 + (h)) * HTB)
#define PG8_SB(b, h) ((4 + (b) * 2 + (h)) * HTB)
#define PG8_STAGE(bufoff, gbase, voff) do { _Pragma("unroll") for (int _i = 0; _i < 2; ++_i) \
        __builtin_amdgcn_global_load_lds((const unsigned*)((const char*)(gbase) + (voff)[_i]), (PG8_LAS unsigned*)(lds + (bufoff) + ldsw + _i * 8192), 16, 0, 0); } while (0)
#define PG8_LDA(dst, b, h) do { _Pragma("unroll") for (int m = 0; m < 4; ++m) _Pragma("unroll") for (int k = 0; k < 2; ++k) dst[m][k] = *(const PG8_LAS bf16x8*)(lds + PG8_SA(b, h) + aoff + m * 2048 + k * 1024); } while (0)
#define PG8_LDB(dst, b, h) do { _Pragma("unroll") for (int n = 0; n < 2; ++n) _Pragma("unroll") for (int k = 0; k < 2; ++k) dst[n][k] = *(const PG8_LAS bf16x8*)(lds + PG8_SB(b, h) + boff + n * 2048 + k * 1024); } while (0)
#define PG8_MMA(ai, bj, At, Bt) do { __builtin_amdgcn_s_setprio(1); _Pragma("unroll") for (int m = 0; m < 4; ++m) _Pragma("unroll") for (int n = 0; n < 2; ++n) _Pragma("unroll") for (int k = 0; k < 2; ++k) \
        acc[ai][bj][m][n] = __builtin_amdgcn_mfma_i32_16x16x64_i8(__builtin_bit_cast(i32x4, Bt[n][k]), __builtin_bit_cast(i32x4, At[m][k]), acc[ai][bj][m][n], 0, 0, 0); __builtin_amdgcn_s_setprio(0); } while (0)
#define PG8_WAIT_V(n) asm volatile("s_waitcnt vmcnt(" #n ")" ::: "memory")
#define PG8_WAIT_L(n) asm volatile("s_waitcnt lgkmcnt(" #n ")" ::: "memory")
#define PG8_BAR __builtin_amdgcn_s_barrier()
#define PG8_SCHED __builtin_amdgcn_sched_barrier(0)
    Unit cur, nxt; int ui = 0;
    if (!S.next(0, cur)) return;
    i32x4 acc[2][2][4][2];
#pragma unroll
    for (int a = 0; a < 2; ++a)
#pragma unroll
        for (int b = 0; b < 2; ++b)
#pragma unroll
            for (int m = 0; m < 4; ++m)
#pragma unroll
                for (int n = 0; n < 2; ++n) acc[a][b][m][n] = (i32x4){0, 0, 0, 0};
    bf16x8 At[4][2], B0[2][2], B1[2][2];
    const char* cA = (const char*)g.A; const char* cB = (const char*)g.Bt + (size_t)cur.pn * tstep;
    unsigned v0[2], v1[2], n0[2], n1[2];
#define PG8_LOADOFF(D0, D1, PM) do { _Pragma("unroll") for (int _i = 0; _i < 2; ++_i) { D0[_i] = rowoff[256 * (PM) + rA[_i]] + cAoff[_i]; D1[_i] = rowoff[256 * (PM) + 128 + rA[_i]] + cAoff[_i]; } } while (0)
    PG8_LOADOFF(v0, v1, cur.pm);
#pragma unroll
    for (int _i = 0; _i < 2; ++_i) { n0[_i] = v0[_i]; n1[_i] = v1[_i]; }
    S.a_ready(cur);
    if constexpr (SP2) {
        PG8_STAGE(PG8_SB(0, 0), cB, voffB); PG8_STAGE(PG8_SB(0, 1), cB + hstep, voffB); PG8_STAGE(PG8_SA(0, 0), cA, v0); PG8_STAGE(PG8_SA(0, 1), cA, v1);
        if (wr == 1) PG8_BAR;
        PG8_WAIT_V(2); PG8_BAR;
        PG8_STAGE(PG8_SB(1, 0), cB + kstep, voffB); PG8_STAGE(PG8_SA(1, 0), cA + kstep, v0); PG8_STAGE(PG8_SB(1, 1), cB + hstep + kstep, voffB);
        PG8_WAIT_V(6); PG8_BAR;
    } else {
        PG8_STAGE(PG8_SB(0, 0), cB, voffB); PG8_STAGE(PG8_SA(0, 0), cA, v0); PG8_STAGE(PG8_SB(0, 1), cB + hstep, voffB); PG8_STAGE(PG8_SA(0, 1), cA, v1);
        if (wr == 1) PG8_BAR;
        PG8_WAIT_V(4); PG8_BAR;
        PG8_STAGE(PG8_SB(1, 0), cB + kstep, voffB); PG8_STAGE(PG8_SA(1, 0), cA + kstep, v0); PG8_STAGE(PG8_SB(1, 1), cB + hstep + kstep, voffB);
        PG8_WAIT_V(6); PG8_BAR;
    }
    for (;;) {
        const bool has_next = S.next(ui + 1, nxt);
        if (has_next) PG8_LOADOFF(n0, n1, nxt.pm);
        const char* nA = cA; const char* nB = has_next ? (const char*)g.Bt + (size_t)nxt.pn * tstep : cB;
        for (int t = 0; t < nt; t += 2) {
            const bool last = (t == nt - 2);
            const char* a1 = cA + (size_t)(t + 1) * kstep;
            const char* a2 = last ? nA : cA + (size_t)(t + 2) * kstep; const char* b2 = last ? nB : cB + (size_t)(t + 2) * kstep;
            const char* a3 = a2 + kstep; const char* b3 = b2 + kstep;
            unsigned o2a[2], o2b[2];
#pragma unroll
            for (int _i = 0; _i < 2; ++_i) { o2a[_i] = last ? n0[_i] : v0[_i]; o2b[_i] = last ? n1[_i] : v1[_i]; }
            if (last && has_next) S.a_ready(nxt);
            if constexpr (SP2) {
            PG8_LDB(B0, 0, 0); PG8_LDB(B1, 0, 1); PG8_SCHED; PG8_LDA(At, 0, 0); PG8_STAGE(PG8_SA(1, 1), a1, v1);
            PG8_WAIT_V(8); PG8_WAIT_L(0); PG8_BAR; PG8_MMA(0, 0, At, B0); PG8_MMA(0, 1, At, B1); PG8_BAR; PG8_SCHED;
            PG8_LDA(At, 0, 1); PG8_STAGE(PG8_SB(0, 0), b2, voffB); PG8_STAGE(PG8_SB(0, 1), b2 + hstep, voffB); PG8_STAGE(PG8_SA(0, 0), a2, o2a);
            PG8_WAIT_V(8); PG8_WAIT_L(0); PG8_BAR; PG8_MMA(1, 0, At, B0); PG8_MMA(1, 1, At, B1); PG8_BAR; PG8_SCHED;
            PG8_LDB(B0, 1, 0); PG8_LDB(B1, 1, 1); PG8_SCHED; PG8_LDA(At, 1, 0); PG8_STAGE(PG8_SA(0, 1), a2, o2b);
            PG8_WAIT_V(8); PG8_WAIT_L(0); PG8_BAR; PG8_MMA(0, 0, At, B0); PG8_MMA(0, 1, At, B1); PG8_BAR; PG8_SCHED;
            PG8_LDA(At, 1, 1); PG8_STAGE(PG8_SB(1, 0), b3, voffB); PG8_STAGE(PG8_SB(1, 1), b3 + hstep, voffB); PG8_STAGE(PG8_SA(1, 0), a3, o2a);
            PG8_WAIT_V(8); PG8_WAIT_L(0); PG8_BAR; PG8_MMA(1, 0, At, B0); PG8_MMA(1, 1, At, B1); PG8_BAR; PG8_SCHED;
            } else {
            PG8_LDB(B0, 0, 0); PG8_SCHED; PG8_LDA(At, 0, 0); PG8_STAGE(PG8_SA(1, 1), a1, v1);
            PG8_WAIT_L(8); PG8_BAR; PG8_WAIT_L(0); PG8_MMA(0, 0, At, B0); PG8_BAR; PG8_SCHED;
            PG8_LDB(B1, 0, 1); PG8_STAGE(PG8_SB(0, 0), b2, voffB);
            PG8_BAR; PG8_WAIT_L(0); PG8_MMA(0, 1, At, B1); PG8_BAR;
            PG8_LDA(At, 0, 1); PG8_STAGE(PG8_SA(0, 0), a2, o2a);
            PG8_BAR; PG8_WAIT_L(0); PG8_MMA(1, 0, At, B0); PG8_BAR; PG8_SCHED;
            PG8_STAGE(PG8_SB(0, 1), b2 + hstep, voffB);
            PG8_WAIT_V(6); PG8_BAR; PG8_MMA(1, 1, At, B1); PG8_BAR;
            PG8_LDB(B0, 1, 0); PG8_SCHED; PG8_LDA(At, 1, 0); PG8_STAGE(PG8_SA(0, 1), a2, o2b);
            PG8_WAIT_L(8); PG8_BAR; PG8_WAIT_L(0); PG8_MMA(0, 0, At, B0); PG8_BAR; PG8_SCHED;
            PG8_LDB(B1, 1, 1); PG8_STAGE(PG8_SB(1, 0), b3, voffB);
            PG8_BAR; PG8_WAIT_L(0); PG8_MMA(0, 1, At, B1); PG8_BAR;
            PG8_LDA(At, 1, 1); PG8_STAGE(PG8_SA(1, 0), a3, o2a);
            PG8_BAR; PG8_WAIT_L(0); PG8_MMA(1, 0, At, B0); PG8_BAR; PG8_SCHED;
            PG8_STAGE(PG8_SB(1, 1), b3 + hstep, voffB);
            PG8_WAIT_V(6); PG8_BAR; PG8_MMA(1, 1, At, B1); PG8_BAR;
            }
        }
        if constexpr (ALIGN_EPI) { if (wr == 0) PG8_BAR; }
        if constexpr (!Epi::AFTER_DRAIN) { E(acc, cur, wr, wc, fr, fq); S.done(cur); }
        if (!has_next) break;
#pragma unroll
        for (int a = 0; a < 2; ++a)
#pragma unroll
            for (int b = 0; b < 2; ++b)
#pragma unroll
                for (int m = 0; m < 4; ++m)
#pragma unroll
                    for (int n = 0; n < 2; ++n) acc[a][b][m][n] = (i32x4){0, 0, 0, 0};
        cur = nxt; cA = nA; cB = nB; ++ui;
#pragma unroll
        for (int _i = 0; _i < 2; ++_i) { v0[_i] = n0[_i]; v1[_i] = n1[_i]; }
        if constexpr (ALIGN_EPI) { if (wr == 1) PG8_BAR; }
    }
    PG8_WAIT_V(0);
    if constexpr (!ALIGN_EPI) { if (wr == 0) PG8_BAR; }
    PG8_BAR;
    if constexpr (Epi::AFTER_DRAIN) { E.fused(acc, cur, wr, wc, fr, fq, lds, wid, lane); S.done(cur); }
#undef PG8_LOADOFF
#undef PG8_SA
#undef PG8_SB
#undef PG8_STAGE
#undef PG8_LDA
#undef PG8_LDB
#undef PG8_MMA
#undef PG8_WAIT_V
#undef PG8_WAIT_L
#undef PG8_BAR
#undef PG8_SCHED
}template <class Epi, class Sched, bool ALIGN_EPI = false, bool SP2 = false>
__device__ __forceinline__ void gemm_phase_i8(PG8_LAS unsigned char* lds, const Gemm g, const Sched& S, const Epi& E, const int tid_arg) {
    int tid_ = tid_arg; asm volatile("" : "+v"(tid_));
    const int tid = tid_, wid = __builtin_amdgcn_readfirstlane(tid >> 6), lane = tid & 63, wr = wid >> 2, wc = wid & 3, fr = lane & 15, fq = lane >> 4;
    const int K = g.K, nt = K / BK;
    unsigned voffA[2], voffB[2];
#pragma unroll
    for (int i = 0; i < 2; ++i) { int R, C; stage_rc(tid * 16 + i * 8192, R, C); const int Rb = Epi::PERM ? ((R & ~31) + perm32(R & 31)) : R;
        voffA[i] = (unsigned)(R * K + C) * 2u; voffB[i] = (unsigned)(Rb * K + C) * 2u; }
    const size_t kstep = (size_t)(BK * 2);
    const size_t hstep = (size_t)HALF * K * 2;
    const size_t tstep = 2 * hstep;
    const unsigned ldsw = (unsigned)wid * 1024u;
    const int aoff = lds_byte(wr * 64 + fr, fq * 8), boff = lds_byte(wc * 32 + fr, fq * 8);
#define PG8_SA(b, h) (((b) * 2 + (h)) * HTB)
#define PG8_SB(b, h) ((4 + (b) * 2 + (h)) * HTB)
#define PG8_STAGE(bufoff, gbase, voff) do { _Pragma("unroll") for (int _i = 0; _i < 2; ++_i) \
        __builtin_amdgcn_global_load_lds((const unsigned*)((const char*)(gbase) + (voff)[_i]), (PG8_LAS unsigned*)(lds + (bufoff) + ldsw + _i * 8192), 16, 0, 0); } while (0)
#define PG8_LDA(dst, b, h) do { _Pragma("unroll") for (int m = 0; m < 4; ++m) _Pragma("unroll") for (int k = 0; k < 2; ++k) dst[m][k] = *(const PG8_LAS bf16x8*)(lds + PG8_SA(b, h) + aoff + m * 2048 + k * 1024); } while (0)
#define PG8_LDB(dst, b, h) do { _Pragma("unroll") for (int n = 0; n < 2; ++n) _Pragma("unroll") for (int k = 0; k < 2; ++k) dst[n][k] = *(const PG8_LAS bf16x8*)(lds + PG8_SB(b, h) + boff + n * 2048 + k * 1024); } while (0)
#define PG8_MMA(ai, bj, At, Bt) do { __builtin_amdgcn_s_setprio(1); _Pragma("unroll") for (int m = 0; m < 4; ++m) _Pragma("unroll") for (int n = 0; n < 2; ++n) _Pragma("unroll") for (int k = 0; k < 2; ++k) \
        acc[ai][bj][m][n] = __builtin_amdgcn_mfma_i32_16x16x64_i8(__builtin_bit_cast(i32x4, Bt[n][k]), __builtin_bit_cast(i32x4, At[m][k]), acc[ai][bj][m][n], 0, 0, 0); __builtin_amdgcn_s_setprio(0); } while (0)
#define PG8_WAIT_V(n) asm volatile("s_waitcnt vmcnt(" #n ")" ::: "memory")
#define PG8_WAIT_L(n) asm volatile("s_waitcnt lgkmcnt(" #n ")" ::: "memory")
#define PG8_BAR __builtin_amdgcn_s_barrier()
#define PG8_SCHED __builtin_amdgcn_sched_barrier(0)
    Unit cur, nxt; int ui = 0;
    if (!S.next(0, cur)) return;
    i32x4 acc[2][2][4][2];
#pragma unroll
    for (int a = 0; a < 2; ++a)
#pragma unroll
        for (int b = 0; b < 2; ++b)
#pragma unroll
            for (int m = 0; m < 4; ++m)
#pragma unroll
                for (int n = 0; n < 2; ++n) acc[a][b][m][n] = (i32x4){0, 0, 0, 0};
    bf16x8 At[4][2], B0[2][2], B1[2][2];
    const char* cA = (const char*)g.A + (size_t)cur.pm * tstep; const char* cB = (const char*)g.Bt + (size_t)cur.pn * tstep;
    S.a_ready(cur);
    if constexpr (SP2) {
        PG8_STAGE(PG8_SB(0, 0), cB, voffB); PG8_STAGE(PG8_SB(0, 1), cB + hstep, voffB); PG8_STAGE(PG8_SA(0, 0), cA, voffA); PG8_STAGE(PG8_SA(0, 1), cA + hstep, voffA);
        if (wr == 1) PG8_BAR;
        PG8_WAIT_V(2); PG8_BAR;
        PG8_STAGE(PG8_SB(1, 0), cB + kstep, voffB); PG8_STAGE(PG8_SA(1, 0), cA + kstep, voffA); PG8_STAGE(PG8_SB(1, 1), cB + hstep + kstep, voffB);
        PG8_WAIT_V(6); PG8_BAR;
    } else {
        PG8_STAGE(PG8_SB(0, 0), cB, voffB); PG8_STAGE(PG8_SA(0, 0), cA, voffA); PG8_STAGE(PG8_SB(0, 1), cB + hstep, voffB); PG8_STAGE(PG8_SA(0, 1), cA + hstep, voffA);
        if (wr == 1) PG8_BAR;
        PG8_WAIT_V(4); PG8_BAR;
        PG8_STAGE(PG8_SB(1, 0), cB + kstep, voffB); PG8_STAGE(PG8_SA(1, 0), cA + kstep, voffA); PG8_STAGE(PG8_SB(1, 1), cB + hstep + kstep, voffB);
        PG8_WAIT_V(6); PG8_BAR;
    }
    for (;;) {
        const bool has_next = S.next(ui + 1, nxt);
        const char* nA = has_next ? (const char*)g.A + (size_t)nxt.pm * tstep : cA; const char* nB = has_next ? (const char*)g.Bt + (size_t)nxt.pn * tstep : cB;
        for (int t = 0; t < nt; t += 2) {
            const bool last = (t == nt - 2);
            const char* a1 = cA + (size_t)(t + 1) * kstep;
            const char* a2 = last ? nA : cA + (size_t)(t + 2) * kstep; const char* b2 = last ? nB : cB + (size_t)(t + 2) * kstep;
            const char* a3 = a2 + kstep; const char* b3 = b2 + kstep;
            if (last && has_next) S.a_ready(nxt);
            if constexpr (SP2) {
            PG8_LDB(B0, 0, 0); PG8_LDB(B1, 0, 1); PG8_SCHED; PG8_LDA(At, 0, 0); PG8_STAGE(PG8_SA(1, 1), a1 + hstep, voffA);
            PG8_WAIT_V(8); PG8_WAIT_L(0); PG8_BAR; PG8_MMA(0, 0, At, B0); PG8_MMA(0, 1, At, B1); PG8_BAR; PG8_SCHED;
            PG8_LDA(At, 0, 1); PG8_STAGE(PG8_SB(0, 0), b2, voffB); PG8_STAGE(PG8_SB(0, 1), b2 + hstep, voffB); PG8_STAGE(PG8_SA(0, 0), a2, voffA);
            PG8_WAIT_V(8); PG8_WAIT_L(0); PG8_BAR; PG8_MMA(1, 0, At, B0); PG8_MMA(1, 1, At, B1); PG8_BAR; PG8_SCHED;
            PG8_LDB(B0, 1, 0); PG8_LDB(B1, 1, 1); PG8_SCHED; PG8_LDA(At, 1, 0); PG8_STAGE(PG8_SA(0, 1), a2 + hstep, voffA);
            PG8_WAIT_V(8); PG8_WAIT_L(0); PG8_BAR; PG8_MMA(0, 0, At, B0); PG8_MMA(0, 1, At, B1); PG8_BAR; PG8_SCHED;
            PG8_LDA(At, 1, 1); PG8_STAGE(PG8_SB(1, 0), b3, voffB); PG8_STAGE(PG8_SB(1, 1), b3 + hstep, voffB); PG8_STAGE(PG8_SA(1, 0), a3, voffA);
            PG8_WAIT_V(8); PG8_WAIT_L(0); PG8_BAR; PG8_MMA(1, 0, At, B0); PG8_MMA(1, 1, At, B1); PG8_BAR; PG8_SCHED;
            } else {
            PG8_LDB(B0, 0, 0); PG8_SCHED; PG8_LDA(At, 0, 0); PG8_STAGE(PG8_SA(1, 1), a1 + hstep, voffA);
            PG8_WAIT_L(8); PG8_BAR; PG8_WAIT_L(0); PG8_MMA(0, 0, At, B0); PG8_BAR; PG8_SCHED;
            PG8_LDB(B1, 0, 1); PG8_STAGE(PG8_SB(0, 0), b2, voffB);
            PG8_BAR; PG8_WAIT_L(0); PG8_MMA(0, 1, At, B1); PG8_BAR;
            PG8_LDA(At, 0, 1); PG8_STAGE(PG8_SA(0, 0), a2, voffA);
            PG8_BAR; PG8_WAIT_L(0); PG8_MMA(1, 0, At, B0); PG8_BAR; PG8_SCHED;
            PG8_STAGE(PG8_SB(0, 1), b2 + hstep, voffB);
            PG8_WAIT_V(6); PG8_BAR; PG8_MMA(1, 1, At, B1); PG8_BAR;
            PG8_LDB(B0, 1, 0); PG8_SCHED; PG8_LDA(At, 1, 0); PG8_STAGE(PG8_SA(0, 1), a2 + hstep, voffA);
            PG8_WAIT_L(8); PG8_BAR; PG8_WAIT_L(0); PG8_MMA(0, 0, At, B0); PG8_BAR; PG8_SCHED;
            PG8_LDB(B1, 1, 1); PG8_STAGE(PG8_SB(1, 0), b3, voffB);
            PG8_BAR; PG8_WAIT_L(0); PG8_MMA(0, 1, At, B1); PG8_BAR;
            PG8_LDA(At, 1, 1); PG8_STAGE(PG8_SA(1, 0), a3, voffA);
            PG8_BAR; PG8_WAIT_L(0); PG8_MMA(1, 0, At, B0); PG8_BAR; PG8_SCHED;
            PG8_STAGE(PG8_SB(1, 1), b3 + hstep, voffB);
            PG8_WAIT_V(6); PG8_BAR; PG8_MMA(1, 1, At, B1); PG8_BAR;
            }
        }
        if constexpr (ALIGN_EPI) { if (wr == 0) PG8_BAR; }
        if constexpr (!Epi::AFTER_DRAIN) { E(acc, cur, wr, wc, fr, fq); S.done(cur); }
        if (!has_next) break;
#pragma unroll
        for (int a = 0; a < 2; ++a)
#pragma unroll
            for (int b = 0; b < 2; ++b)
#pragma unroll
                for (int m = 0; m < 4; ++m)
#pragma unroll
                    for (int n = 0; n < 2; ++n) acc[a][b][m][n] = (i32x4){0, 0, 0, 0};
        cur = nxt; cA = nA; cB = nB; ++ui;
        if constexpr (ALIGN_EPI) { if (wr == 1) PG8_BAR; }
    }
    PG8_WAIT_V(0);
    if constexpr (!ALIGN_EPI) { if (wr == 0) PG8_BAR; }
    PG8_BAR;
    if constexpr (Epi::AFTER_DRAIN) { E.fused(acc, cur, wr, wc, fr, fq, lds, wid, lane); S.done(cur); }
#undef PG8_SA
#undef PG8_SB
#undef PG8_STAGE
#undef PG8_LDA
#undef PG8_LDB
#undef PG8_MMA
#undef PG8_WAIT_V
#undef PG8_WAIT_L
#undef PG8_BAR
#undef PG8_SCHED
}}

#ifndef PROBE_MASK
#define PROBE_MASK 0
#endif
#ifndef PROBE_TMASK
#define PROBE_TMASK 0
#endif
namespace mk {
using pg8::bf16_t; using pg8::bf16x8; using pg8::f32x4; using pg8::u32x4; using pg8::Unit;
typedef float f32x16 __attribute__((ext_vector_type(16)));
typedef short s16x4 __attribute__((ext_vector_type(4)));
typedef unsigned u32x2 __attribute__((ext_vector_type(2)));
typedef float f32x2_t __attribute__((ext_vector_type(2)));
typedef __bf16 bf16x2_t __attribute__((ext_vector_type(2)));

constexpr int D = 1024, NB = 16, SEQ = 2048, CTXL = 256, DEPTH = 4;
constexpr int NL = NB * SEQ, NC = NB * CTXL, NT = NL + NC;
constexpr int PIN = 3088, NPROJ = 3072;
constexpr int NE = 16, DE = 1408;
constexpr int NTILE = 288, YROWS = NTILE * 256;
constexpr float EPS = 1e-6f;
constexpr float LOG2E = 1.4426950408889634f;
constexpr int NWAVES = 8, NTHREADS = 512;

constexpr size_t al256(size_t x) { return (x + 255) & ~(size_t)255; }
constexpr size_t WS_CTL = 0, CTL_BYTES = 2u << 20;
constexpr size_t WS_AMAXIN = 98304;
constexpr size_t CTL_ZERO_BYTES = WS_AMAXIN + (size_t)4 * 3072 * 4;
constexpr size_t WS_MOD = CTL_BYTES,                      MOD_BYTES = (size_t)DEPTH * 17 * 6144 * 4;
constexpr size_t WS_ROPE = al256(WS_MOD + MOD_BYTES),     ROPE_BYTES = (size_t)2 * 2048 * 32 * 4;
constexpr size_t WS_QKW = al256(WS_ROPE + ROPE_BYTES),    QKW_BYTES = (size_t)DEPTH * 128 * 4;
constexpr size_t WS_WT = al256(WS_QKW + QKW_BYTES),      WT_BYTES = (size_t)DEPTH * 2 * 16 * 1024 * 4;
constexpr size_t WS_WIN = al256(WS_WT + WT_BYTES),     WIN_BYTES = (size_t)DEPTH * NPROJ * D * 2;
constexpr size_t WS_WOUT = al256(WS_WIN + WIN_BYTES),     WOUT_BYTES = (size_t)DEPTH * D * D * 2;
constexpr size_t WS_WGU = al256(WS_WOUT + WOUT_BYTES),    WGU_BYTES = (size_t)DEPTH * NE * 2816 * D * 2;
constexpr size_t WS_WD = al256(WS_WGU + WGU_BYTES),       WD_BYTES = (size_t)DEPTH * NE * D * DE * 2;
constexpr size_t WS_HA = al256(WS_WD + WD_BYTES),         HA_BYTES = (size_t)NT * D * 2;
constexpr size_t WS_XB = al256(WS_HA + HA_BYTES),         XB_BYTES = (size_t)NT * D * 2;
constexpr size_t WS_DT = al256(WS_XB + XB_BYTES),     DT_BYTES = (size_t)NT * 16 * 4;
constexpr size_t WS_AFF = al256(WS_DT + DT_BYTES),        AFF_BYTES = (size_t)NT * 16 * 4;
constexpr size_t WS_GATE = al256(WS_AFF + AFF_BYTES),     GATE_BYTES = (size_t)YROWS * 4;
constexpr size_t WS_INV = al256(WS_GATE + GATE_BYTES),    INV_BYTES = (size_t)NT * 16 * 4;
constexpr size_t WS_ROFF = al256(WS_INV + INV_BYTES),    ROFF_BYTES = (size_t)YROWS * 4;
constexpr size_t WS_SW = al256(WS_ROFF + ROFF_BYTES),     SW_BYTES = (size_t)DEPTH * NE * 2816 * 4;
constexpr size_t WS_HQ = al256(WS_SW + SW_BYTES),         HQ_BYTES = (size_t)NT * D;
constexpr size_t WS_SA = al256(WS_HQ + HQ_BYTES),         SA_BYTES = (size_t)NT * 4;
constexpr size_t WS_SAY = al256(WS_SA + SA_BYTES),        SAY_BYTES = (size_t)YROWS * 4;
constexpr size_t WS_SAH = al256(WS_SAY + SAY_BYTES),      SAH_BYTES = (size_t)NT * 4;
constexpr size_t WS_SWIN = al256(WS_SAH + SAH_BYTES),     SWIN_BYTES = (size_t)DEPTH * NPROJ * 4;
constexpr size_t WS_U = al256(WS_SWIN + SWIN_BYTES);
constexpr size_t U_Q = 0,                                 QKVZ_BYTES = (size_t)NT * 512 * 2;
constexpr size_t U_K = U_Q + QKVZ_BYTES, U_V = U_K + QKVZ_BYTES, U_Z = U_V + QKVZ_BYTES;
constexpr size_t U_XBC = U_Z + QKVZ_BYTES,                XBC_BYTES = (size_t)NT * 1024 * 2;
constexpr size_t U_XBCC = U_XBC + XBC_BYTES;
constexpr size_t U_GM = U_XBCC + XBC_BYTES,               GM_BYTES = (size_t)288 * 2 * 128 * 128 * 2;
constexpr size_t U_YF = U_GM + GM_BYTES, U_YB = U_YF + QKVZ_BYTES;
constexpr size_t U_A2 = U_YB + QKVZ_BYTES;
constexpr size_t U_MIX_END = U_A2 + XBC_BYTES;
constexpr size_t U_XE = 0,                                XE_BYTES = (size_t)YROWS * D * 2;
constexpr size_t U_HID = U_XE + XE_BYTES,                 HID_BYTES = (size_t)YROWS * DE * 2;
constexpr size_t U_Y = U_HID + HID_BYTES;
constexpr size_t U_MOE_END = U_Y + XE_BYTES;
constexpr size_t WS_END = WS_U + (U_MIX_END > U_MOE_END ? U_MIX_END : U_MOE_END);

constexpr int CW_BAR = 0;
constexpr int CW_WQ = 16384;
constexpr int CW_CVQ = 12288;
constexpr int CW_DONE = 14336;
constexpr int CW_ZERO = 8192;

constexpr int LDS_BYTES = 155648;
constexpr int MISC_OFF = 154624;

__device__ __forceinline__ unsigned pk2(float lo, float hi) { f32x2_t v = {lo, hi}; bf16x2_t b = __builtin_convertvector(v, bf16x2_t); return __builtin_bit_cast(unsigned, b); }
__device__ __forceinline__ float bflo(unsigned w) { return __uint_as_float(w << 16); }
__device__ __forceinline__ float bfhi(unsigned w) { return __uint_as_float(w & 0xffff0000u); }
__device__ __forceinline__ float bf1(unsigned short h) { return __uint_as_float((unsigned)h << 16); }
__device__ __forceinline__ unsigned short f2bf(float f) { return (unsigned short)(pk2(f, 0.f) & 0xffffu); }
__device__ __forceinline__ float silu_f(float x) { return x / (1.f + __expf(-x)); }
__device__ __forceinline__ int lane_id_v() { int l; asm volatile("v_mbcnt_lo_u32_b32 %0, -1, 0\n\tv_mbcnt_hi_u32_b32 %0, -1, %0" : "=v"(l)); return l; }
__device__ __forceinline__ float shx(float v, int m, int lane) { return __int_as_float(__builtin_amdgcn_ds_bpermute((lane ^ m) << 2, __float_as_int(v))); }
__device__ __forceinline__ float shl_from(float v, int src_lane) { return __int_as_float(__builtin_amdgcn_ds_bpermute(src_lane << 2, __float_as_int(v))); }
__device__ __forceinline__ int shl_from_i(int v, int src_lane) { return __builtin_amdgcn_ds_bpermute(src_lane << 2, v); }
__device__ __forceinline__ float wave_sum(float v) {
    const int l = lane_id_v();
#pragma unroll
    for (int o = 1; o < 64; o <<= 1) v += shx(v, o, l);
    return v;
}
__device__ __forceinline__ float wave_max(float v) {
    const int l = lane_id_v();
#pragma unroll
    for (int o = 1; o < 64; o <<= 1) v = fmaxf(v, shx(v, o, l));
    return v;
}
template <int CTRL> __device__ __forceinline__ float dpp_f(float v) { return __int_as_float(__builtin_amdgcn_update_dpp(0, __float_as_int(v), CTRL, 0xf, 0xf, true)); }
__device__ __forceinline__ float rl_f(float v, int l) { return __int_as_float(__builtin_amdgcn_readlane(__float_as_int(v), l)); }
__device__ __forceinline__ float wave_sum_dpp(float v) {
    v += dpp_f<0xB1>(v); v += dpp_f<0x4E>(v); v += dpp_f<0x141>(v); v += dpp_f<0x140>(v);
    return (rl_f(v, 0) + rl_f(v, 16)) + (rl_f(v, 32) + rl_f(v, 48));
}
__device__ __forceinline__ float wave_max_dpp(float v) {
    v = fmaxf(v, dpp_f<0xB1>(v)); v = fmaxf(v, dpp_f<0x4E>(v)); v = fmaxf(v, dpp_f<0x141>(v)); v = fmaxf(v, dpp_f<0x140>(v));
    return fmaxf(fmaxf(rl_f(v, 0), rl_f(v, 16)), fmaxf(rl_f(v, 32), rl_f(v, 48)));
}
#define LDS_WAIT() asm volatile("s_waitcnt lgkmcnt(0)" ::: "memory")
__device__ __forceinline__ void lds_barrier() { asm volatile("s_waitcnt lgkmcnt(0)" ::: "memory"); __builtin_amdgcn_s_barrier(); asm volatile("" ::: "memory"); }
__device__ __forceinline__ u32x4 pack8(f32x4 a, f32x4 b) { u32x4 w; w.x = pk2(a[0], a[1]); w.y = pk2(a[2], a[3]); w.z = pk2(b[0], b[1]); w.w = pk2(b[2], b[3]); return w; }

__device__ __forceinline__ float reduce16(float (&v)[16], int lane) {
    { const bool b = (lane & 32) != 0;
#pragma unroll
      for (int i = 0; i < 8; ++i) { const float send = b ? v[i] : v[i + 8], keep = b ? v[i + 8] : v[i]; v[i] = keep + shx(send, 32, lane); } }
    { const bool b = (lane & 16) != 0;
#pragma unroll
      for (int i = 0; i < 4; ++i) { const float send = b ? v[i] : v[i + 4], keep = b ? v[i + 4] : v[i]; v[i] = keep + shx(send, 16, lane); } }
    { const bool b = (lane & 8) != 0;
#pragma unroll
      for (int i = 0; i < 2; ++i) { const float send = b ? v[i] : v[i + 2], keep = b ? v[i + 2] : v[i]; v[i] = keep + shx(send, 8, lane); } }
    { const bool b = (lane & 4) != 0; const float send = b ? v[0] : v[1], keep = b ? v[1] : v[0]; v[0] = keep + shx(send, 4, lane); }
    float t = v[0]; t += shx(t, 1, lane); t += shx(t, 2, lane); return t;
}
__device__ __forceinline__ int colidx16(int lane) { return ((lane >> 5) & 1) * 8 + ((lane >> 4) & 1) * 4 + ((lane >> 3) & 1) * 2 + ((lane >> 2) & 1); }
__device__ __forceinline__ int laneof16(int c) { return ((c >> 3) & 1) * 32 + ((c >> 2) & 1) * 16 + ((c >> 1) & 1) * 8 + (c & 1) * 4; }

__device__ __forceinline__ bf16x8 frag_rm(LAS const unsigned char* base, int stride, int row0, int k0, int lane) {
    return *(LAS const bf16x8*)(base + (row0 + (lane & 31)) * stride + (k0 + 8 * (lane >> 5)) * 2);
}
__device__ __forceinline__ bf16x8 frag_tr(LAS const unsigned char* base, int stride, int k0, int col0, int lane) {
    const int h = lane >> 5, blk = (lane >> 4) & 1, q = (lane & 15) >> 2, p = lane & 3;
    LAS const unsigned char* a = base + (k0 + 8 * h + q) * stride + (col0 + 16 * blk + 4 * p) * 2;
    const s16x4 lo = __builtin_bit_cast(s16x4, __builtin_amdgcn_ds_read_tr16_b64_v4i16((LAS s16x4*)a));
    const s16x4 hi = __builtin_bit_cast(s16x4, __builtin_amdgcn_ds_read_tr16_b64_v4i16((LAS s16x4*)(a + 4 * stride)));
    return (bf16x8){lo[0], lo[1], lo[2], lo[3], hi[0], hi[1], hi[2], hi[3]};
}
__device__ __forceinline__ bf16x8 frag_tr_acc(LAS const unsigned char* base, int stride, int k0, int col0, int lane) {
    const int h = lane >> 5, blk = (lane >> 4) & 1, q = (lane & 15) >> 2, p = lane & 3;
    LAS const unsigned char* a = base + (k0 + 4 * h + q) * stride + (col0 + 16 * blk + 4 * p) * 2;
    const s16x4 lo = __builtin_bit_cast(s16x4, __builtin_amdgcn_ds_read_tr16_b64_v4i16((LAS s16x4*)a));
    const s16x4 hi = __builtin_bit_cast(s16x4, __builtin_amdgcn_ds_read_tr16_b64_v4i16((LAS s16x4*)(a + 8 * stride)));
    return (bf16x8){lo[0], lo[1], lo[2], lo[3], hi[0], hi[1], hi[2], hi[3]};
}
__device__ __forceinline__ int accrow(int t, int h) { return (t & 3) + 8 * (t >> 2) + 4 * h; }
#define MFMA32(a, b, c) __builtin_amdgcn_mfma_f32_32x32x16_bf16((a), (b), (c), 0, 0, 0)

struct Frame {
    LAS unsigned char* lds;
    int tid, lane, wave, G, blk;
};
__device__ __forceinline__ unsigned long long karg64(int byteoff) {
    unsigned long long p; auto ka = __builtin_amdgcn_kernarg_segment_ptr();
    asm volatile("s_load_dwordx2 %0, %1, %2\n\ts_waitcnt lgkmcnt(0)" : "=s"(p) : "s"(ka), "i"(byteoff) : "memory");
    return p;
}
#define INP(i)  ((const float*)(const GAS float*)karg64(8 * (i)))
#define OUTP()  ((float*)(GAS float*)karg64(232))
#define WSP()   ((unsigned char*)(GAS unsigned char*)karg64(240))
#define F_CTL   ((unsigned*)(WSP() + WS_CTL))
#define F_MOD   ((float*)(WSP() + WS_MOD))
#define F_ROPEC ((float*)(WSP() + WS_ROPE))
#define F_ROPES ((float*)(WSP() + WS_ROPE) + 2048 * 32)
#define F_QKW   ((float*)(WSP() + WS_QKW))
#define F_WT    ((float*)(WSP() + WS_WT))
#define F_WIN   ((bf16_t*)(WSP() + WS_WIN))
#define F_WOUT  ((bf16_t*)(WSP() + WS_WOUT))
#define F_WGU   ((bf16_t*)(WSP() + WS_WGU))
#define F_WGUQ  ((signed char*)(WSP() + WS_WGU))
#define F_WD    ((bf16_t*)(WSP() + WS_WD))
#define F_HA    ((bf16_t*)(WSP() + WS_HA))
#define F_XB    ((bf16_t*)(WSP() + WS_XB))
#define F_DT    ((float*)(WSP() + WS_DT))
#define F_AFF   ((float*)(WSP() + WS_AFF))
#define F_GATE  ((float*)(WSP() + WS_GATE))
#define F_INV   ((int*)(WSP() + WS_INV))
#define F_ROFF  ((unsigned*)(WSP() + WS_ROFF))
#define F_AMAXIN ((unsigned*)(WSP() + WS_AMAXIN))
#define F_SAH   ((float*)(WSP() + WS_SAH))
#define F_SWIN  ((float*)(WSP() + WS_SWIN))
#define F_HAQ   ((signed char*)(WSP() + WS_HA))
#define F_WINQ  ((signed char*)(WSP() + WS_WIN))
#define F_SW    ((float*)(WSP() + WS_SW))
#define F_HQ    ((signed char*)(WSP() + WS_HQ))
#define F_SA    ((float*)(WSP() + WS_SA))
#define F_SAY   ((float*)(WSP() + WS_SAY))
#define F_Q     ((bf16_t*)(WSP() + WS_U + U_Q))
#define F_K     ((bf16_t*)(WSP() + WS_U + U_K))
#define F_V     ((bf16_t*)(WSP() + WS_U + U_V))
#define F_Z     ((bf16_t*)(WSP() + WS_U + U_Z))
#define F_XBC   ((bf16_t*)(WSP() + WS_U + U_XBC))
#define F_XBCC  ((bf16_t*)(WSP() + WS_U + U_XBCC))
#define F_GM    ((bf16_t*)(WSP() + WS_U + U_GM))
#define F_YF    ((bf16_t*)(WSP() + WS_U + U_YF))
#define F_YB    ((bf16_t*)(WSP() + WS_U + U_YB))
#define F_A2    ((bf16_t*)(WSP() + WS_U + U_A2))
#define F_XE    ((bf16_t*)(WSP() + WS_U + U_XE))
#define F_HID   ((bf16_t*)(WSP() + WS_U + U_HID))
#define F_Y     ((bf16_t*)(WSP() + WS_U + U_Y))
enum { I_X = 0, I_C, I_CTX, I_CCTX, I_WMOD, I_BMOD, I_N1W, I_N2W, I_WIN, I_QNW, I_KNW, I_LQ1, I_LK1, I_LQ2, I_LK2, I_SUBLN, I_CONVW, I_CONVB,
       I_DTBF, I_DTBB, I_ALOGF, I_ALOGB, I_DSKIP, I_SSDNW, I_WOUT, I_WR, I_WG, I_WU, I_WDN };

constexpr int CT_STR = 144;
__device__ __forceinline__ int inv_perm32(int x) { return 16 * ((x >> 2) & 1) + 4 * (x >> 3) + (x & 3); }
__device__ __forceinline__ int cvt_row_of_col(int c, int kperm) { return (c & 32) + (kperm ? inv_perm32(c & 31) : (c & 31)); }
__device__ __forceinline__ unsigned pack_i8x4(float a, float b, float c, float d, float inv) {
    const unsigned ua = __float_as_uint(fmaf(a, inv, 12582912.f)), ub = __float_as_uint(fmaf(b, inv, 12582912.f)), uc = __float_as_uint(fmaf(c, inv, 12582912.f)), ud = __float_as_uint(fmaf(d, inv, 12582912.f));
    const unsigned p01 = __builtin_amdgcn_perm(ub, ua, 0x0c0c0400u), p23 = __builtin_amdgcn_perm(ud, uc, 0x0c0c0400u);
    return __builtin_amdgcn_perm(p23, p01, 0x05040100u);
}
__device__ __forceinline__ unsigned pack_i8x4s(float a, float ia, float b, float ib, float c, float ic, float d, float id) {
    const unsigned ua = __float_as_uint(fmaf(a, ia, 12582912.f)), ub = __float_as_uint(fmaf(b, ib, 12582912.f)), uc = __float_as_uint(fmaf(c, ic, 12582912.f)), ud = __float_as_uint(fmaf(d, id, 12582912.f));
    const unsigned p01 = __builtin_amdgcn_perm(ub, ua, 0x0c0c0400u), p23 = __builtin_amdgcn_perm(ud, uc, 0x0c0c0400u);
    return __builtin_amdgcn_perm(p23, p01, 0x05040100u);
}
__device__ __forceinline__ void cvt_item64(const float* __restrict__ src, int ld, int c0a, int c0b, int kperm, int k0, bf16_t* __restrict__ dst, int K, LAS float* scr, int lane) {
    LAS unsigned char* T = (LAS unsigned char*)scr;
    { const int cq = lane & 15, rq = lane >> 4, col = ((cq >> 3) ? c0b : c0a) + 4 * (cq & 7);
      f32x4 v[16];
#pragma unroll
      for (int i = 0; i < 16; ++i) v[i] = __builtin_nontemporal_load((const f32x4*)(src + (size_t)(k0 + 4 * i + rq) * ld + col));
#pragma unroll
      for (int i = 0; i < 16; ++i) *(LAS u32x2*)(T + (4 * i + rq) * CT_STR + 8 * cq) = (u32x2){pk2(v[i][0], v[i][1]), pk2(v[i][2], v[i][3])}; }
    LDS_WAIT();
    const int h = lane >> 5;
#pragma unroll
    for (int kk = 0; kk < 4; ++kk)
#pragma unroll
        for (int cc = 0; cc < 2; ++cc) { const bf16x8 f = frag_tr(T, CT_STR, 16 * kk, 32 * cc, lane); const int n = cvt_row_of_col(32 * cc + (lane & 31), kperm);
            __builtin_nontemporal_store(__builtin_bit_cast(u32x4, f), (u32x4*)(dst + (size_t)n * K + k0 + 16 * kk + 8 * h)); }
    LDS_WAIT();
}
__device__ __forceinline__ void cvt_item64_i8(const float* __restrict__ src, int ld, int c0a, int c0b, int kperm, int k0, signed char* __restrict__ dst, int Kb, const unsigned* __restrict__ amax, float* sw,
                                              LAS float* scr, int lane) {
    LAS unsigned char* T = (LAS unsigned char*)scr;
    { const int cq = lane & 15, rq = lane >> 4, col = ((cq >> 3) ? c0b : c0a) + 4 * (cq & 7);
      f32x4 v[16];
#pragma unroll
      for (int i = 0; i < 16; ++i) v[i] = __builtin_nontemporal_load((const f32x4*)(src + (size_t)(k0 + 8 * (i >> 1) + 2 * rq + (i & 1)) * ld + col));
      const f32x4 am = __builtin_bit_cast(f32x4, *(const u32x4*)(amax + col)); f32x4 inv;
#pragma unroll
      for (int c = 0; c < 4; ++c) inv[c] = am[c] > 0.f ? 127.f / am[c] : 0.f;
#pragma unroll
      for (int ii = 0; ii < 8; ++ii) *(LAS u32x2*)(T + (4 * ii + rq) * CT_STR + 8 * cq) =
          (u32x2){pack_i8x4s(v[2 * ii][0], inv[0], v[2 * ii + 1][0], inv[0], v[2 * ii][1], inv[1], v[2 * ii + 1][1], inv[1]), pack_i8x4s(v[2 * ii][2], inv[2], v[2 * ii + 1][2], inv[2], v[2 * ii][3], inv[3], v[2 * ii + 1][3], inv[3])}; }
    LDS_WAIT();
    const int h = lane >> 5;
#pragma unroll
    for (int kk = 0; kk < 2; ++kk)
#pragma unroll
        for (int cc = 0; cc < 2; ++cc) { const bf16x8 f = frag_tr(T, CT_STR, 16 * kk, 32 * cc, lane); const int n = cvt_row_of_col(32 * cc + (lane & 31), kperm);
            __builtin_nontemporal_store(__builtin_bit_cast(u32x4, f), (u32x4*)(dst + (size_t)n * Kb + k0 + 32 * kk + 16 * h)); }
    if (sw) { const int colsrc = ((lane & 32) ? c0b : c0a) + (kperm ? pg8::perm32(lane & 31) : (lane & 31)); sw[lane] = __uint_as_float(amax[colsrc]) * (1.f / 127.f); }
    LDS_WAIT();
}
constexpr int AM_IN_ITEMS = DEPTH * 48 * 4;
__device__ __forceinline__ void amax_block(const float* src, int ld, unsigned* dst, int lane) {
    const int rq = lane >> 4, cq = lane & 15;
    f32x4 m = {0.f, 0.f, 0.f, 0.f};
    for (int i = 0; i < 64; i += 16) {
        f32x4 v[16];
#pragma unroll
        for (int q = 0; q < 16; ++q) v[q] = *(const f32x4*)(src + (size_t)(4 * (i + q) + rq) * ld + 4 * cq);
#pragma unroll
        for (int q = 0; q < 16; ++q) { m[0] = fmaxf(m[0], fabsf(v[q][0])); m[1] = fmaxf(m[1], fabsf(v[q][1])); m[2] = fmaxf(m[2], fabsf(v[q][2])); m[3] = fmaxf(m[3], fabsf(v[q][3])); }
    }
#pragma unroll
    for (int cidx = 0; cidx < 4; ++cidx) { m[cidx] = fmaxf(m[cidx], shx(m[cidx], 16, lane)); m[cidx] = fmaxf(m[cidx], shx(m[cidx], 32, lane)); }
    if (rq == 0) {
#pragma unroll
        for (int cidx = 0; cidx < 4; ++cidx) (void)__hip_atomic_fetch_max(dst + 4 * cq + cidx, __float_as_uint(m[cidx]), __ATOMIC_RELAXED, __HIP_MEMORY_SCOPE_AGENT); }
}
__device__ __forceinline__ void amax_in_item(const float* win, unsigned* amaxp, int it, int lane) {
    const int kq = it & 3; int r = it >> 2; const int cb = r % 48, l = r / 48;
    amax_block(win + (size_t)l * D * PIN + (size_t)(256 * kq) * PIN + cb * 64, PIN, amaxp + (size_t)l * NPROJ + cb * 64, lane);
}
constexpr int CV_WIN = 48 * 16, CV_WOUT = 16 * 16, CV_WGU = NE * 44 * 16, CV_WD = NE * 16 * 22, CV_LAYER = CV_WIN + CV_WOUT + CV_WGU + CV_WD;

__device__ __forceinline__ void cvt_layer_item(const Frame& F, int l, int r, LAS float* scr) {
    const int lane = F.lane;
    if (r < CV_WIN) { const int GI = r % 48, kb = r / 48, gI = 2 * GI, pn = gI >> 3, gg = gI & 7; int c0a, c0b, kp;
        if (pn < 4) { c0a = 256 * pn + 64 * (gg & 3) + 32 * (gg >> 2); c0b = 256 * pn + 64 * ((gg + 1) & 3) + 32 * ((gg + 1) >> 2); kp = 0; } else { c0a = 32 * gI; c0b = c0a + 32; kp = 1; }
        cvt_item64_i8(INP(I_WIN) + (size_t)l * D * PIN, PIN, c0a, c0b, kp, 64 * kb, F_WINQ + ((size_t)l * NPROJ + 32 * gI) * D, D, F_AMAXIN + (size_t)l * NPROJ,
                      kb == 0 ? F_SWIN + (size_t)l * NPROJ + 32 * gI : (float*)nullptr, scr, lane); return; }
    r -= CV_WIN;
    if (r < CV_WOUT) { const int GI = r % 16, kb = r / 16;
        cvt_item64(INP(I_WOUT) + (size_t)l * D * D, D, 64 * GI, 64 * GI + 32, 1, 64 * kb, F_WOUT + ((size_t)l * D + 64 * GI) * D, D, scr, lane); return; }
    r -= CV_WOUT;
    r -= CV_WGU;
    { const int e = r / 352, r2 = r % 352, GI = r2 % 16, kb = r2 / 16;
        cvt_item64(INP(I_WDN) + (size_t)(l * NE + e) * DE * D, D, 64 * GI, 64 * GI + 32, 1, 64 * kb, F_WD + ((size_t)(l * NE + e) * D + 64 * GI) * DE, DE, scr, lane); }
}
__device__ __forceinline__ void cvt_wgu_block(const Frame& F, int l, int it) {
    const int lane = F.lane, wave = F.wave, cq = lane & 15, rq = lane >> 4;
    const int e = it / 44, GI = it % 44, gI = 2 * GI, j = gI >> 3, gg = gI & 7;
    const float* src = (gg < 4 ? INP(I_WG) : INP(I_WU)) + (size_t)(l * NE + e) * D * DE + 128 * j + 32 * (gg & 3) + (size_t)(128 * wave + 2 * rq) * DE + 4 * cq;
    signed char* dst = F_WGUQ + ((size_t)(l * NE + e) * 2816 + 32 * gI) * D + 128 * wave;
    LAS unsigned char* T = F.lds + wave * 17408;
    LAS float* am = (LAS float*)(F.lds + 8 * 17408);
    f32x4 v0[16], v1[16];
#pragma unroll
    for (int i = 0; i < 16; ++i) v0[i] = __builtin_nontemporal_load((const f32x4*)(src + (size_t)(8 * (i >> 1) + (i & 1)) * DE));
#pragma unroll
    for (int i = 0; i < 16; ++i) v1[i] = __builtin_nontemporal_load((const f32x4*)(src + (size_t)(64 + 8 * (i >> 1) + (i & 1)) * DE));
    f32x4 m = {0.f, 0.f, 0.f, 0.f};
#pragma unroll
    for (int i = 0; i < 16; ++i)
#pragma unroll
        for (int c = 0; c < 4; ++c) m[c] = fmaxf(m[c], fmaxf(fabsf(v0[i][c]), fabsf(v1[i][c])));
#pragma unroll
    for (int c = 0; c < 4; ++c) { m[c] = fmaxf(m[c], shx(m[c], 16, lane)); m[c] = fmaxf(m[c], shx(m[c], 32, lane)); }
    if (rq == 0) *(LAS f32x4*)(am + wave * 64 + 4 * cq) = m;
    __syncthreads();
    f32x4 a = *(LAS const f32x4*)(am + 4 * cq);
#pragma unroll
    for (int w = 1; w < 8; ++w) { const f32x4 b = *(LAS const f32x4*)(am + w * 64 + 4 * cq);
#pragma unroll
        for (int c = 0; c < 4; ++c) a[c] = fmaxf(a[c], b[c]); }
    f32x4 inv;
#pragma unroll
    for (int c = 0; c < 4; ++c) inv[c] = a[c] > 0.f ? 127.f / a[c] : 0.f;
    if (wave == 0) { const int lc = (lane & 32) + pg8::perm32(lane & 31); float an = am[lc];
#pragma unroll
        for (int w = 1; w < 8; ++w) an = fmaxf(an, am[w * 64 + lc]);
        F_SW[(size_t)(l * NE + e) * 2816 + 32 * gI + lane] = an * (1.f / 127.f); }
    const int h = lane >> 5;
#pragma unroll
    for (int tl = 0; tl < 2; ++tl) {
#pragma unroll
        for (int ii = 0; ii < 8; ++ii) { const f32x4 ve = tl ? v1[2 * ii] : v0[2 * ii], vo = tl ? v1[2 * ii + 1] : v0[2 * ii + 1];
            *(LAS u32x2*)(T + (4 * ii + rq) * CT_STR + 8 * cq) = (u32x2){pack_i8x4s(ve[0], inv[0], vo[0], inv[0], ve[1], inv[1], vo[1], inv[1]), pack_i8x4s(ve[2], inv[2], vo[2], inv[2], ve[3], inv[3], vo[3], inv[3])}; }
        LDS_WAIT();
#pragma unroll
        for (int kk = 0; kk < 2; ++kk)
#pragma unroll
            for (int cc = 0; cc < 2; ++cc) { const bf16x8 f = frag_tr(T, CT_STR, 16 * kk, 32 * cc, lane); const int n = cvt_row_of_col(32 * cc + (lane & 31), 1);
                __builtin_nontemporal_store(__builtin_bit_cast(u32x4, f), (u32x4*)(dst + (size_t)n * D + 64 * tl + 32 * kk + 16 * h)); }
        LDS_WAIT();
    }
}
constexpr int CV_SMALL = CV_WIN + CV_WOUT;
constexpr int CVB_WGU = NE * 44, CVB = CVB_WGU + CV_WD / 8;
__device__ __forceinline__ void cvt_small(const Frame& F, int l) {
    LAS float* scr = (LAS float*)(F.lds + F.wave * 17408);
    for (int it = F.blk * NWAVES + F.wave; it < CV_SMALL; it += F.G * NWAVES) cvt_layer_item(F, l, it, scr);
}
__device__ __forceinline__ void p0_prologue(const Frame& F) {
    const int gw = F.blk * NWAVES + F.wave, NGW = F.G * NWAVES, lane = F.lane, wave = F.wave;
    {
        LAS float* S = (LAS float*)F.lds;
        LAS float* red = (LAS float*)(F.lds + 69632);
        { const float* const cp = INP(I_C); const float* const ccp = INP(I_CCTX);
          for (int i = F.tid; i < 17 * 1024; i += NTHREADS) { const int r = i >> 10, k = i & 1023; const float c = (r < 16) ? cp[r * D + k] : ccp[k]; S[i] = silu_f(c); } }
        __syncthreads();
        const float* const wmod = INP(I_WMOD); const float* const bmod = INP(I_BMOD); float* const modp = F_MOD;
        for (int it = F.blk; it < DEPTH * 96; it += F.G) {
            const int l = it / 96, cb = it % 96, col = cb * 64 + lane;
            const float* wm = wmod + (size_t)l * D * 6144 + (size_t)(128 * wave) * 6144 + col;
            float acc[17];
#pragma unroll
            for (int r = 0; r < 17; ++r) acc[r] = 0.f;
            for (int k = 0; k < 128; k += 8) {
                float w[8];
#pragma unroll
                for (int q = 0; q < 8; ++q) w[q] = wm[(size_t)(k + q) * 6144];
#pragma unroll
                for (int r = 0; r < 17; ++r) { const f32x4 s0 = *(LAS const f32x4*)(S + r * 1024 + 128 * wave + k), s1 = *(LAS const f32x4*)(S + r * 1024 + 128 * wave + k + 4);
                    acc[r] += s0[0] * w[0] + s0[1] * w[1] + s0[2] * w[2] + s0[3] * w[3] + s1[0] * w[4] + s1[1] * w[5] + s1[2] * w[6] + s1[3] * w[7]; }
            }
#pragma unroll
            for (int r = 0; r < 17; ++r) red[(wave * 17 + r) * 64 + lane] = acc[r];
            __syncthreads();
            for (int o = F.tid; o < 17 * 64; o += NTHREADS) { const int r = o >> 6, cc = o & 63; float a = 0.f;
#pragma unroll
                for (int w = 0; w < 8; ++w) a += red[(w * 17 + r) * 64 + cc];
                modp[((size_t)l * 17 + r) * 6144 + cb * 64 + cc] = a + bmod[l * 6144 + cb * 64 + cc]; }
            __syncthreads();
        }
    }
    { const float* const win = INP(I_WIN); unsigned* const amaxin = F_AMAXIN;
      for (int it = gw; it < AM_IN_ITEMS; it += NGW) amax_in_item(win, amaxin, it, lane); }
    float* const ropec = F_ROPEC; float* const ropes = F_ROPES;
    for (int gt = F.blk * NTHREADS + F.tid; gt < 64 * 16; gt += F.G * NTHREADS) {
        const int pos = gt >> 4, f = gt & 15;
        const float inv = powf(10000.0f, -(float)f / 16.0f); const float ang = (float)pos * inv;
        ropec[gt] = cosf(ang); ropes[gt] = sinf(ang);
    }
    if (F.blk == F.G - 1) { float* const qkw = F_QKW; const float* const qn = INP(I_QNW); const float* const kn = INP(I_KNW);
        for (int i = F.tid; i < DEPTH * 128; i += NTHREADS) { const int l = i >> 7, j = i & 127; qkw[i] = (j < 64) ? qn[l * 64 + j] : kn[l * 64 + j - 64]; } }
    { float* const wt = F_WT; const float* const win = INP(I_WIN); const float* const wr = INP(I_WR);
      for (int i = F.blk * NTHREADS + F.tid; i < DEPTH * 2 * 16 * 1024; i += F.G * NTHREADS) { const int l = i >> 15, w = (i >> 14) & 1, c = (i >> 10) & 15, k = i & 1023;
          wt[i] = w ? wr[((size_t)l * D + k) * NE + c] : win[((size_t)l * D + k) * PIN + NPROJ + c]; } }
}

__device__ __forceinline__ void load_thin_T(const Frame& F, const float* src, LAS float* T) {
    f32x4 t[8];
#pragma unroll
    for (int i = 0; i < 8; ++i) t[i] = *(const f32x4*)(src + 4 * (F.tid + 512 * i));
#pragma unroll
    for (int i = 0; i < 8; ++i) *(LAS f32x4*)(T + 4 * (F.tid + 512 * i)) = t[i];
    __syncthreads();
}
__device__ __forceinline__ float softplus_f(float x) { const float e = __expf(-fabsf(x)), u = 1.f + e; const float l = (u == 1.f) ? e : __logf(u) * (e * __builtin_amdgcn_rcpf(u - 1.f)); return fmaxf(x, 0.f) + l; }


constexpr int TH_STR = 2064;
constexpr int TH_THI = 0, TH_TLO = 16 * TH_STR, TH_HHI = 32 * TH_STR, TH_HLO = 48 * TH_STR, TH_PART = 64 * TH_STR;
static_assert(TH_PART + 8192 <= MISC_OFF, "thin lds");
__device__ __forceinline__ void load_thin_T_bf(const Frame& F, const float* src, LAS unsigned char* L) {
    f32x4 t[8];
#pragma unroll
    for (int i = 0; i < 8; ++i) t[i] = *(const f32x4*)(src + 4 * (F.tid + 512 * i));
#pragma unroll
    for (int i = 0; i < 8; ++i) { const int e = 4 * (F.tid + 512 * i), c = e >> 10, k = e & 1023;
        const u32x2 hi = {pk2(t[i][0], t[i][1]), pk2(t[i][2], t[i][3])};
        const u32x2 lo = {pk2(t[i][0] - bflo(hi.x), t[i][1] - bfhi(hi.x)), pk2(t[i][2] - bflo(hi.y), t[i][3] - bfhi(hi.y))};
        *(LAS u32x2*)(L + TH_THI + c * TH_STR + k * 2) = hi; *(LAS u32x2*)(L + TH_TLO + c * TH_STR + k * 2) = lo; }
    __syncthreads();
}
__device__ __forceinline__ void thin_stage_row(LAS unsigned char* L, int srow, const f32x4 (&h)[4], int lane) {
#pragma unroll
    for (int j = 0; j < 4; ++j) { const int k = 4 * (lane + 64 * j);
        const u32x2 hi = {pk2(h[j][0], h[j][1]), pk2(h[j][2], h[j][3])};
        const u32x2 lo = {pk2(h[j][0] - bflo(hi.x), h[j][1] - bfhi(hi.x)), pk2(h[j][2] - bflo(hi.y), h[j][3] - bfhi(hi.y))};
        *(LAS u32x2*)(L + TH_HHI + srow * TH_STR + k * 2) = hi; *(LAS u32x2*)(L + TH_HLO + srow * TH_STR + k * 2) = lo; }
}
__device__ __forceinline__ void thin_mfma_partial(LAS unsigned char* L, int wave, int lane) {
    const int fr = lane & 15, fq = lane >> 4;
    f32x4 acc = {0.f, 0.f, 0.f, 0.f};
#pragma unroll
    for (int s = 0; s < 4; ++s) { const int off = fr * TH_STR + (32 * (4 * wave + s) + 8 * fq) * 2;
        const bf16x8 ahi = *(LAS const bf16x8*)(L + TH_HHI + off), alo = *(LAS const bf16x8*)(L + TH_HLO + off);
        const bf16x8 bhi = *(LAS const bf16x8*)(L + TH_THI + off), blo = *(LAS const bf16x8*)(L + TH_TLO + off);
        acc = __builtin_amdgcn_mfma_f32_16x16x32_bf16(ahi, bhi, acc, 0, 0, 0);
        acc = __builtin_amdgcn_mfma_f32_16x16x32_bf16(ahi, blo, acc, 0, 0, 0);
        acc = __builtin_amdgcn_mfma_f32_16x16x32_bf16(alo, bhi, acc, 0, 0, 0); }
    LAS float* P = (LAS float*)(L + TH_PART) + wave * 256;
#pragma unroll
    for (int t2 = 0; t2 < 4; ++t2) P[(4 * fq + t2) * 16 + fr] = acc[t2];
}
__device__ __forceinline__ float thin_total(LAS unsigned char* L, int tid) {
    LAS const float* P = (LAS const float*)(L + TH_PART) + tid; float s = 0.f;
#pragma unroll
    for (int w = 0; w < 8; ++w) s += P[w * 256];
    return s;
}
__device__ __forceinline__ void p1_gather_issue(u32x2 (&wa)[4][4], u32x2 (&wb)[4][4], unsigned& maska, unsigned& maskb, int inva, int invb, const bf16_t* Yp, const bf16_t* zrow, int lane) {
    maska = (unsigned)__ballot(inva >= 0) & 0xffffu; maskb = (unsigned)__ballot(invb >= 0) & 0xffffu;
    const bf16_t* ypa[4]; const bf16_t* ypb[4];
#pragma unroll
    for (int q = 0; q < 4; ++q) {
        if (maska) { const int e = __builtin_ctz(maska); maska &= maska - 1; ypa[q] = Yp + (size_t)shl_from_i(inva, e) * D; } else ypa[q] = zrow;
        if (maskb) { const int e = __builtin_ctz(maskb); maskb &= maskb - 1; ypb[q] = Yp + (size_t)shl_from_i(invb, e) * D; } else ypb[q] = zrow; }
#pragma unroll
    for (int q = 0; q < 4; ++q)
#pragma unroll
        for (int j = 0; j < 4; ++j) { wa[q][j] = *(const u32x2*)(ypa[q] + 4 * (lane + 64 * j)); wb[q][j] = *(const u32x2*)(ypb[q] + 4 * (lane + 64 * j)); }
}
__device__ __forceinline__ void p1_gather_consume(f32x4 (&va)[4], f32x4 (&vb)[4], u32x2 (&wa)[4][4], u32x2 (&wb)[4][4], unsigned maska, unsigned maskb, int inva, int invb,
                                                  const bf16_t* Yp, const bf16_t* zrow, const f32x4 (&g2)[4], int lane) {
    f32x4 aa[4], ab[4];
#pragma unroll
    for (int j = 0; j < 4; ++j) { aa[j] = (f32x4){0.f, 0.f, 0.f, 0.f}; ab[j] = (f32x4){0.f, 0.f, 0.f, 0.f}; }
    for (;;) {
#pragma unroll
        for (int q = 0; q < 4; ++q)
#pragma unroll
            for (int j = 0; j < 4; ++j) { aa[j] += (f32x4){bflo(wa[q][j].x), bfhi(wa[q][j].x), bflo(wa[q][j].y), bfhi(wa[q][j].y)};
                ab[j] += (f32x4){bflo(wb[q][j].x), bfhi(wb[q][j].x), bflo(wb[q][j].y), bfhi(wb[q][j].y)}; }
        if (!(maska | maskb)) break;
        const bf16_t* ypa[4]; const bf16_t* ypb[4];
#pragma unroll
        for (int q = 0; q < 4; ++q) {
            if (maska) { const int e = __builtin_ctz(maska); maska &= maska - 1; ypa[q] = Yp + (size_t)shl_from_i(inva, e) * D; } else ypa[q] = zrow;
            if (maskb) { const int e = __builtin_ctz(maskb); maskb &= maskb - 1; ypb[q] = Yp + (size_t)shl_from_i(invb, e) * D; } else ypb[q] = zrow; }
#pragma unroll
        for (int q = 0; q < 4; ++q)
#pragma unroll
            for (int j = 0; j < 4; ++j) { wa[q][j] = *(const u32x2*)(ypa[q] + 4 * (lane + 64 * j)); wb[q][j] = *(const u32x2*)(ypb[q] + 4 * (lane + 64 * j)); }
    }
#pragma unroll
    for (int j = 0; j < 4; ++j) { va[j] += aa[j] * g2[j]; vb[j] += ab[j] * g2[j]; }
}
__device__ __forceinline__ void thin16x2(float (&d0)[16], float (&d1)[16], const f32x4 (&h0)[4], const f32x4 (&h1)[4], LAS const float* T, int lane) {
#pragma unroll
    for (int cg = 0; cg < 8; ++cg) {
#pragma unroll
        for (int cc = 0; cc < 2; ++cc) { const int c = 2 * cg + cc; float a0 = 0.f, a1 = 0.f;
#pragma unroll
            for (int j = 0; j < 4; ++j) { const f32x4 t = *(LAS const f32x4*)(T + c * 1024 + 4 * (lane + 64 * j));
                a0 += h0[j][0] * t[0] + h0[j][1] * t[1] + h0[j][2] * t[2] + h0[j][3] * t[3];
                a1 += h1[j][0] * t[0] + h1[j][1] * t[1] + h1[j][2] * t[2] + h1[j][3] * t[3]; }
            d0[c] = a0; d1[c] = a1; }
        asm volatile("" ::: "memory");
    }
}
__device__ __forceinline__ void p1_norm1(const Frame& F, int layer, int probe_rerun) {
    const bool fin = (layer == DEPTH);
    if (layer == 0 && !probe_rerun) { cvt_small(F, layer); __syncthreads(); }
    if (!fin) load_thin_T_bf(F, F_WT + (size_t)(layer * 2 + 0) * 16384, F.lds);
    const int gw = F.blk * NWAVES + F.wave, NGW = F.G * NWAVES, lane = F.lane;
    const int nrows = fin ? NL : NT;
    const int RW = 2 * ((nrows + 2 * NGW - 1) / (2 * NGW)), rbeg = gw * RW;
    const float* modl = F_MOD + (size_t)(fin ? 0 : layer) * 17 * 6144;
    const float* modp = F_MOD + (size_t)(layer > 0 ? layer - 1 : 0) * 17 * 6144;
    const float* n1w = INP(I_N1W) + (size_t)(fin ? 0 : layer) * D;
    float* const outp = OUTP(); bf16_t* const xb = F_XB; const bool srcf32 = (layer == 0 && !probe_rerun);
    const float* const srcl = INP(I_X); const float* const srcc = INP(I_CTX);
    const int* const invp = F_INV; const bf16_t* const Yp = F_Y; signed char* const HQp = F_HAQ; float* const SAp = F_SAH; float* const DTp = F_DT;
    const bf16_t* const zrow = (const bf16_t*)(F_CTL + CW_ZERO);
    const float* const dtbf = INP(I_DTBF) + (fin ? 0 : layer) * 8; const float* const dtbb = INP(I_DTBB) + (fin ? 0 : layer) * 8;
    const bool comb = (layer > 0 && !probe_rerun);
    f32x4 nva[4], nvb[4]; int nia = -1, nib = -1;
    f32x4 W1[4], S0[4], G2[4]; int cur_m = -1;
#pragma unroll
    for (int j = 0; j < 4; ++j) { W1[j] = (f32x4){0.f, 0.f, 0.f, 0.f}; S0[j] = W1[j]; G2[j] = W1[j]; }
#define P1_SRC(r) (((r) < NL) ? srcl + (size_t)(r) * D : srcc + (size_t)((r) - NL) * D)
#define P1_PRELOAD(r) do { const int ra_ = ((r) < nrows) ? (r) : 0, rb_ = ra_ + 1; \
        if (srcf32) { const float* sa_ = P1_SRC(ra_); const float* sb_ = P1_SRC(rb_); \
            _Pragma("unroll") for (int j = 0; j < 4; ++j) { nva[j] = *(const f32x4*)(sa_ + 4 * (lane + 64 * j)); nvb[j] = *(const f32x4*)(sb_ + 4 * (lane + 64 * j)); } } \
        else { const bf16_t* sa_ = xb + (size_t)ra_ * D; const bf16_t* sb_ = xb + (size_t)rb_ * D; \
            _Pragma("unroll") for (int j = 0; j < 4; ++j) { const u32x2 ta_ = *(const u32x2*)(sa_ + 4 * (lane + 64 * j)), tb_ = *(const u32x2*)(sb_ + 4 * (lane + 64 * j)); \
                nva[j][0] = __uint_as_float(ta_.x); nva[j][1] = __uint_as_float(ta_.y); nvb[j][0] = __uint_as_float(tb_.x); nvb[j][1] = __uint_as_float(tb_.y); } } \
        nia = (comb && lane < 16) ? invp[(size_t)ra_ * 16 + lane] : -1; nib = (comb && lane < 16) ? invp[(size_t)rb_ * 16 + lane] : -1; } while (0)
    P1_PRELOAD(rbeg);
    for (int pi = 0; pi < RW / 2; ++pi) {
        const int row0 = rbeg + 2 * pi; const bool vR = row0 < nrows; const int rowA = vR ? row0 : 0, rowB = rowA + 1;
        const int mR = (rowA < NL) ? (rowA >> 11) : 16;
        f32x4 va[4], vb[4]; const int ia = nia, ib = nib;
#pragma unroll
        for (int j = 0; j < 4; ++j) { va[j] = nva[j]; vb[j] = nvb[j]; }
        if (!srcf32) {
#pragma unroll
            for (int j = 0; j < 4; ++j) { const unsigned ax = __float_as_uint(nva[j][0]), ay = __float_as_uint(nva[j][1]), bx = __float_as_uint(nvb[j][0]), by = __float_as_uint(nvb[j][1]);
                va[j] = (f32x4){bflo(ax), bfhi(ax), bflo(ay), bfhi(ay)}; vb[j] = (f32x4){bflo(bx), bfhi(bx), bflo(by), bfhi(by)}; } }
        if (pi + 1 < RW / 2) P1_PRELOAD(row0 + 2);
        if (mR != cur_m) { cur_m = mR;
            const float* sh = modl + mR * 6144; const float* sc = sh + 1024; const float* g2 = modp + mR * 6144 + 5 * 1024;
#pragma unroll
            for (int j = 0; j < 4; ++j) { const int k = 4 * (lane + 64 * j);
                if (!fin) { W1[j] = *(const f32x4*)(n1w + k) * (*(const f32x4*)(sc + k) + 1.f); S0[j] = *(const f32x4*)(sh + k); }
                if (layer > 0) G2[j] = *(const f32x4*)(g2 + k); } }
        if (layer > 0) {
            { u32x2 gwa[4][4], gwb[4][4]; unsigned gma, gmb; p1_gather_issue(gwa, gwb, gma, gmb, ia, ib, Yp, zrow, lane); p1_gather_consume(va, vb, gwa, gwb, gma, gmb, ia, ib, Yp, zrow, G2, lane); }
            asm volatile("" ::: "memory");
            if (vR) {
            if (fin) { float* da_ = outp + (size_t)rowA * D; float* db_ = outp + (size_t)rowB * D;
#pragma unroll
                for (int j = 0; j < 4; ++j) { *(f32x4*)(da_ + 4 * (lane + 64 * j)) = va[j]; *(f32x4*)(db_ + 4 * (lane + 64 * j)) = vb[j]; } }
            else { bf16_t* da_ = xb + (size_t)rowA * D; bf16_t* db_ = xb + (size_t)rowB * D;
#pragma unroll
                for (int j = 0; j < 4; ++j) { *(u32x2*)(da_ + 4 * (lane + 64 * j)) = (u32x2){pk2(va[j][0], va[j][1]), pk2(va[j][2], va[j][3])};
                    *(u32x2*)(db_ + 4 * (lane + 64 * j)) = (u32x2){pk2(vb[j][0], vb[j][1]), pk2(vb[j][2], vb[j][3])}; } }
            }
        }
        if (fin) continue;
        float sa = 0.f, sb = 0.f;
#pragma unroll
        for (int j = 0; j < 4; ++j) { sa += va[j][0] * va[j][0] + va[j][1] * va[j][1] + va[j][2] * va[j][2] + va[j][3] * va[j][3];
            sb += vb[j][0] * vb[j][0] + vb[j][1] * vb[j][1] + vb[j][2] * vb[j][2] + vb[j][3] * vb[j][3]; }
        sa = wave_sum_dpp(sa); sb = wave_sum_dpp(sb);
        float ma = 0.f, mb = 0.f;
        { const float rsa = rsqrtf(sa * (1.f / D) + EPS), rsb = rsqrtf(sb * (1.f / D) + EPS);
#pragma unroll
          for (int j = 0; j < 4; ++j) {
              const f32x4 ha = va[j] * rsa * W1[j] + S0[j], hb = vb[j] * rsb * W1[j] + S0[j];
              ma = fmaxf(fmaxf(ma, fmaxf(fabsf(ha[0]), fabsf(ha[1]))), fmaxf(fabsf(ha[2]), fabsf(ha[3])));
              mb = fmaxf(fmaxf(mb, fmaxf(fabsf(hb[0]), fabsf(hb[1]))), fmaxf(fabsf(hb[2]), fabsf(hb[3])));
              va[j] = ha; vb[j] = hb; } }
        ma = wave_max_dpp(ma); mb = wave_max_dpp(mb);
        if (vR) { const float ia = ma > 0.f ? 127.f / ma : 0.f, ib = mb > 0.f ? 127.f / mb : 0.f;
#pragma unroll
          for (int j = 0; j < 4; ++j) { const int k = 4 * (lane + 64 * j);
              const unsigned qa = pack_i8x4(va[j][0], va[j][1], va[j][2], va[j][3], ia), qb = pack_i8x4(vb[j][0], vb[j][1], vb[j][2], vb[j][3], ib);
              *(unsigned*)(HQp + (size_t)rowA * D + k) = qa; *(unsigned*)(HQp + (size_t)rowB * D + k) = qb; }
          if (lane == 0) { SAp[rowA] = ma * (1.f / 127.f); SAp[rowB] = mb * (1.f / 127.f); } }
        asm volatile("" ::: "memory");
        thin_stage_row(F.lds, 2 * F.wave, va, lane); thin_stage_row(F.lds, 2 * F.wave + 1, vb, lane);
        lds_barrier();
        thin_mfma_partial(F.lds, F.wave, lane);
        lds_barrier();
        if (F.wave < 4) { const int t16 = F.wave * 64 + lane, srow = t16 >> 4, c = t16 & 15; const float tot = thin_total(F.lds, t16);
            const float bias = (c < 8) ? dtbf[c] : dtbb[c - 8]; const int grow = (F.blk * NWAVES + (srow >> 1)) * RW + 2 * pi + (srow & 1);
            if (grow < nrows) DTp[(size_t)grow * 16 + c] = softplus_f(tot + bias); }
    }
#undef P1_PRELOAD
#undef P1_SRC
}

__device__ __forceinline__ void p7_finish_row(float tot, int lane, int row, float* AFFp) {
    float lg[16]; float mx = -INFINITY;
#pragma unroll
    for (int c = 0; c < 16; ++c) { lg[c] = shl_from(tot, laneof16(c)); mx = fmaxf(mx, lg[c]); }
    float se = 0.f;
#pragma unroll
    for (int c = 0; c < 16; ++c) { lg[c] = __expf(lg[c] - mx); se += lg[c]; }
    float mine = 0.f;
#pragma unroll
    for (int c = 0; c < 16; ++c) mine = (lane == c) ? lg[c] : mine;
    if (lane < 16) {
        const float a = mine / se;
        if (row < NL) AFFp[((size_t)((row >> 11) * 16 + lane)) * 2048 + (row & 2047)] = a;
        else { const int r = row - NL; AFFp[(size_t)NL * 16 + ((size_t)((r >> 8) * 16 + lane)) * 256 + (r & 255)] = a; }
    }
}
__device__ __forceinline__ void p7_norm2(const Frame& F, int layer) {
    load_thin_T_bf(F, F_WT + (size_t)(layer * 2 + 1) * 16384, F.lds);
    const int gw = F.blk * NWAVES + F.wave, NGW = F.G * NWAVES, lane = F.lane;
    const int nrows = (layer < DEPTH - 1) ? NT : NL;
    const int RW = 2 * ((nrows + 2 * NGW - 1) / (2 * NGW)), rbeg = gw * RW;
    const float* modl = F_MOD + (size_t)layer * 17 * 6144;
    const float* n2w = INP(I_N2W) + (size_t)layer * D;
    const bf16_t* const xb = F_XB; signed char* const HQp = F_HQ; float* const SAp = F_SA; float* const AFFp = F_AFF;
    u32x2 nva[4], nvb[4];
    f32x4 W1[4], S0[4]; int cur_m = -1;
#pragma unroll
    for (int j = 0; j < 4; ++j) { W1[j] = (f32x4){0.f, 0.f, 0.f, 0.f}; S0[j] = W1[j]; }
#define P7_PRELOAD(r) do { const int ra_ = ((r) < nrows) ? (r) : 0; const bf16_t* sa_ = xb + (size_t)ra_ * D; const bf16_t* sb_ = sa_ + D; \
        _Pragma("unroll") for (int j = 0; j < 4; ++j) { nva[j] = *(const u32x2*)(sa_ + 4 * (lane + 64 * j)); nvb[j] = *(const u32x2*)(sb_ + 4 * (lane + 64 * j)); } } while (0)
    P7_PRELOAD(rbeg);
    for (int pi = 0; pi < RW / 2; ++pi) {
        const int row0 = rbeg + 2 * pi; const bool vR = row0 < nrows; const int rowA = vR ? row0 : 0, rowB = rowA + 1;
        const int mR = (rowA < NL) ? (rowA >> 11) : 16;
        f32x4 va[4], vb[4]; float sa = 0.f, sb = 0.f;
#pragma unroll
        for (int j = 0; j < 4; ++j) { va[j] = (f32x4){bflo(nva[j].x), bfhi(nva[j].x), bflo(nva[j].y), bfhi(nva[j].y)}; vb[j] = (f32x4){bflo(nvb[j].x), bfhi(nvb[j].x), bflo(nvb[j].y), bfhi(nvb[j].y)};
            sa += va[j][0] * va[j][0] + va[j][1] * va[j][1] + va[j][2] * va[j][2] + va[j][3] * va[j][3];
            sb += vb[j][0] * vb[j][0] + vb[j][1] * vb[j][1] + vb[j][2] * vb[j][2] + vb[j][3] * vb[j][3]; }
        if (pi + 1 < RW / 2) P7_PRELOAD(row0 + 2);
        if (mR != cur_m) { cur_m = mR; const float* sh = modl + mR * 6144 + 3 * 1024; const float* sc = sh + 1024;
#pragma unroll
            for (int j = 0; j < 4; ++j) { const int k = 4 * (lane + 64 * j); W1[j] = *(const f32x4*)(n2w + k) * (*(const f32x4*)(sc + k) + 1.f); S0[j] = *(const f32x4*)(sh + k); } }
        sa = wave_sum_dpp(sa); sb = wave_sum_dpp(sb);
        float ma = 0.f, mb = 0.f;
        { const float rsa = rsqrtf(sa * (1.f / D) + EPS), rsb = rsqrtf(sb * (1.f / D) + EPS);
#pragma unroll
          for (int j = 0; j < 4; ++j) {
              const f32x4 ha = va[j] * rsa * W1[j] + S0[j], hb = vb[j] * rsb * W1[j] + S0[j];
              ma = fmaxf(fmaxf(ma, fmaxf(fabsf(ha[0]), fabsf(ha[1]))), fmaxf(fabsf(ha[2]), fabsf(ha[3])));
              mb = fmaxf(fmaxf(mb, fmaxf(fabsf(hb[0]), fabsf(hb[1]))), fmaxf(fabsf(hb[2]), fabsf(hb[3])));
              va[j] = ha; vb[j] = hb; } }
        ma = wave_max_dpp(ma); mb = wave_max_dpp(mb);
        if (vR) { const float ia = ma > 0.f ? 127.f / ma : 0.f, ib = mb > 0.f ? 127.f / mb : 0.f;
#pragma unroll
          for (int j = 0; j < 4; ++j) { const int k = 4 * (lane + 64 * j);
              const unsigned qa = pack_i8x4(va[j][0], va[j][1], va[j][2], va[j][3], ia), qb = pack_i8x4(vb[j][0], vb[j][1], vb[j][2], vb[j][3], ib);
              *(unsigned*)(HQp + (size_t)rowA * D + k) = qa; *(unsigned*)(HQp + (size_t)rowB * D + k) = qb; }
          if (lane == 0) { SAp[rowA] = ma * (1.f / 127.f); SAp[rowB] = mb * (1.f / 127.f); } }
        asm volatile("" ::: "memory");
        thin_stage_row(F.lds, 2 * F.wave, va, lane); thin_stage_row(F.lds, 2 * F.wave + 1, vb, lane);
        lds_barrier();
        thin_mfma_partial(F.lds, F.wave, lane);
        lds_barrier();
        if (F.wave < 4) { const int t16 = F.wave * 64 + lane, srow = t16 >> 4, c = t16 & 15; const float lg = thin_total(F.lds, t16);
            float mx = lg;
#pragma unroll
            for (int o = 1; o < 16; o <<= 1) mx = fmaxf(mx, shx(mx, o, lane));
            const float ex = __expf(lg - mx); float se = ex;
#pragma unroll
            for (int o = 1; o < 16; o <<= 1) se += shx(se, o, lane);
            const int row = (F.blk * NWAVES + (srow >> 1)) * RW + 2 * pi + (srow & 1);
            if (row < nrows) { const float a = ex / se;
                if (row < NL) AFFp[((size_t)((row >> 11) * 16 + c)) * 2048 + (row & 2047)] = a;
                else { const int r = row - NL; AFFp[(size_t)NL * 16 + ((size_t)((r >> 8) * 16 + c)) * 256 + (r & 255)] = a; } } }
    }
#undef P7_PRELOAD
}

__device__ __forceinline__ void p5_ssd_post(const Frame& F, int layer) {
    const int gw = F.blk * NWAVES + F.wave, NGW = F.G * NWAVES, lane = F.lane;
    const int nrows = (layer < DEPTH - 1) ? NT : NL;
    const int c0 = 8 * lane;
    const float dsk = INP(I_DSKIP)[layer * 8 + (c0 >> 6)];
    const f32x4 w0 = *(const f32x4*)(INP(I_SSDNW) + layer * 512 + c0), w1 = *(const f32x4*)(INP(I_SSDNW) + layer * 512 + c0 + 4);
    const bf16_t* const YFp = F_YF; const bf16_t* const YBp = F_YB; const bf16_t* const XSp = F_XBCC; const bf16_t* const Zp = F_Z; bf16_t* const A2p = F_A2;
    u32x4 nyf[2], nyb[2], nxs[2], nz[2];
#define P5_LOAD(rr_) do { _Pragma("unroll") for (int q = 0; q < 2; ++q) { const int row = (rr_) + q; \
            nyf[q] = *(const u32x4*)(YFp + (size_t)row * 512 + c0); nyb[q] = *(const u32x4*)(YBp + (size_t)row * 512 + c0); \
            nxs[q] = *(const u32x4*)(XSp + (size_t)row * 1024 + c0); nz[q] = *(const u32x4*)(Zp + (size_t)row * 512 + c0); } } while (0)
    if (2 * gw < nrows) P5_LOAD(2 * gw);
    for (int r0 = 2 * gw; r0 < nrows; r0 += 2 * NGW) {
        u32x4 yf[2], yb[2], xs[2], z[2];
#pragma unroll
        for (int q = 0; q < 2; ++q) { yf[q] = nyf[q]; yb[q] = nyb[q]; xs[q] = nxs[q]; z[q] = nz[q]; }
        if (r0 + 2 * NGW < nrows) P5_LOAD(r0 + 2 * NGW);
#pragma unroll
        for (int q = 0; q < 2; ++q) { const int row = r0 + q;
            float g[8]; float ss = 0.f;
#pragma unroll
            for (int i = 0; i < 4; ++i) {
                const float y0 = bflo(yf[q][i]) + bflo(yb[q][i]) + dsk * bflo(xs[q][i]), y1 = bfhi(yf[q][i]) + bfhi(yb[q][i]) + dsk * bfhi(xs[q][i]);
                const float z0 = bflo(z[q][i]), z1 = bfhi(z[q][i]);
                g[2 * i] = y0 * z0 * __builtin_amdgcn_rcpf(1.f + __expf(-z0)); g[2 * i + 1] = y1 * z1 * __builtin_amdgcn_rcpf(1.f + __expf(-z1)); ss += g[2 * i] * g[2 * i] + g[2 * i + 1] * g[2 * i + 1]; }
#pragma unroll
            for (int o = 1; o < 32; o <<= 1) ss += shx(ss, o, lane);
            const float rstd = rsqrtf(ss * (1.f / 256.f) + EPS);
            u32x4 o; o.x = pk2(g[0] * rstd * w0[0], g[1] * rstd * w0[1]); o.y = pk2(g[2] * rstd * w0[2], g[3] * rstd * w0[3]);
            o.z = pk2(g[4] * rstd * w1[0], g[5] * rstd * w1[1]); o.w = pk2(g[6] * rstd * w1[2], g[7] * rstd * w1[3]);
            *(u32x4*)(A2p + (size_t)row * 1024 + 512 + c0) = o; }
    }
#undef P5_LOAD
}

struct EpiInProj {
    static constexpr bool PERM = false, AFTER_DRAIN = false;
    unsigned char* U; const float* qkw; const float* ropec; const float* ropes; const float* sah; const float* swin;
    __device__ __forceinline__ void operator()(const pg8::i32x4 (&acc)[2][2][4][2], const Unit& u, int wr, int wc, int fr, int fq) const {
        const int pn = u.pn;
        f32x4 swv[2][2];
#pragma unroll
        for (int bj = 0; bj < 2; ++bj)
#pragma unroll
            for (int n = 0; n < 2; ++n) swv[bj][n] = *(const f32x4*)(swin + pn * 256 + 128 * bj + 32 * wc + 16 * n + 4 * fq);
        if (pn < 4) {
            const bool isq = pn < 2; bf16_t* base = (bf16_t*)(U + (isq ? U_Q : U_K)); const float* nw = qkw + (isq ? 0 : 64); const float osc = isq ? 0.125f * LOG2E : 1.f;
            const int hg = 4 * (pn & 1) + wc;
            f32x4 w[2][2];
#pragma unroll
            for (int bj = 0; bj < 2; ++bj)
#pragma unroll
                for (int n = 0; n < 2; ++n) w[bj][n] = *(const f32x4*)(nw + 32 * bj + 16 * n + 4 * fq);
#pragma unroll
            for (int ai = 0; ai < 2; ++ai)
#pragma unroll
                for (int m = 0; m < 4; ++m) {
                    const int row = u.pm * 256 + ai * 128 + wr * 64 + m * 16 + fr;
                    float ss = 0.f; const float sa = sah[row]; f32x4 xf[2][2];
#pragma unroll
                    for (int bj = 0; bj < 2; ++bj)
#pragma unroll
                        for (int n = 0; n < 2; ++n) { f32x4 x;
#pragma unroll
                            for (int i = 0; i < 4; ++i) x[i] = (float)acc[ai][bj][m][n][i] * (sa * swv[bj][n][i]);
                            xf[bj][n] = x; ss += x[0] * x[0] + x[1] * x[1] + x[2] * x[2] + x[3] * x[3]; }
                    { const int ln = fq * 16 + fr; ss += shx(ss, 16, ln); ss += shx(ss, 32, ln); }
                    const float rstd = rsqrtf(ss * (1.f / 64.f) + EPS);
                    const bool lat = row < NL; const int tok = row & 2047;
#pragma unroll
                    for (int bj = 0; bj < 2; ++bj) {
                        f32x4 x1 = xf[bj][0] * rstd * w[bj][0], x2 = xf[bj][1] * rstd * w[bj][1];
                        if (lat) { const int pos = bj ? (tok & 63) : (tok >> 6); const f32x4 c = *(const f32x4*)(ropec + pos * 16 + 4 * fq), s = *(const f32x4*)(ropes + pos * 16 + 4 * fq);
                            const f32x4 o1 = x1 * c - x2 * s, o2 = x1 * s + x2 * c; x1 = o1; x2 = o2; }
                        x1 = x1 * osc; x2 = x2 * osc;
                        bf16_t* p = base + (size_t)row * 512 + 64 * hg + 32 * bj + 4 * fq;
                        *(u32x2*)p = (u32x2){pk2(x1[0], x1[1]), pk2(x1[2], x1[3])};
                        *(u32x2*)(p + 16) = (u32x2){pk2(x2[0], x2[1]), pk2(x2[2], x2[3])};
                    }
                }
        } else {
            size_t boff; int cb, ldc;
            if (pn < 6) { boff = U_V; cb = 256 * (pn - 4); ldc = 512; } else if (pn < 8) { boff = U_Z; cb = 256 * (pn - 6); ldc = 512; } else { boff = U_XBC; cb = 256 * (pn - 8); ldc = 1024; }
            bf16_t* base = (bf16_t*)(U + boff);
#pragma unroll
            for (int ai = 0; ai < 2; ++ai)
#pragma unroll
                for (int m = 0; m < 4; ++m) {
                    const int row = u.pm * 256 + ai * 128 + wr * 64 + m * 16 + fr; const float sa = sah[row];
#pragma unroll
                    for (int bj = 0; bj < 2; ++bj) { f32x4 x0, x1;
#pragma unroll
                        for (int i = 0; i < 4; ++i) { x0[i] = (float)acc[ai][bj][m][0][i] * (sa * swv[bj][0][i]); x1[i] = (float)acc[ai][bj][m][1][i] * (sa * swv[bj][1][i]); }
                        *(u32x4*)(base + (size_t)row * ldc + cb + 128 * bj + 32 * wc + 8 * fq) = pack8(x0, x1); }
                }
        }
    }
};
struct EpiOutProj {
    static constexpr bool PERM = false, AFTER_DRAIN = false;
    const float* sl; const float* sc; bf16_t* xb; const float* modl; float gscale; bool first;
    __device__ __forceinline__ void operator()(const f32x4 (&acc)[2][2][4][2], const Unit& u, int wr, int wc, int fr, int fq) const {
        const int row_t = u.pm * 256; const bool lat = row_t < NL; const int mrow = lat ? (row_t >> 11) : 16;
        const float* g = modl + mrow * 6144 + 2048;
        f32x4 gv[2][2];
#pragma unroll
        for (int bj = 0; bj < 2; ++bj)
#pragma unroll
            for (int n = 0; n < 2; ++n) gv[bj][n] = *(const f32x4*)(g + u.pn * 256 + 128 * bj + 32 * wc + 8 * fq + 4 * n) * gscale;
        if (first) {
            const float* xs = lat ? sl : sc - (size_t)NL * D;
#pragma unroll
            for (int ai = 0; ai < 2; ++ai) {
                f32x4 xv[4][2][2];
#pragma unroll
                for (int m = 0; m < 4; ++m) { const size_t ro = (size_t)(row_t + ai * 128 + wr * 64 + m * 16 + fr) * D + u.pn * 256 + 32 * wc + 8 * fq;
#pragma unroll
                    for (int bj = 0; bj < 2; ++bj)
#pragma unroll
                        for (int n = 0; n < 2; ++n) xv[m][bj][n] = *(const f32x4*)(xs + ro + 128 * bj + 4 * n); }
#pragma unroll
                for (int m = 0; m < 4; ++m) { const size_t ro = (size_t)(row_t + ai * 128 + wr * 64 + m * 16 + fr) * D + u.pn * 256 + 32 * wc + 8 * fq;
#pragma unroll
                    for (int bj = 0; bj < 2; ++bj) *(u32x4*)(xb + ro + 128 * bj) = pack8(xv[m][bj][0] + gv[bj][0] * acc[ai][bj][m][0], xv[m][bj][1] + gv[bj][1] * acc[ai][bj][m][1]); }
            }
        } else {
#pragma unroll
            for (int ai = 0; ai < 2; ++ai) {
                u32x4 xr[4][2];
#pragma unroll
                for (int m = 0; m < 4; ++m) { const size_t ro = (size_t)(row_t + ai * 128 + wr * 64 + m * 16 + fr) * D + u.pn * 256 + 32 * wc + 8 * fq;
#pragma unroll
                    for (int bj = 0; bj < 2; ++bj) xr[m][bj] = *(const u32x4*)(xb + ro + 128 * bj); }
#pragma unroll
                for (int m = 0; m < 4; ++m) { const size_t ro = (size_t)(row_t + ai * 128 + wr * 64 + m * 16 + fr) * D + u.pn * 256 + 32 * wc + 8 * fq;
#pragma unroll
                    for (int bj = 0; bj < 2; ++bj) { const u32x4 r = xr[m][bj];
                        const f32x4 x0 = {bflo(r.x), bfhi(r.x), bflo(r.y), bfhi(r.y)}, x1 = {bflo(r.z), bfhi(r.z), bflo(r.w), bfhi(r.w)};
                        *(u32x4*)(xb + ro + 128 * bj) = pack8(x0 + gv[bj][0] * acc[ai][bj][m][0], x1 + gv[bj][1] * acc[ai][bj][m][1]); } }
            }
        }
    }
};
struct EpiMoe1 {
    static constexpr bool PERM = false, AFTER_DRAIN = false;
    bf16_t* HID; const float* sw; const float* say;
    __device__ __forceinline__ void operator()(const pg8::i32x4 (&acc)[2][2][4][2], const Unit& u, int wr, int wc, int fr, int fq) const {
        const int j = u.pn % 11;
        f32x4 sg[2], su[2];
#pragma unroll
        for (int n = 0; n < 2; ++n) { sg[n] = *(const f32x4*)(sw + (size_t)u.pn * 256 + 32 * wc + 16 * n + 4 * fq); su[n] = *(const f32x4*)(sw + (size_t)u.pn * 256 + 128 + 32 * wc + 16 * n + 4 * fq); }
#pragma unroll
        for (int ai = 0; ai < 2; ++ai)
#pragma unroll
            for (int m = 0; m < 4; ++m) {
                const int row = u.pm * 256 + ai * 128 + wr * 64 + m * 16 + fr; const float sa = say[row];
                f32x4 h0, h1;
#pragma unroll
                for (int i = 0; i < 4; ++i) { const float g0 = (float)acc[ai][0][m][0][i] * (sa * sg[0][i]), g1 = (float)acc[ai][0][m][1][i] * (sa * sg[1][i]);
                    const float u0 = (float)acc[ai][1][m][0][i] * (sa * su[0][i]), u1 = (float)acc[ai][1][m][1][i] * (sa * su[1][i]);
                    h0[i] = g0 * __builtin_amdgcn_rcpf(1.f + __expf(-g0)) * u0; h1[i] = g1 * __builtin_amdgcn_rcpf(1.f + __expf(-g1)) * u1; }
                *(u32x4*)(HID + (size_t)row * DE + 128 * j + 32 * wc + 8 * fq) = pack8(h0, h1);
            }
    }
};
struct EpiMoe2 {
    static constexpr bool PERM = false, AFTER_DRAIN = false;
    bf16_t* Y; const float* gate;
    __device__ __forceinline__ void operator()(const f32x4 (&acc)[2][2][4][2], const Unit& u, int wr, int wc, int fr, int fq) const {
        const int jn = u.pn & 3;
#pragma unroll
        for (int ai = 0; ai < 2; ++ai)
#pragma unroll
            for (int m = 0; m < 4; ++m) {
                const int row = u.pm * 256 + ai * 128 + wr * 64 + m * 16 + fr; const float gt = gate[row];
#pragma unroll
                for (int bj = 0; bj < 2; ++bj) *(u32x4*)(Y + (size_t)row * D + 256 * jn + 128 * bj + 32 * wc + 8 * fq) = pack8(acc[ai][bj][m][0] * gt, acc[ai][bj][m][1] * gt);
            }
    }
};
struct SchedMoe1 {
    int G, c, ctx;
    __device__ __forceinline__ bool next(int i, Unit& u) const {
        if (G & 7) { const int L = i * G + c, nt = ctx ? 3168 : 2816; if (L >= nt) return false;
            if (L < 2816) { const int e = L / 176, rem = L % 176, j = rem >> 4, b = rem & 15; u.pm = b * 16 + e; u.pn = e * 11 + j; }
            else { const int LL = L - 2816, e = LL / 22, rem = LL % 22, j = rem >> 1, hf = rem & 1; u.pm = 256 + 2 * e + hf; u.pn = e * 11 + j; }
            return true; }
        const int W = G >> 3, x = c & 7, q = i * W + (c >> 3), nq = ctx ? 396 : 352;
        if (q >= nq) return false;
        if (q < 352) { const int el = q / 176, rem = q % 176, bg = rem / 44, rem2 = rem % 44, j = rem2 >> 2, bb = rem2 & 3, e = 2 * x + el, b = 4 * bg + bb; u.pm = b * 16 + e; u.pn = e * 11 + j; }
        else { const int qq = q - 352, el = qq / 22, rem = qq % 22, j = rem >> 1, hf = rem & 1, e = 2 * x + el; u.pm = 256 + 2 * e + hf; u.pn = e * 11 + j; }
        return true;
    }
    __device__ __forceinline__ void a_ready(const Unit&) const {}
    __device__ __forceinline__ void done(const Unit&) const {}
};
struct SchedMoe2 {
    int G, c, ctx;
    __device__ __forceinline__ bool next(int i, Unit& u) const {
        if (G & 7) { const int L = i * G + c, nt = ctx ? 1152 : 1024; if (L >= nt) return false;
            if (L < 1024) { const int e = L >> 6, rem = L & 63, j = rem >> 4, b = rem & 15; u.pm = b * 16 + e; u.pn = e * 4 + j; }
            else { const int LL = L - 1024, e = LL >> 3, rem = LL & 7, j = rem >> 1, hf = rem & 1; u.pm = 256 + 2 * e + hf; u.pn = e * 4 + j; }
            return true; }
        const int W = G >> 3, x = c & 7, q = i * W + (c >> 3), nq = ctx ? 144 : 128;
        if (q >= nq) return false;
        if (q < 128) { const int el = q >> 6, rem = q & 63, bg = rem >> 5, j = (rem & 31) >> 3, bb = rem & 7, e = 2 * x + el, b = 8 * bg + bb; u.pm = b * 16 + e; u.pn = e * 4 + j; }
        else { const int qq = q - 128, el = qq >> 3, rem = qq & 7, j = rem >> 1, hf = rem & 1, e = 2 * x + el; u.pm = 256 + 2 * e + hf; u.pn = e * 4 + j; }
        return true;
    }
    __device__ __forceinline__ void a_ready(const Unit&) const {}
    __device__ __forceinline__ void done(const Unit&) const {}
};

__device__ __forceinline__ void chunk_rows(int chunk, int& row0, int& slo, int& shi) {
    if (chunk < 256) { const int b = chunk >> 4, c = chunk & 15; slo = b * SEQ; shi = slo + SEQ; row0 = slo + 128 * c; }
    else { const int cc = chunk - 256, b = cc >> 1, c = cc & 1; slo = NL + b * CTXL; shi = slo + CTXL; row0 = slo + 128 * c; }
}
struct ConvW { f32x4 w[3][2]; f32x4 b[2]; };
__device__ __forceinline__ void conv_load_w(ConvW& cw, const float* convw, const float* convb, int ch0) {
#pragma unroll
    for (int t = 0; t < 3; ++t) { cw.w[t][0] = *(const f32x4*)(convw + t * 1024 + ch0); cw.w[t][1] = *(const f32x4*)(convw + t * 1024 + ch0 + 4); }
    cw.b[0] = *(const f32x4*)(convb + ch0); cw.b[1] = *(const f32x4*)(convb + ch0 + 4);
}
__device__ __forceinline__ float silu_fast(float x) { return x * __builtin_amdgcn_rcpf(1.f + __expf(-x)); }
__device__ __forceinline__ u32x4 conv8v(const ConvW& cw, const u32x4 xp, const u32x4 xc, const u32x4 xn) {
    float o[8];
#pragma unroll
    for (int i = 0; i < 4; ++i) {
        const int h = i >> 1, k = 2 * (i & 1);
        const float a0 = cw.b[h][k] + cw.w[0][h][k] * bflo(xp[i]) + cw.w[1][h][k] * bflo(xc[i]) + cw.w[2][h][k] * bflo(xn[i]);
        const float a1 = cw.b[h][k + 1] + cw.w[0][h][k + 1] * bfhi(xp[i]) + cw.w[1][h][k + 1] * bfhi(xc[i]) + cw.w[2][h][k + 1] * bfhi(xn[i]);
        o[2 * i] = silu_fast(a0); o[2 * i + 1] = silu_fast(a1);
    }
    u32x4 r; r.x = pk2(o[0], o[1]); r.y = pk2(o[2], o[3]); r.z = pk2(o[4], o[5]); r.w = pk2(o[6], o[7]); return r;
}
constexpr int CV_STRIDE = 272;
template <int R, bool TO_LDS>
__device__ __forceinline__ void conv_rows(const ConvW& cw, const bf16_t* __restrict__ XBCp, bf16_t* __restrict__ XBCCp, int rfirst, int row0, int slo, int shi, int ch0, LAS unsigned char* T, int tcol) {
    u32x4 x[R + 2];
#pragma unroll
    for (int i = 0; i < R + 2; ++i) { const int row = row0 + rfirst + i - 1; x[i] = (row >= slo && row < shi) ? *(const u32x4*)(XBCp + (size_t)row * 1024 + ch0) : (u32x4){0u, 0u, 0u, 0u}; }
#pragma unroll
    for (int i = 0; i < R; ++i) { const u32x4 v = conv8v(cw, x[i], x[i + 1], x[i + 2]); *(u32x4*)(XBCCp + (size_t)(row0 + rfirst + i) * 1024 + ch0) = v;
        if (TO_LDS) *(LAS u32x4*)(T + (rfirst + i) * CV_STRIDE + tcol * 16) = v; }
}
__device__ __forceinline__ void p3_conv(const Frame& F, int layer) {
    const float* convw = INP(I_CONVW) + (size_t)layer * 3 * 1024; const float* convb = INP(I_CONVB) + (size_t)layer * 1024;
    LAS unsigned char* Bt = F.lds; LAS unsigned char* Ct = F.lds + 128 * CV_STRIDE;
    const int tid = F.tid, lane = F.lane, wave = F.wave;
    const bf16_t* const XBCp = F_XBC; bf16_t* const XBCCp = F_XBCC; bf16_t* const GMp = F_GM;
    for (int u = F.blk; u < 288 * 3; u += F.G) {
        const int chunk = u / 3, part = u % 3; int row0, slo, shi; chunk_rows(chunk, row0, slo, shi);
        if (part == 0) {
            const int ch0 = 8 * (tid & 63), rg = tid >> 6; ConvW cw; conv_load_w(cw, convw, convb, ch0);
            conv_rows<16, false>(cw, XBCp, XBCCp, 16 * rg, row0, slo, shi, ch0, Bt, 0);
        } else {
            const int g = part - 1, cg = tid & 31, rg = tid >> 5;
            const int ch0 = (cg < 16) ? (512 + 128 * g + 8 * cg) : (768 + 128 * g + 8 * (cg - 16));
            ConvW cw; conv_load_w(cw, convw, convb, ch0);
            conv_rows<8, true>(cw, XBCp, XBCCp, 8 * rg, row0, slo, shi, ch0, (cg < 16) ? Bt : Ct, cg & 15);
            __syncthreads();
            bf16_t* gm = GMp + (size_t)(chunk * 2 + g) * 128 * 128;
#pragma unroll
            for (int i = 0; i < 2; ++i) { const int blk = 2 * wave + i, lb = blk >> 2, sb = blk & 3;
                f32x16 acc = {};
#pragma unroll
                for (int ks = 0; ks < 8; ++ks) acc = MFMA32(frag_rm(Ct, CV_STRIDE, 32 * lb, 16 * ks, lane), frag_rm(Bt, CV_STRIDE, 32 * sb, 16 * ks, lane), acc);
#pragma unroll
                for (int t = 0; t < 16; ++t) gm[(32 * lb + accrow(t, lane >> 5)) * 128 + 32 * sb + (lane & 31)] = f2bf(acc[t]);
            }
            __syncthreads();
        }
    }
}

constexpr int SS_XS = 0, SS_XS_STRIDE = 144;
constexpr int SS_BM = 18432;
constexpr int SS_CM = SS_BM + 34816;
constexpr int SS_GM = SS_CM + 34816;
constexpr int SS_H = SS_GM + 34816, SS_H_BYTES = 64 * 272;
constexpr int SS_SC = SS_H + SS_H_BYTES;
static_assert(SS_SC + 4 * 512 + 16 <= MISC_OFF, "ssd lds");
__device__ __forceinline__ int ssd_chunk_of(int dir, int b, int step) {
    if (dir == 0) return (step < 2) ? (256 + 2 * b + step) : (16 * b + (step - 2));
    return (step < 2) ? (256 + 2 * b + (1 - step)) : (16 * b + (17 - step));
}
__device__ __forceinline__ void ssd_unit(const Frame& F, int layer, int unit) {
    int tid_ = F.tid; asm volatile("" : "+v"(tid_));
    const int tid = tid_, lane = tid & 63, wave = __builtin_amdgcn_readfirstlane(tid >> 6);
    const int dir = unit & 1, hd = (unit >> 1) & 7, b = unit >> 4, g = hd >> 2;
    LAS unsigned char* L = F.lds;
    LAS float* acs = (LAS float*)(L + SS_SC); LAS float* dtv = acs + 128; LAS float* wrow = acs + 256; LAS float* erow = acs + 384; LAS float* aendp = acs + 512;
    const float a_coef = -__expf((dir ? INP(I_ALOGB) : INP(I_ALOGF))[layer * 8 + hd]);
    unsigned vz; asm volatile("v_mov_b32 %0, 0" : "=v"(vz));
    bf16_t* Yout = (dir ? F_YB : F_YF) + vz; const bf16_t* const XBCCp = F_XBCC + vz; const bf16_t* const GMp = F_GM + vz; const float* const DTp = F_DT + vz;
    f32x16 hacc = {};
    for (int prb = 0; prb < ((PROBE_MASK & 256) ? 2 : 1); ++prb) {
    for (int i = tid; i < SS_H_BYTES / 4; i += NTHREADS) ((LAS unsigned*)(L + SS_H))[i] = 0u;
    hacc = (f32x16){};
    u32x4 rx[2], rb[4], rc[4], rg[4]; float rd0 = 0.f, rd1 = 0.f;
#define SS_LOAD(step_) do { const int ck_ = ssd_chunk_of(dir, b, (step_)); int r0_, lo_, hi_; chunk_rows(ck_, r0_, lo_, hi_); \
        _Pragma("unroll") for (int i = 0; i < 2; ++i) { const int idx = tid + 512 * i, r = idx >> 3, ch = idx & 7; rx[i] = *(const u32x4*)(XBCCp + (size_t)(r0_ + r) * 1024 + hd * 64 + ch * 8); } \
        const bf16_t* gmp_ = GMp + (size_t)(ck_ * 2 + g) * 128 * 128; \
        _Pragma("unroll") for (int i = 0; i < 4; ++i) { const int idx = tid + 512 * i, r = idx >> 4, ch = idx & 15; \
            rb[i] = *(const u32x4*)(XBCCp + (size_t)(r0_ + r) * 1024 + 512 + 128 * g + ch * 8); rc[i] = *(const u32x4*)(XBCCp + (size_t)(r0_ + r) * 1024 + 768 + 128 * g + ch * 8); \
            rg[i] = *(const u32x4*)(gmp_ + r * 128 + ch * 8); } \
        if (wave == 7) { rd0 = DTp[(size_t)(r0_ + 2 * lane) * 16 + dir * 8 + hd]; rd1 = DTp[(size_t)(r0_ + 2 * lane + 1) * 16 + dir * 8 + hd]; } } while (0)
#define SS_STORE() do { \
        _Pragma("unroll") for (int i = 0; i < 2; ++i) { const int idx = tid + 512 * i, r = idx >> 3, ch = idx & 7; *(LAS u32x4*)(L + SS_XS + r * SS_XS_STRIDE + ch * 16) = rx[i]; } \
        _Pragma("unroll") for (int i = 0; i < 4; ++i) { const int idx = tid + 512 * i, r = idx >> 4, ch = idx & 15; \
            *(LAS u32x4*)(L + SS_BM + r * 272 + ch * 16) = rb[i]; *(LAS u32x4*)(L + SS_CM + r * 272 + ch * 16) = rc[i]; *(LAS u32x4*)(L + SS_GM + r * 272 + ch * 16) = rg[i]; } } while (0)
    SS_LOAD(0);
    SS_STORE();
    for (int step = 0; step < 18; ++step) {
        const int chunk = ssd_chunk_of(dir, b, step);
        int row0, slo, shi; chunk_rows(chunk, row0, slo, shi);
        int tid2 = tid, lane2 = lane; asm volatile("" : "+v"(tid2), "+v"(lane2));
        if (wave == 7) {
            const float d0 = rd0, d1 = rd1;
            const float da0 = d0 * a_coef, da1 = d1 * a_coef; const float ps = da0 + da1;
            float inc = ps; float c0v, c1v;
            if (dir == 0) {
#pragma unroll
                for (int o = 1; o < 64; o <<= 1) { const float t = shl_from(inc, lane2 - o); if (lane2 >= o) inc += t; }
                c0v = inc - da1; c1v = inc;
            } else {
#pragma unroll
                for (int o = 1; o < 64; o <<= 1) { const float t = shl_from(inc, lane2 + o); if (lane2 + o < 64) inc += t; }
                c0v = inc; c1v = inc - da0;
            }
            const float tot = shl_from(inc, dir ? 0 : 63);
            acs[2 * lane2] = c0v; acs[2 * lane2 + 1] = c1v; dtv[2 * lane2] = d0; dtv[2 * lane2 + 1] = d1;
            wrow[2 * lane2] = __expf(tot - c0v) * d0; wrow[2 * lane2 + 1] = __expf(tot - c1v) * d1;
            erow[2 * lane2] = __expf(c0v); erow[2 * lane2 + 1] = __expf(c1v);
            if (lane2 == 0) aendp[0] = __expf(tot);
        }
        if (step + 1 < 18) SS_LOAD(step + 1);
        lds_barrier();
        {
            u32x4 vg[4], vb[4]; float alr[4], wr_[4]; f32x4 ac0[4], ac1[4], dq0[4], dq1[4];
#pragma unroll
            for (int i = 0; i < 4; ++i) { const int idx = tid2 + 512 * i, r = idx >> 4, ch = idx & 15, s0 = ch * 8;
                vg[i] = *(LAS const u32x4*)(L + SS_GM + r * 272 + ch * 16); vb[i] = *(LAS const u32x4*)(L + SS_BM + r * 272 + ch * 16);
                alr[i] = acs[r]; wr_[i] = wrow[r];
                ac0[i] = *(LAS const f32x4*)(acs + s0); ac1[i] = *(LAS const f32x4*)(acs + s0 + 4); dq0[i] = *(LAS const f32x4*)(dtv + s0); dq1[i] = *(LAS const f32x4*)(dtv + s0 + 4); }
#pragma unroll
            for (int i = 0; i < 4; ++i) { const int idx = tid2 + 512 * i, r = idx >> 4, ch = idx & 15, s0 = ch * 8; float o[8];
#pragma unroll
                for (int e = 0; e < 8; ++e) { const int s = s0 + e; const bool ok = dir ? (s >= r) : (s <= r);
                    const float acv = (e < 4) ? ac0[i][e & 3] : ac1[i][e & 3], dtq = (e < 4) ? dq0[i][e & 3] : dq1[i][e & 3];
                    const float gv = (e & 1) ? bfhi(vg[i][e >> 1]) : bflo(vg[i][e >> 1]); o[e] = ok ? gv * __expf(alr[i] - acv) * dtq : 0.f; }
                u32x4 w; w.x = pk2(o[0], o[1]); w.y = pk2(o[2], o[3]); w.z = pk2(o[4], o[5]); w.w = pk2(o[6], o[7]); *(LAS u32x4*)(L + SS_GM + r * 272 + ch * 16) = w;
                u32x4 wb;
#pragma unroll
                for (int e = 0; e < 4; ++e) wb[e] = pk2(bflo(vb[i][e]) * wr_[i], bfhi(vb[i][e]) * wr_[i]);
                *(LAS u32x4*)(L + SS_BM + r * 272 + ch * 16) = wb; }
        }
        lds_barrier();
        {
            const int lb = wave >> 1, pb = wave & 1; f32x16 y = {}, yo = {};
            bf16x8 fa[8], fb[8];
#pragma unroll
            for (int ks = 0; ks < 8; ++ks) { fa[ks] = frag_rm(L + SS_GM, 272, 32 * lb, 16 * ks, lane); fb[ks] = frag_tr(L + SS_XS, SS_XS_STRIDE, 16 * ks, 32 * pb, lane); }
            __builtin_amdgcn_sched_barrier(0);
#pragma unroll
            for (int ks = 0; ks < 8; ++ks) y = MFMA32(fa[ks], fb[ks], y);
#pragma unroll
            for (int ks = 0; ks < 8; ++ks) { fa[ks] = frag_rm(L + SS_CM, 272, 32 * lb, 16 * ks, lane); fb[ks] = frag_rm(L + SS_H, 272, 32 * pb, 16 * ks, lane); }
            __builtin_amdgcn_sched_barrier(0);
#pragma unroll
            for (int ks = 0; ks < 8; ++ks) yo = MFMA32(fa[ks], fb[ks], yo);
            __builtin_amdgcn_sched_barrier(0);
#pragma unroll
            for (int t = 0; t < 16; ++t) { const int l = 32 * lb + accrow(t, lane >> 5); Yout[(size_t)(row0 + l) * 512 + hd * 64 + 32 * pb + (lane & 31)] = f2bf(y[t] + erow[l] * yo[t]); }
        }
        lds_barrier();
        {
            const int pb = wave & 1, nb = wave >> 1; const float dec = aendp[0];
            bf16x8 fa[8], fb[8];
#pragma unroll
            for (int ks = 0; ks < 8; ++ks) { fa[ks] = frag_tr(L + SS_XS, SS_XS_STRIDE, 16 * ks, 32 * pb, lane); fb[ks] = frag_tr(L + SS_BM, 272, 16 * ks, 32 * nb, lane); }
#pragma unroll
            for (int t = 0; t < 16; ++t) hacc[t] *= dec;
            __builtin_amdgcn_sched_barrier(0);
#pragma unroll
            for (int ks = 0; ks < 8; ++ks) hacc = MFMA32(fa[ks], fb[ks], hacc);
#pragma unroll
            for (int t = 0; t < 16; ++t) *(LAS bf16_t*)(L + SS_H + (32 * pb + accrow(t, lane >> 5)) * 272 + (32 * nb + (lane & 31)) * 2) = f2bf(hacc[t]);
        }
        lds_barrier();
        if (step + 1 < 18) SS_STORE();
    }
    __syncthreads();
    }
#undef SS_LOAD
#undef SS_STORE
    __syncthreads();
}

constexpr int AT_KSTR = 272, AT_VSTR = 320, AT_KBYTES = 64 * AT_KSTR, AT_VBYTES = 64 * AT_VSTR;
constexpr int AT_K = 0, AT_V = 2 * AT_KBYTES, AT_LX = AT_V + 2 * AT_VBYTES;
__device__ __forceinline__ void attn_unit(const Frame& F, int layer, int qrow0, int ntiles, int b, int head, float lam, float m2, float lam_init) {
    int tid_ = F.tid; asm volatile("" : "+v"(tid_));
    const int tid = tid_, lane = tid & 63, wave = __builtin_amdgcn_readfirstlane(tid >> 6), r32 = lane & 31, hh = lane >> 5;
    const int mp = wave & 1, qg = wave >> 1;
    LAS unsigned char* L = F.lds;
    const bf16_t* const Kp = F_K + head * 128; const bf16_t* const Vp = F_V + head * 128; bf16_t* const A2p = F_A2;
    bf16x8 qf[4];
    { const bf16_t* qp = F_Q + (size_t)(qrow0 + 32 * qg + r32) * 512 + head * 128 + mp * 64 + 8 * hh;
#pragma unroll
      for (int d0 = 0; d0 < 4; ++d0) qf[d0] = *(const bf16x8*)(qp + d0 * 16); }
    f32x16 o[4];
#pragma unroll
    for (int j = 0; j < 4; ++j) o[j] = (f32x16){};
    float lsum = 0.f;
    f32x16 negm;
    { float m2l = m2; asm volatile("" : "+v"(m2l));
#pragma unroll
      for (int t = 0; t < 16; ++t) negm[t] = -m2l; }
    u32x4 kreg[2], vreg[2];
    const int prow0 = tid >> 4, pch = tid & 15;
#define AT_KROW(t) (((t) < 4) ? (NL + b * CTXL + 64 * (t)) : (b * SEQ + 64 * ((t) - 4)))
#define AT_LOADK(t) do { const int kr_ = AT_KROW(t); _Pragma("unroll") for (int i_ = 0; i_ < 2; ++i_) kreg[i_] = *(const u32x4*)(Kp + (size_t)(kr_ + prow0 + 32 * i_) * 512 + pch * 8); } while (0)
#define AT_LOADV(t) do { const int kr_ = AT_KROW(t); _Pragma("unroll") for (int i_ = 0; i_ < 2; ++i_) vreg[i_] = *(const u32x4*)(Vp + (size_t)(kr_ + prow0 + 32 * i_) * 512 + pch * 8); } while (0)
#define AT_STOREK(st) do { _Pragma("unroll") for (int i_ = 0; i_ < 2; ++i_) *(LAS u32x4*)(L + AT_K + (st) * AT_KBYTES + (prow0 + 32 * i_) * AT_KSTR + pch * 16) = kreg[i_]; } while (0)
#define AT_STOREV(st) do { _Pragma("unroll") for (int i_ = 0; i_ < 2; ++i_) *(LAS u32x4*)(L + AT_V + (st) * AT_VBYTES + (prow0 + 32 * i_) * AT_VSTR + pch * 16) = vreg[i_]; } while (0)
#define AT_QK(SA, SB, st) do { LAS const unsigned char* Kt_ = L + AT_K + (st) * AT_KBYTES + r32 * AT_KSTR + (mp * 64 + 8 * hh) * 2; SA = negm; SB = negm; \
        _Pragma("unroll") for (int d0 = 0; d0 < 4; ++d0) { const bf16x8 ka = *(LAS const bf16x8*)(Kt_ + d0 * 32); const bf16x8 kb = *(LAS const bf16x8*)(Kt_ + 32 * AT_KSTR + d0 * 32); \
            SA = MFMA32(ka, qf[d0], SA); SB = MFMA32(kb, qf[d0], SB); } } while (0)
    if (wave >= 4) __builtin_amdgcn_s_setprio(1);
    AT_LOADK(0); AT_LOADV(0); AT_STOREK(0); AT_STOREV(0);
    if (ntiles > 1) { AT_LOADK(1); AT_STOREK(1); }
    __syncthreads();
    f32x16 sa, sb, na, nb;
    AT_QK(sa, sb, 0);
    lds_barrier();
    for (int t = 0; t < ntiles; ++t) {
        if (t + 2 < ntiles) AT_LOADK(t + 2);
        if (t + 1 < ntiles) AT_LOADV(t + 1);
        if (t + 1 < ntiles) AT_QK(na, nb, (t + 1) & 1);
        float ls = 0.f;
#pragma unroll
        for (int i = 0; i < 16; ++i) { sa[i] = __builtin_amdgcn_exp2f(sa[i]); sb[i] = __builtin_amdgcn_exp2f(sb[i]); ls += sa[i] + sb[i]; }
        lsum += ls;
        bf16x8 pk[4];
        { u32x4 w0, w1, w2, w3;
#pragma unroll
          for (int i = 0; i < 4; ++i) { w0[i] = pk2(sa[2 * i], sa[2 * i + 1]); w1[i] = pk2(sa[8 + 2 * i], sa[9 + 2 * i]); w2[i] = pk2(sb[2 * i], sb[2 * i + 1]); w3[i] = pk2(sb[8 + 2 * i], sb[9 + 2 * i]); }
          pk[0] = __builtin_bit_cast(bf16x8, w0); pk[1] = __builtin_bit_cast(bf16x8, w1); pk[2] = __builtin_bit_cast(bf16x8, w2); pk[3] = __builtin_bit_cast(bf16x8, w3); }
        LAS const unsigned char* Vt = L + AT_V + (t & 1) * AT_VBYTES;
        __builtin_amdgcn_sched_barrier(0);
        bf16x8 vfa[4], vfb[4];
#pragma unroll
        for (int j = 0; j < 4; ++j) vfa[j] = frag_tr_acc(Vt, AT_VSTR, 0, 32 * j, lane);
#pragma unroll
        for (int ks = 0; ks < 4; ks += 2) {
#pragma unroll
            for (int j = 0; j < 4; ++j) vfb[j] = frag_tr_acc(Vt, AT_VSTR, 16 * (ks + 1), 32 * j, lane);
#pragma unroll
            for (int j = 0; j < 4; ++j) o[j] = MFMA32(pk[ks], vfa[j], o[j]);
            __builtin_amdgcn_sched_barrier(0);
            if (ks + 2 < 4) {
#pragma unroll
                for (int j = 0; j < 4; ++j) vfa[j] = frag_tr_acc(Vt, AT_VSTR, 16 * (ks + 2), 32 * j, lane);
            }
#pragma unroll
            for (int j = 0; j < 4; ++j) o[j] = MFMA32(pk[ks + 1], vfb[j], o[j]);
            __builtin_amdgcn_sched_barrier(0);
        }
        if (t + 2 < ntiles) AT_STOREK(t & 1);
        if (t + 1 < ntiles) AT_STOREV((t + 1) & 1);
        __syncthreads();
        sa = na; sb = nb;
    }
#undef AT_LOADK
#undef AT_LOADV
#undef AT_STOREK
#undef AT_STOREV
#undef AT_QK
#undef AT_KROW
    __builtin_amdgcn_s_setprio(0);
    int lane_e = lane; asm volatile("" : "+v"(lane_e));
#define r32 r32e
#define hh hhe
    const int r32e = lane_e & 31, hhe = lane_e >> 5;
    LAS float* lx = (LAS float*)(L + AT_LX + wave * 256);
    { const float l0 = lsum + shx(lsum, 32, lane_e); if (hh == 0) lx[r32] = (mp ? lam : 1.f) / l0; }
    LDS_WAIT();
    LAS float* X = (LAS float*)(L + qg * 16384);
    float isc[16];
#pragma unroll
    for (int t = 0; t < 16; ++t) isc[t] = lx[accrow(t, hh)];
    if (mp == 1) {
#pragma unroll
        for (int t = 0; t < 16; ++t)
#pragma unroll
            for (int j = 0; j < 4; ++j) X[accrow(t, hh) * 128 + 32 * j + r32] = o[j][t] * isc[t];
    }
    __syncthreads();
    if (mp == 0) {
        const float* sw = INP(I_SUBLN) + layer * 128;
        float swv[4];
#pragma unroll
        for (int j = 0; j < 4; ++j) swv[j] = sw[32 * j + r32] * (1.f - lam_init);
#pragma unroll
        for (int t = 0; t < 16; ++t) {
            const int q = accrow(t, hh);
            float v[4]; float ss = 0.f;
#pragma unroll
            for (int j = 0; j < 4; ++j) { v[j] = o[j][t] * isc[t] - X[q * 128 + 32 * j + r32]; ss += v[j] * v[j]; }
#pragma unroll
            for (int of = 1; of < 32; of <<= 1) ss += shx(ss, of, lane_e);
            const float rstd = rsqrtf(ss * (1.f / 128.f) + EPS);
            bf16_t* op = A2p + (size_t)(qrow0 + 32 * qg + q) * 1024 + head * 128 + r32;
#pragma unroll
            for (int j = 0; j < 4; ++j) op[32 * j] = f2bf(v[j] * rstd * swv[j]);
        }
    }
#undef r32
#undef hh
    __syncthreads();
}

__device__ __forceinline__ void p4_mixer(const Frame& F, int layer, int rep) {
    const int lane = F.lane;
    const float lam_init = 0.8f - 0.6f * __expf(-0.3f * (float)layer);
    const float p1 = wave_sum(INP(I_LQ1)[layer * 64 + lane] * INP(I_LK1)[layer * 64 + lane]);
    const float p2 = wave_sum(INP(I_LQ2)[layer * 64 + lane] * INP(I_LK2)[layer * 64 + lane]);
    const float lam = __expf(p1) - __expf(p2) + lam_init;
    const float qmx = wave_max(fabsf(INP(I_QNW)[layer * 64 + lane])), kmx = wave_max(fabsf(INP(I_KNW)[layer * 64 + lane]));
    const float m2 = 8.f * qmx * kmx * LOG2E * 1.01f;
    const int na = (layer < DEPTH - 1) ? 128 + 16 : 128;
    const int ncv = (CVB + ((layer + 1 < DEPTH) ? CV_SMALL / 8 : 0)) / 8;
    const int nq = 32 + na + ncv;
    volatile LAS unsigned* bc = (volatile LAS unsigned*)(F.lds + MISC_OFF) + 16;
    const int myx = (int)(__builtin_amdgcn_s_getreg((3 << 11) | 20) & 7u);
    unsigned* const wq = F_CTL + CW_WQ + 1024 * (layer + 4 * rep);
    for (int qi = 0; qi < 8; ++qi) {
        const int x = (myx + qi) & 7;
        for (;;) {
            if (F.tid == 0) bc[0] = __hip_atomic_fetch_add(wq + 64 * x, 1u, __ATOMIC_RELAXED, __HIP_MEMORY_SCOPE_AGENT);
            __syncthreads();
            const int it = (int)bc[0];
            __syncthreads();
            if (it >= nq) break;
            if (it < 32) {
#ifndef SKIP_SSD
                const int grp = 4 * x + (it >> 3), m = it & 7, b = grp >> 1, g = grp & 1, hd = 4 * g + (m >> 1), dir = m & 1;
                ssd_unit(F, layer, (b << 4) | (hd << 1) | dir);
#endif
            } else {
                const int p = it - 32; int a = -1, cv = -1;
                if (p < 2 * na) { if (p & 1) cv = p >> 1; else a = p >> 1; } else cv = p - na;
                if (cv >= 0) { const int g = x + 8 * cv; Frame Fc = F; Fc.lane = lane_id_v(); Fc.tid = Fc.wave * 64 + Fc.lane;
                    if (g < CVB_WGU) cvt_wgu_block(Fc, layer, g);
                    else if (g < CVB) cvt_layer_item(Fc, layer, CV_SMALL + CV_WGU + 8 * (g - CVB_WGU) + Fc.wave, (LAS float*)(Fc.lds + Fc.wave * 17408));
                    else cvt_layer_item(Fc, layer + 1, 8 * (g - CVB) + Fc.wave, (LAS float*)(Fc.lds + Fc.wave * 17408)); }
#ifndef SKIP_ATT
                else
                for (int pr = 0; pr < ((PROBE_MASK & 512) ? 2 : 1); ++pr)
                if (a < 128) { const int c = 8 * (a >> 4) + x, qb = a & 15, b = c >> 2, head = c & 3; attn_unit(F, layer, b * SEQ + 128 * qb, 36, b, head, lam, m2, lam_init); }
                else { const int a2 = a - 128, c = 8 * (a2 >> 1) + x, qb = a2 & 1, b = c >> 2, head = c & 3; attn_unit(F, layer, NL + b * CTXL + 128 * qb, 4, b, head, lam, m2, lam_init); }
#endif
            }
        }
    }
}

__device__ __forceinline__ void p8_topk(const Frame& F, int layer) {
    const int tid = F.tid, lane = F.lane, wave = F.wave;
    LAS unsigned* cnt = (LAS unsigned*)F.lds;
    LAS unsigned* cg = cnt + 48;
    LAS unsigned* ce = cnt + 80;
    LAS int* sidx = (LAS int*)(F.lds + 1024);
    const int nunits = (layer < DEPTH - 1) ? 512 : 256;
    const float* const AFFp = F_AFF; float* const GATEp = F_GATE; int* const INVp = F_INV; unsigned* const ROFFp = F_ROFF; const float* const SAp = F_SA; float* const SAYp = F_SAY;
    const unsigned long long lt_mask = (lane == 0) ? 0ull : (~0ull >> (64 - lane));
    for (int u = F.blk; u < nunits; u += F.G) {
        const bool lat = u < 256; const int uu = lat ? u : u - 256, b = uu >> 4, e = uu & 15;
        const int n = lat ? SEQ : CTXL, cap = lat ? 256 : 32;
        const float* av = lat ? AFFp + (size_t)uu * 2048 : AFFp + (size_t)NL * 16 + (size_t)uu * 256;
        const int rowb = lat ? b * SEQ : NL + b * CTXL;
        const int yb = lat ? (b * 16 + e) * 256 : (256 + 2 * e + (b >> 3)) * 256 + (b & 7) * 32;
        unsigned v[4];
#pragma unroll
        for (int k = 0; k < 4; ++k) { const int i = tid + 512 * k; v[k] = (i < n) ? __float_as_uint(av[i]) : 0u; }
        unsigned T = 0u;
        {
            unsigned c = 0;
#pragma unroll
            for (int k = 0; k < 4; ++k) c += (unsigned)__popcll(__ballot(v[k] >= 0x40000000u));
            if (lane == 0) cnt[24 + wave] = c;
            __syncthreads();
            unsigned tot = 0;
#pragma unroll
            for (int w = 0; w < 8; ++w) tot += cnt[24 + w];
            if (tot >= (unsigned)cap) T = 0x40000000u;
        }
        for (int bit = 28; bit >= 0; bit -= 2) {
            const unsigned c1 = T | (1u << bit), c2 = T | (2u << bit), c3 = T | (3u << bit); const int par = (bit >> 1) & 1;
            unsigned n1 = 0, n2 = 0, n3 = 0;
#pragma unroll
            for (int k = 0; k < 4; ++k) { n1 += (unsigned)__popcll(__ballot(v[k] >= c1)); n2 += (unsigned)__popcll(__ballot(v[k] >= c2)); n3 += (unsigned)__popcll(__ballot(v[k] >= c3)); }
            if (lane == 0) { cnt[par * 24 + wave] = n1; cnt[par * 24 + 8 + wave] = n2; cnt[par * 24 + 16 + wave] = n3; }
            __syncthreads();
            unsigned t1 = 0, t2 = 0, t3 = 0;
#pragma unroll
            for (int w = 0; w < 8; ++w) { t1 += cnt[par * 24 + w]; t2 += cnt[par * 24 + 8 + w]; t3 += cnt[par * 24 + 16 + w]; }
            if (t3 >= (unsigned)cap) T = c3; else if (t2 >= (unsigned)cap) T = c2; else if (t1 >= (unsigned)cap) T = c1;
        }
        unsigned pg[4], pe[4]; bool isg[4], ise[4];
#pragma unroll
        for (int k = 0; k < 4; ++k) { isg[k] = v[k] > T; ise[k] = v[k] == T;
            const unsigned long long mg = __ballot(isg[k]), me = __ballot(ise[k]);
            pg[k] = (unsigned)__popcll(mg & lt_mask); pe[k] = (unsigned)__popcll(me & lt_mask);
            if (lane == 0) { cg[k * 8 + wave] = (unsigned)__popcll(mg); ce[k * 8 + wave] = (unsigned)__popcll(me); } }
        __syncthreads();
        unsigned totg = 0;
#pragma unroll
        for (int j = 0; j < 32; ++j) totg += cg[j];
        unsigned bg = 0, be = 0;
#pragma unroll
        for (int k = 0; k < 4; ++k) {
#pragma unroll
            for (int w = 0; w < 8; ++w) { const bool before = w < wave; if (before) { bg += cg[k * 8 + w]; be += ce[k * 8 + w]; } }
            const int i = tid + 512 * k;
            if (i < n) {
                int slot = -1;
                if (isg[k]) slot = (int)(bg + pg[k]);
                else if (ise[k]) { const unsigned r = be + pe[k]; if (totg + r < (unsigned)cap) slot = (int)(totg + r); }
                const int row = rowb + i;
                if (slot >= 0) { ROFFp[yb + slot] = (unsigned)row * (unsigned)D; SAYp[yb + slot] = SAp[row]; GATEp[yb + slot] = __uint_as_float(v[k]); INVp[(size_t)row * 16 + e] = yb + slot; } else INVp[(size_t)row * 16 + e] = -1;
            }
#pragma unroll
            for (int w = 0; w < 8; ++w) { const bool rest = w >= wave; if (rest) { bg += cg[k * 8 + w]; be += ce[k * 8 + w]; } }
        }
        __syncthreads();
    }
}
}

#define XB_TMO      128
#define XB_XCNT(j)  (256  + 64 * (j))
#define XB_XSUB(j)  (1280 + 64 * (j))
#define XB_XGEN(j)  (2304 + 64 * (j))
#define XB_TOP      3328
#define XB_TOPGEN   3392
#define XCD_BAR_WORDS 3456
#define XB_SPIN_CAP (1u << 22)

__device__ __forceinline__ unsigned xb_ld(unsigned* p)              { return __hip_atomic_load(p, __ATOMIC_RELAXED, __HIP_MEMORY_SCOPE_AGENT); }
__device__ __forceinline__ unsigned xb_add(unsigned* p, unsigned v) { return __hip_atomic_fetch_add(p, v, __ATOMIC_RELAXED, __HIP_MEMORY_SCOPE_AGENT); }
__device__ __forceinline__ unsigned xb_xcc_id() { return (unsigned)__builtin_amdgcn_s_getreg((3 << 11) | 20) & 0xFu; }
#define XB_SPIN(cond, bar) do { unsigned _sp = 0; while (cond) { __builtin_amdgcn_s_sleep(1); \
    if ((++_sp & 255u) == 0u) { if (xb_ld(&(bar)[XB_TMO])) break; if (_sp > XB_SPIN_CAP) { atomicAdd(&(bar)[XB_TMO], 1u); break; } } } } while (0)

struct XcdBarrier { unsigned* bar; unsigned x; volatile LAS unsigned* st; };

__device__ __forceinline__ XcdBarrier xcd_barrier_post(unsigned* bar, volatile LAS unsigned* st) {
    XcdBarrier b; b.bar = bar; b.x = xb_xcc_id(); b.st = st;
    if (threadIdx.x == 0) (void)xb_add(&bar[XB_XCNT(b.x)], 1u);
    return b;
}
__device__ __forceinline__ void xcd_barrier_complete(unsigned* bar, unsigned x, unsigned& nloc, unsigned& nx) {
    const unsigned G = gridDim.x * gridDim.y * gridDim.z;
    unsigned sum, cnt, mine, sp = 0u;
    for (;;) {
        sum = 0u; cnt = 0u; mine = 0u;
#pragma unroll
        for (unsigned j = 0; j < 16; ++j) { const unsigned c = xb_ld(&bar[XB_XCNT(j)]); sum += c; cnt += (c > 0u) ? 1u : 0u; mine = (j == x) ? c : mine; }
        if (sum == G) break;
        __builtin_amdgcn_s_sleep(1);
        if ((++sp & 255u) == 0u) { if (xb_ld(&bar[XB_TMO])) break; if (sp > XB_SPIN_CAP) { atomicAdd(&bar[XB_TMO], 1u); break; } }
    }
    nloc = mine > 0u ? mine : 1u; nx = cnt > 0u ? cnt : 1u;
}
__device__ __forceinline__ void xcd_barrier(const XcdBarrier& b) {
    asm volatile("s_waitcnt vmcnt(0)" ::: "memory");
    __syncthreads();
    if (threadIdx.x == 0) {
        unsigned* bar = b.bar;
        __builtin_amdgcn_s_waitcnt(0);
        unsigned nloc = b.st[0], nx = b.st[1];
        if (nloc == 0u) { xcd_barrier_complete(bar, b.x, nloc, nx); b.st[0] = nloc; b.st[1] = nx; }
        const unsigned old = xb_add(&bar[XB_XSUB(b.x)], 1u);
        const unsigned gen = old / nloc;
        if (old + 1u == (gen + 1u) * nloc) {
            __builtin_amdgcn_fence(__ATOMIC_RELEASE, "agent");
            asm volatile("s_waitcnt vmcnt(0)" ::: "memory");
            const unsigned og = xb_add(&bar[XB_TOP], 1u);
            const unsigned tg = og / nx;
            if (og + 1u == (tg + 1u) * nx) xb_add(&bar[XB_TOPGEN], 1u);
            else XB_SPIN(xb_ld(&bar[XB_TOPGEN]) == tg, bar);
            __builtin_amdgcn_fence(__ATOMIC_ACQUIRE, "agent");
            xb_add(&bar[XB_XGEN(b.x)], 1u);
            asm volatile("s_waitcnt vmcnt(0)" ::: "memory");
        } else {
            XB_SPIN(xb_ld(&bar[XB_XGEN(b.x)]) == gen, bar);
            __builtin_amdgcn_fence(__ATOMIC_ACQUIRE, "agent");
            asm volatile("s_waitcnt vmcnt(0)" ::: "memory");
        }
    }
    __syncthreads();
}


namespace mk {
__device__ __forceinline__ void g_inproj(const Frame& F, int layer) {
    pg8::Gemm g{(const bf16_t*)F_HAQ, (const bf16_t*)(F_WINQ + (size_t)layer * NPROJ * D), NT, NPROJ, D / 2}; pg8::StaticOrder S; S.init(NT, NPROJ, F.G, F.blk);
    EpiInProj E{WSP() + WS_U, F_QKW + layer * 128, F_ROPEC, F_ROPES, F_SAH, F_SWIN + (size_t)layer * NPROJ};
    pg8::gemm_phase_i8<EpiInProj, pg8::StaticOrder, true, true>(F.lds, g, S, E, F.tid);
}
__device__ __forceinline__ void g_outproj(const Frame& F, int layer, float gscale) {
    const int M = (layer < DEPTH - 1) ? NT : NL;
    pg8::Gemm g{F_A2, F_WOUT + (size_t)layer * D * D, M, D, D}; pg8::StaticOrder S; S.init(M, D, F.G, F.blk);
    const bool first = (layer == 0 && gscale != 0.f);
    EpiOutProj E{INP(I_X), INP(I_CTX), F_XB, F_MOD + (size_t)layer * 17 * 6144, gscale, first};
    pg8::gemm_phase<EpiOutProj, pg8::StaticOrder, true, true>(F.lds, g, S, E, F.tid);
}
__device__ __forceinline__ void g_moe1(const Frame& F, int layer) {
    pg8::Gemm g{(const bf16_t*)F_HQ, (const bf16_t*)(F_WGUQ + (size_t)layer * NE * 2816 * D), YROWS, NE * 2816, D / 2}; SchedMoe1 S{F.G, F.blk, (layer < DEPTH - 1) ? 1 : 0};
    EpiMoe1 E{F_HID, F_SW + (size_t)layer * NE * 2816, F_SAY};
    pg8::gemm_phase_gather_i8<EpiMoe1, SchedMoe1, true, true>(F.lds, g, S, E, F.tid, F_ROFF);
}
__device__ __forceinline__ void g_moe2(const Frame& F, int layer) {
    pg8::Gemm g{F_HID, F_WD + (size_t)layer * NE * D * DE, YROWS, NE * D, DE}; SchedMoe2 S{F.G, F.blk, (layer < DEPTH - 1) ? 1 : 0};
    EpiMoe2 E{F_Y, F_GATE};
    pg8::gemm_phase<EpiMoe2, SchedMoe2, true, true>(F.lds, g, S, E, F.tid);
}
}

#ifndef PROBE_MASK
#define PROBE_MASK 0
#endif
#ifndef PROBE_GEMM
#define PROBE_GEMM 0
#endif
#ifndef PROBE_P4
#define PROBE_P4 0
#endif
#ifndef PROBE_ROW
#define PROBE_ROW 0
#endif
#ifndef PROBE_TMASK
#define PROBE_TMASK 0
#endif
#ifndef MK_PER_PHASE
#define MK_PER_PHASE 0
#endif
constexpr int N_PHASES = 1 + 10 * mk::DEPTH + 1;
struct Args { const float* in[29]; float* out; unsigned char* ws; int ph_lo, ph_hi; };

__global__ void __launch_bounds__(512, 2) mk_fwd(Args args) {
    using namespace mk;
    extern __shared__ __attribute__((aligned(16))) unsigned char lds_raw[];
    Frame F0;
    F0.lds = (LAS unsigned char*)lds_raw;
    F0.tid = threadIdx.x; F0.lane = F0.tid & 63; F0.wave = __builtin_amdgcn_readfirstlane(F0.tid >> 6); F0.G = gridDim.x; F0.blk = blockIdx.x;
    const int wave0 = F0.wave;
    volatile LAS unsigned* MISC = (volatile LAS unsigned*)(F0.lds + MISC_OFF);
    for (int u = F0.tid; u < (LDS_BYTES - MISC_OFF) / 4; u += NTHREADS) MISC[u] = 0u;
    __syncthreads();
    XcdBarrier bar; bar.bar = F_CTL + CW_BAR; bar.x = 0; bar.st = nullptr;
    if (!MK_PER_PHASE) bar = xcd_barrier_post(F_CTL + CW_BAR, MISC + 8);

    const int lo = args.ph_lo, hi = args.ph_hi;
    int ph = 0;
    unsigned long long tacc = 0, tph0 = 0; int pcl = 0;
#define PCL(c) pcl = (c);
#define PH_BEGIN if (PROBE_TMASK) tph0 = __builtin_amdgcn_s_memrealtime(); if (ph >= lo && ph < hi) { Frame F; F.lds = (LAS unsigned char*)lds_raw; F.G = gridDim.x; F.blk = blockIdx.x; F.wave = wave0; \
        F.lane = mk::lane_id_v(); asm volatile("" : "+s"(F.G), "+s"(F.blk), "+s"(F.wave)); F.tid = F.wave * 64 + F.lane;
#define PH_END   if (!MK_PER_PHASE && ph + 1 < hi) xcd_barrier(bar); else __syncthreads(); } ++ph; if (PROBE_TMASK && ((PROBE_TMASK >> pcl) & 1)) tacc += __builtin_amdgcn_s_memrealtime() - tph0;

    PCL(0) PH_BEGIN p0_prologue(F); PH_END
    if (PROBE_MASK & 128) { --ph; PH_BEGIN p0_prologue(F); PH_END }
    for (int layer = 0; layer < DEPTH; ++layer) {
        if (PROBE_MASK & 4096) { for (int e_ = 0; e_ < 8; ++e_) { --ph; PH_BEGIN PH_END } ++ph; --ph; }
        PCL(1) PH_BEGIN p1_norm1(F, layer, 0); PH_END
        if (PROBE_MASK & 2048) { --ph; PH_BEGIN p1_norm1(F, layer, 1); PH_END }
        PCL(2) PH_BEGIN g_inproj(F, layer); PH_END
        if (PROBE_GEMM || (PROBE_MASK & 16)) { --ph; PH_BEGIN g_inproj(F, layer); PH_END }
        PCL(3) PH_BEGIN p3_conv(F, layer); PH_END
        if (PROBE_ROW || (PROBE_MASK & 1)) { --ph; PH_BEGIN p3_conv(F, layer); PH_END }
        PCL(4) PH_BEGIN p4_mixer(F, layer, 0); PH_END
        if (PROBE_P4) { --ph; PH_BEGIN p4_mixer(F, layer, 1); PH_END }
        PCL(5) PH_BEGIN p5_ssd_post(F, layer); PH_END
        if (PROBE_ROW || (PROBE_MASK & 2)) { --ph; PH_BEGIN p5_ssd_post(F, layer); PH_END }
        PCL(6) PH_BEGIN g_outproj(F, layer, 1.f); PH_END
        if (PROBE_MASK & 1024) { --ph; PH_BEGIN g_outproj(F, layer, 0.f); PH_END }
        PCL(7) PH_BEGIN p7_norm2(F, layer); PH_END
        if (PROBE_ROW || (PROBE_MASK & 4)) { --ph; PH_BEGIN p7_norm2(F, layer); PH_END }
        PCL(8) PH_BEGIN p8_topk(F, layer); PH_END
        if (PROBE_ROW || (PROBE_MASK & 8)) { --ph; PH_BEGIN p8_topk(F, layer); PH_END }
        PCL(9) PH_BEGIN g_moe1(F, layer); PH_END
        if (PROBE_GEMM || (PROBE_MASK & 32)) { --ph; PH_BEGIN g_moe1(F, layer); PH_END }
        PCL(10) PH_BEGIN g_moe2(F, layer); PH_END
        if (PROBE_GEMM || (PROBE_MASK & 64)) { --ph; PH_BEGIN g_moe2(F, layer); PH_END }
    }
    PCL(11) PH_BEGIN p1_norm1(F, DEPTH, 0); PH_END
#undef PH_BEGIN
#undef PH_END
    if (PROBE_TMASK && blockIdx.x == 0) { const unsigned long long te = __builtin_amdgcn_s_memrealtime(); while (__builtin_amdgcn_s_memrealtime() - te < 9ull * tacc) __builtin_amdgcn_s_sleep(8); }
}

extern "C" void kernel_launch(void* const* d_in, const int* in_sizes, int n_in, void* d_out, int out_size, void* d_ws, size_t ws_size, hipStream_t stream) {
    static int grid = 0;
    if (grid == 0) {
        if (n_in != 29 || out_size != mk::NL * mk::D || ws_size < mk::WS_END) { fprintf(stderr, "kernel_launch: unexpected shapes: n_in %d out %d ws %zu (need %zu)\n", n_in, out_size, ws_size, (size_t)mk::WS_END); grid = -1; return; }
        int dev = 0, cus = 0, per_cu = 0;
        if (hipGetDevice(&dev) != hipSuccess || hipDeviceGetAttribute(&cus, hipDeviceAttributeMultiprocessorCount, dev) != hipSuccess) { grid = -1; return; }
        if (hipFuncSetAttribute((const void*)mk_fwd, hipFuncAttributeMaxDynamicSharedMemorySize, mk::LDS_BYTES) != hipSuccess) { fprintf(stderr, "kernel_launch: hipFuncSetAttribute failed\n"); grid = -1; return; }
        if (hipOccupancyMaxActiveBlocksPerMultiprocessor(&per_cu, (const void*)mk_fwd, mk::NTHREADS, mk::LDS_BYTES) != hipSuccess || per_cu < 1) { fprintf(stderr, "kernel_launch: occupancy query says %d\n", per_cu); }
        (void)hipGetLastError();
        grid = cus;
    }
    if (grid < 0) return;
    (void)hipMemsetAsync((char*)d_ws + mk::WS_CTL, 0, mk::CTL_ZERO_BYTES, stream);
    Args a{};
    for (int i = 0; i < 29; ++i) a.in[i] = (const float*)d_in[i];
    a.out = (float*)d_out; a.ws = (unsigned char*)d_ws;
#if MK_PER_PHASE
    for (int p = 0; p < N_PHASES; ++p) { a.ph_lo = p; a.ph_hi = p + 1; hipLaunchKernelGGL(mk_fwd, dim3(grid), dim3(mk::NTHREADS), mk::LDS_BYTES, stream, a); }
#else
    a.ph_lo = 0; a.ph_hi = N_PHASES;
    hipLaunchKernelGGL(mk_fwd, dim3(grid), dim3(mk::NTHREADS), mk::LDS_BYTES, stream, a);
#endif
}
```
